# Optimizing an MI355X kernel written in HIP

```python
import math
import jax, jax.numpy as jnp
from jax import lax
import numpy as np

D_MODEL = 1024
BATCH = 2
SEQ = 8192
DEPTH = 1
DEC_BATCH = 16
DEC_SEQ = 32
PAST_LEN = 2048

CHUNK = 64
N_META = 16
ROPE_THETA = 10000.0
EPS = 1e-6
D_FF = 2816
A_HEADS = 8
A_DIM = 64
B_HEADS = 8
B_DIM = 128
IDX_HEADS = 8
IDX_DIM = 64
TOPK_MAX = 256
QBLOCK = 128
A_WIDTH = A_HEADS * 2 * A_DIM
B_WIDTH = B_HEADS * B_DIM
SPLIT_SIZES = (A_WIDTH, A_WIDTH, A_WIDTH, B_WIDTH, B_WIDTH, B_WIDTH,
               IDX_HEADS * IDX_DIM, IDX_DIM, IDX_HEADS, 2 * D_MODEL)
SPLIT_POINTS = tuple(int(s) for s in np.cumsum(SPLIT_SIZES)[:-1])
N_IN_COLS = int(sum(SPLIT_SIZES))

kernel_name = "gated_diffattn_dsa_macaron_stream"


def rms_norm(x, g):
    xf = x.astype(jnp.float32)
    y = xf * lax.rsqrt(jnp.mean(xf * xf, axis=-1, keepdims=True) + EPS)
    return (y * g.astype(jnp.float32)).astype(x.dtype)


def swiglu(x, w_gate, w_up, w_down):
    return (jax.nn.silu(x @ w_gate) * (x @ w_up)) @ w_down


def rope(x, pos):
    half = x.shape[-1] // 2
    inv_freq = ROPE_THETA ** (-jnp.arange(half, dtype=jnp.float32) / half)
    ang = pos.astype(jnp.float32)[:, None] * inv_freq[None, :]
    cos = jnp.cos(ang)[None, :, None, :]
    sin = jnp.sin(ang)[None, :, None, :]
    xf = x.astype(jnp.float32)
    x1, x2 = xf[..., :half], xf[..., half:]
    return jnp.concatenate([x1 * cos - x2 * sin, x2 * cos + x1 * sin], axis=-1).astype(x.dtype)


def mixer_inputs(h, w_in, pos):
    b, n = h.shape[:2]
    aq, ak, av, bq, bk, bv, iq, ik, iw, gates = jnp.split(h @ w_in, SPLIT_POINTS, axis=-1)
    aq = rope(aq.reshape(b, n, 2 * A_HEADS, A_DIM), pos).reshape(b, n, A_HEADS, 2 * A_DIM)
    ak = rope(ak.reshape(b, n, 2 * A_HEADS, A_DIM), pos).reshape(b, n, A_HEADS, 2 * A_DIM)
    av = av.reshape(b, n, A_HEADS, 2 * A_DIM)
    bq = rope(bq.reshape(b, n, B_HEADS, B_DIM), pos)
    bk = rope(bk.reshape(b, n, B_HEADS, B_DIM), pos)
    bv = bv.reshape(b, n, B_HEADS, B_DIM)
    iq = rope(iq.reshape(b, n, IDX_HEADS, IDX_DIM), pos)
    ik = rope(ik.reshape(b, n, 1, IDX_DIM), pos).reshape(b, n, IDX_DIM)
    return aq, ak, av, bq, bk, bv, iq, ik, iw, gates


def map_query_blocks(fn, q_args, q_chunk):
    n = q_chunk.shape[0]
    qb = min(QBLOCK, n)
    n_blk = -(-n // qb)
    pad = n_blk * qb - n

    def to_blocks(a):
        a = jnp.pad(a, [(0, 0), (0, pad)] + [(0, 0)] * (a.ndim - 2))
        return jnp.moveaxis(a.reshape((a.shape[0], n_blk, qb) + a.shape[2:]), 1, 0)

    qc = jnp.pad(q_chunk, (0, pad), constant_values=-1).reshape(n_blk, qb)
    out = lax.map(lambda blk: fn(*blk[0], blk[1]), (tuple(to_blocks(a) for a in q_args), qc))
    out = jnp.moveaxis(out, 0, 1)
    return out.reshape((out.shape[0], n_blk * qb) + out.shape[3:])[:, :n]


def diff_attn_block(q, qc, k, v, kc, lam):
    b, nq = q.shape[:2]
    nk = k.shape[1]
    q = q.reshape(b, nq, A_HEADS, 2, A_DIM)
    k = k.reshape(b, nk, A_HEADS, 2, A_DIM)
    s = jnp.einsum('bqhmd,bkhmd->bmhqk', q, k).astype(jnp.float32) * (A_DIM ** -0.5)
    visible = kc[None, :] <= qc[:, None]
    p = jax.nn.softmax(jnp.where(visible, s, -jnp.inf), axis=-1)
    w = p[:, 0] - lam * p[:, 1]
    return jnp.einsum('bhqk,bkhe->bqhe', w.astype(v.dtype), v)


def dsa_block(q, iq, iw, qc, k, v, ik, kc, n_top):
    rel = jax.nn.relu(jnp.einsum('bqhd,bkd->bqhk', iq, ik).astype(jnp.float32) * (IDX_DIM ** -0.5))
    score = jnp.einsum('bqhk,bqh->bqk', rel, iw.astype(jnp.float32)) * (IDX_HEADS ** -0.5)
    visible = kc[None, :] <= qc[:, None]
    score = jnp.where(visible[None], score, -jnp.inf)
    top_val, top_idx = lax.top_k(score, n_top)
    valid = top_val > -jnp.inf
    k_sel = jax.vmap(lambda kb, ib: kb[ib])(k, top_idx)
    v_sel = jax.vmap(lambda vb, ib: vb[ib])(v, top_idx)
    s = jnp.einsum('bqhd,bqthd->bhqt', q, k_sel).astype(jnp.float32) * (B_DIM ** -0.5)
    s = jnp.where(valid[:, None], s, -jnp.inf)
    p = jax.nn.softmax(s, axis=-1)
    return jnp.einsum('bhqt,bqthd->bqhd', p.astype(v.dtype), v_sel)


def trunk_layer(x, pos, q_chunk, k_chunk, past, n_top, lam, lam_init,
                g_ffn1, w1_gate, w1_up, w1_down, g_mix, w_in, a_subln, w_a, w_b, w_o,
                g_ffn2, w2_gate, w2_up, w2_down):
    b, n = x.shape[:2]
    x = x + 0.5 * swiglu(rms_norm(x, g_ffn1), w1_gate, w1_up, w1_down)
    h = rms_norm(x, g_mix)
    aq, ak, av, bq, bk, bv, iq, ik, iw, gates = mixer_inputs(h, w_in, pos)
    new_rows = (ak, av, bk, bv, ik)
    if past is None:
        keys = new_rows
    else:
        keys = tuple(jnp.concatenate([c, r.astype(c.dtype)], axis=1) for c, r in zip(past, new_rows))
    ak_all, av_all, bk_all, bv_all, ik_all = keys
    oa = map_query_blocks(lambda q, qc: diff_attn_block(q, qc, ak_all, av_all, k_chunk, lam),
                          (aq,), q_chunk)
    oa = rms_norm(oa, a_subln) * (1.0 - lam_init)
    ob = map_query_blocks(lambda q, qi, qw, qc: dsa_block(q, qi, qw, qc, bk_all, bv_all, ik_all, k_chunk, n_top),
                          (bq, iq, iw), q_chunk)
    g_a, g_b = jnp.split(gates, 2, axis=-1)
    merged = (jax.nn.sigmoid(g_a) * (oa.reshape(b, n, A_WIDTH) @ w_a)
              + jax.nn.sigmoid(g_b) * (ob.reshape(b, n, B_WIDTH) @ w_b))
    x = x + merged @ w_o
    x = x + 0.5 * swiglu(rms_norm(x, g_ffn2), w2_gate, w2_up, w2_down)
    return x, new_rows


def setup_inputs(seed: int = 0) -> dict:
    key = jax.random.key(seed)
    ks = jax.random.split(key, 32)

    def nrm(k, shape, scale):
        return jax.random.normal(k, shape, jnp.float32) * scale

    n_cache = N_META + PAST_LEN
    return {
        'x_prompt': nrm(ks[0], (BATCH, SEQ, D_MODEL), 1.0),
        'x_sample': nrm(ks[1], (DEC_BATCH, DEC_SEQ, D_MODEL), 1.0),
        'cache_a_k': nrm(ks[2], (DEPTH, DEC_BATCH, n_cache, A_HEADS, 2 * A_DIM), 1.0),
        'cache_a_v': nrm(ks[3], (DEPTH, DEC_BATCH, n_cache, A_HEADS, 2 * A_DIM), 1.0),
        'cache_b_k': nrm(ks[4], (DEPTH, DEC_BATCH, n_cache, B_HEADS, B_DIM), 1.0),
        'cache_b_v': nrm(ks[5], (DEPTH, DEC_BATCH, n_cache, B_HEADS, B_DIM), 1.0),
        'cache_b_kidx': nrm(ks[6], (DEPTH, DEC_BATCH, n_cache, IDX_DIM), 1.0),
        'meta': nrm(ks[7], (N_META, D_MODEL), 1.0),
        'g_ffn1': 1.0 + nrm(ks[8], (DEPTH, D_MODEL), 0.01),
        'w1_gate': nrm(ks[9], (DEPTH, D_MODEL, D_FF), D_MODEL ** -0.5),
        'w1_up': nrm(ks[10], (DEPTH, D_MODEL, D_FF), D_MODEL ** -0.5),
        'w1_down': nrm(ks[11], (DEPTH, D_FF, D_MODEL), D_FF ** -0.5),
        'g_mix': 1.0 + nrm(ks[12], (DEPTH, D_MODEL), 0.01),
        'w_in': nrm(ks[13], (DEPTH, D_MODEL, N_IN_COLS), D_MODEL ** -0.5),
        'lam_q1': nrm(ks[14], (DEPTH, A_DIM), 0.1),
        'lam_k1': nrm(ks[15], (DEPTH, A_DIM), 0.1),
        'lam_q2': nrm(ks[16], (DEPTH, A_DIM), 0.1),
        'lam_k2': nrm(ks[17], (DEPTH, A_DIM), 0.1),
        'a_subln': 1.0 + nrm(ks[18], (DEPTH, 2 * A_DIM), 0.01),
        'w_a': nrm(ks[19], (DEPTH, A_WIDTH, D_MODEL), A_WIDTH ** -0.5),
        'w_b': nrm(ks[20], (DEPTH, B_WIDTH, D_MODEL), B_WIDTH ** -0.5),
        'w_o': nrm(ks[21], (DEPTH, D_MODEL, D_MODEL), D_MODEL ** -0.5),
        'g_ffn2': 1.0 + nrm(ks[22], (DEPTH, D_MODEL), 0.01),
        'w2_gate': nrm(ks[23], (DEPTH, D_MODEL, D_FF), D_MODEL ** -0.5),
        'w2_up': nrm(ks[24], (DEPTH, D_MODEL, D_FF), D_MODEL ** -0.5),
        'w2_down': nrm(ks[25], (DEPTH, D_FF, D_MODEL), D_FF ** -0.5),
        'g_final': 1.0 + nrm(ks[26], (D_MODEL,), 0.01),
    }


def reference(x_prompt, x_sample, cache_a_k, cache_a_v, cache_b_k, cache_b_v, cache_b_kidx,
              meta, g_ffn1, w1_gate, w1_up, w1_down, g_mix, w_in, lam_q1, lam_k1, lam_q2, lam_k2,
              a_subln, w_a, w_b, w_o, g_ffn2, w2_gate, w2_up, w2_down, g_final):
    n_top_p = min(TOPK_MAX, SEQ // 4)
    n_top_s = min(TOPK_MAX, (PAST_LEN + DEC_SEQ) // 4)
    meta_chunk = jnp.full((N_META,), -1, jnp.int32)
    pos_p = jnp.arange(N_META + SEQ, dtype=jnp.int32)
    chunk_p = jnp.concatenate([meta_chunk, jnp.arange(SEQ, dtype=jnp.int32) // CHUNK])
    new_frames = PAST_LEN + jnp.arange(DEC_SEQ, dtype=jnp.int32)
    pos_s = N_META + new_frames
    chunk_q_s = new_frames // CHUNK
    chunk_k_s = jnp.concatenate([meta_chunk, jnp.arange(PAST_LEN, dtype=jnp.int32) // CHUNK, chunk_q_s])

    xp = jnp.concatenate([jnp.broadcast_to(meta[None].astype(x_prompt.dtype),
                                           (x_prompt.shape[0], N_META, D_MODEL)), x_prompt], axis=1)
    xs = x_sample
    new_p = [[], [], [], [], []]
    new_s = [[], [], [], [], []]
    for l in range(DEPTH):
        lam_init = 0.8 - 0.6 * math.exp(-0.3 * l)
        lam = (jnp.exp(jnp.sum(lam_q1[l].astype(jnp.float32) * lam_k1[l].astype(jnp.float32)))
               - jnp.exp(jnp.sum(lam_q2[l].astype(jnp.float32) * lam_k2[l].astype(jnp.float32)))
               + lam_init)
        weights = (g_ffn1[l], w1_gate[l], w1_up[l], w1_down[l], g_mix[l], w_in[l], a_subln[l],
                   w_a[l], w_b[l], w_o[l], g_ffn2[l], w2_gate[l], w2_up[l], w2_down[l])
        xp, rows_p = trunk_layer(xp, pos_p, chunk_p, chunk_p, None, n_top_p, lam, lam_init, *weights)
        past = (cache_a_k[l], cache_a_v[l], cache_b_k[l], cache_b_v[l], cache_b_kidx[l])
        xs, rows_s = trunk_layer(xs, pos_s, chunk_q_s, chunk_k_s, past, n_top_s, lam, lam_init, *weights)
        for i in range(5):
            new_p[i].append(rows_p[i])
            new_s[i].append(rows_s[i])
    y_prompt = rms_norm(xp, g_final)[:, N_META:]
    y_sample = rms_norm(xs, g_final)
    a_k_p = jnp.stack(new_p[0])
    a_v_p = jnp.stack(new_p[1])
    b_k_p = jnp.stack(new_p[2])
    b_v_p = jnp.stack(new_p[3])
    b_kidx_p = jnp.stack(new_p[4])
    a_k_s = jnp.stack(new_s[0])
    a_v_s = jnp.stack(new_s[1])
    b_k_s = jnp.stack(new_s[2])
    b_v_s = jnp.stack(new_s[3])
    b_kidx_s = jnp.stack(new_s[4])
    return (y_prompt, y_sample, a_k_p, a_v_p, b_k_p, b_v_p, b_kidx_p, a_k_s, a_v_s, b_k_s, b_v_s, b_kidx_s)
```

```cpp
#include <hip/hip_runtime.h>
#include <hip/hip_cooperative_groups.h>
#include <stdint.h>
#include <cstdio>
namespace cg = cooperative_groups;

typedef __attribute__((ext_vector_type(8))) short bf16x8;
typedef __attribute__((ext_vector_type(4))) short bf16x4;
typedef __attribute__((ext_vector_type(16))) float f32x16;
typedef unsigned short u16;
typedef unsigned long long u64;
#define MFMA(a, b, c) __builtin_amdgcn_mfma_f32_32x32x16_bf16((a), (b), (c), 0, 0, 0)
#define DI __device__ __forceinline__

constexpr int NTOKP = 8208;
constexpr int TP = 2 * NTOKP;
constexpr int TS = 512;
constexpr int T = TP + TS;
constexpr int TPAD = 17024;
constexpr int NT_M = 133;
constexpr int NCACHE = 2064;
constexpr int NKS = 2096;
constexpr int NWP = 129;
constexpr int NWS = 33;
constexpr float EPS = 1e-6f;
constexpr float LOG2E = 1.4426950408889634f;
constexpr float QA_SCALE = 0.125f * LOG2E;
constexpr float QB_SCALE = 0.08838834764831845f * LOG2E;
constexpr float IW_SCALE = 0.125f * 0.35355339059327373f;

constexpr size_t O_YP = 0;
constexpr size_t O_YS = O_YP + 2ull * 8192 * 1024;
constexpr size_t O_AKP = O_YS + 512ull * 1024;
constexpr size_t SZ_NEWP = (size_t)TP * 1024;
constexpr size_t O_AVP = O_AKP + SZ_NEWP;
constexpr size_t O_BKP = O_AVP + SZ_NEWP;
constexpr size_t O_BVP = O_BKP + SZ_NEWP;
constexpr size_t O_IKP = O_BVP + SZ_NEWP;
constexpr size_t O_AKS = O_IKP + (size_t)TP * 64;
constexpr size_t SZ_NEWS = (size_t)TS * 1024;
constexpr size_t O_AVS = O_AKS + SZ_NEWS;
constexpr size_t O_BKS = O_AVS + SZ_NEWS;
constexpr size_t O_BVS = O_BKS + SZ_NEWS;
constexpr size_t O_IKS = O_BVS + SZ_NEWS;

constexpr size_t al256(size_t x) { return (x + 255) & ~size_t(255); }
constexpr size_t SZ_WGU = 5632ull * 1024 * 2, SZ_WD = 1024ull * 2816 * 2, SZ_WIN = 8832ull * 1024 * 2, SZ_WSQ = 1024ull * 1024 * 2;
constexpr size_t OFF_WGU1 = 0;
constexpr size_t OFF_WD1 = OFF_WGU1 + SZ_WGU;
constexpr size_t OFF_WIN = OFF_WD1 + SZ_WD;
constexpr size_t OFF_WA = OFF_WIN + SZ_WIN;
constexpr size_t OFF_WB = OFF_WA + SZ_WSQ;
constexpr size_t OFF_WO = OFF_WB + SZ_WSQ;
constexpr size_t OFF_WGU2 = OFF_WO + SZ_WSQ;
constexpr size_t OFF_WD2 = OFF_WGU2 + SZ_WGU;
constexpr size_t OFF_XB = OFF_WD2 + SZ_WD;
constexpr size_t OFF_XF = OFF_XB + (size_t)TPAD * 1024 * 2;
constexpr size_t SZ_SSP = (size_t)TPAD * 16 * 4;
constexpr size_t OFF_SSP0 = OFF_XF + (size_t)TPAD * 1024 * 4;
constexpr size_t OFF_SSP1 = OFF_SSP0 + SZ_SSP;
constexpr size_t OFF_SSP2 = OFF_SSP1 + SZ_SSP;
constexpr size_t OFF_SSP3 = OFF_SSP2 + SZ_SSP;
constexpr size_t OFF_TAB = OFF_SSP3 + SZ_SSP;
constexpr size_t OFF_AQ = OFF_TAB + (size_t)NTOKP * 64 * 8;
constexpr size_t OFF_MB = OFF_AQ;
constexpr size_t OFF_BQ = OFF_AQ + (size_t)TPAD * 1024 * 2;
constexpr size_t OFF_IQ = OFF_BQ + (size_t)TPAD * 1024 * 2;
constexpr size_t OFF_IW = OFF_IQ + (size_t)TPAD * 512 * 2;
constexpr size_t OFF_G = OFF_IW + (size_t)TPAD * 8 * 4;
constexpr size_t OFF_OA = OFF_G + (size_t)TPAD * 2048 * 2;
constexpr size_t OFF_OB = OFF_OA + (size_t)TPAD * 1024 * 2;
constexpr size_t OFF_MASKP = OFF_OB + (size_t)TPAD * 1024 * 2;
constexpr size_t OFF_MASKS = OFF_MASKP + al256((size_t)TP * NWP * 8);
constexpr size_t OFF_CNT = OFF_MASKS + al256((size_t)TS * NWS * 8);
constexpr size_t OFF_HID = OFF_CNT + 256;
constexpr size_t OFF_SC = OFF_HID;
constexpr size_t SC_BSTRIDE = 4096ull * (128 * 131 / 2);
constexpr size_t SC_META = 2 * SC_BSTRIDE;
constexpr size_t SC_SAMP = SC_META + 2 * 4096;
constexpr size_t SC_FLOATS = SC_SAMP + 16ull * 64 * 2112;
constexpr size_t WS_END = OFF_SC + SC_FLOATS * 4;
static_assert(WS_END <= 736544256ull, "workspace budget");
static_assert((size_t)TPAD * 2816 * 2 <= SC_FLOATS * 4, "hid fits in sc region");

constexpr int SMEM_BYTES = 77824 + 64;

struct Params {
  const float* in[27];
  float* out;
  char* ws;
};

DI u16 f2bf(float x) {
  unsigned u = __float_as_uint(x);
  u += 0x7fffu + ((u >> 16) & 1u);
  return (u16)(u >> 16);
}
DI unsigned pack2(float a, float b) { return (unsigned)f2bf(a) | ((unsigned)f2bf(b) << 16); }
DI int crow(int i, int h) { return (i & 3) + 8 * (i >> 2) + 4 * h; }
DI float fexp2(float x) { return __builtin_amdgcn_exp2f(x); }
DI float shx(float v, int m) { return __shfl_xor(v, m, 64); }

DI const float* xrow_ptr(const Params& p, int row) {
  if (row < TP) {
    int b = row >= NTOKP ? 1 : 0;
    int tok = row - b * NTOKP;
    if (tok < 16) return p.in[7] + (size_t)tok * 1024;
    return p.in[0] + ((size_t)b * 8192 + (tok - 16)) * 1024;
  }
  return p.in[1] + (size_t)(row - TP) * 1024;
}

DI const float* kv_row(const Params& p, int grp, int b, int tk, int which) {
  if (!grp) return p.out + O_AKP + (size_t)which * SZ_NEWP + ((size_t)b * NTOKP + tk) * 1024;
  if (tk < NCACHE) return (which == 0 ? p.in[2] : which == 1 ? p.in[3] : which == 2 ? p.in[4] : p.in[5]) + ((size_t)b * NCACHE + tk) * 1024;
  return p.out + O_AKS + (size_t)which * SZ_NEWS + ((size_t)b * 32 + (tk - NCACHE)) * 1024;
}
DI const float* ik_row(const Params& p, int grp, int b, int tk) {
  if (!grp) return p.out + O_IKP + ((size_t)b * NTOKP + tk) * 64;
  if (tk < NCACHE) return p.in[6] + ((size_t)b * NCACHE + tk) * 64;
  return p.out + O_IKS + ((size_t)b * 32 + (tk - NCACHE)) * 64;
}

template <int job>
DI void wt_tile(const Params& p, int seg, int kt, float* ts) {
  const int t = threadIdx.x;
  const float* src = nullptr; int ld = 0; const float* gs = nullptr; u16* dst = nullptr; int K = 1024; int nvalid4 = 8;
  switch (job) {
    case 0: case 6: {
      const int j = seg >> 1;
      const float* wg = job == 0 ? p.in[9] : p.in[23]; const float* wu = job == 0 ? p.in[10] : p.in[24];
      src = ((seg & 1) ? wu : wg) + 32 * j; ld = 2816; gs = job == 0 ? p.in[8] : p.in[22];
      dst = (u16*)(p.ws + (job == 0 ? OFF_WGU1 : OFF_WGU2)) + (size_t)seg * 32 * 1024; K = 1024;
    } break;
    case 1: case 7: {
      src = (job == 1 ? p.in[11] : p.in[25]) + 32 * seg; ld = 1024; K = 2816;
      dst = (u16*)(p.ws + (job == 1 ? OFF_WD1 : OFF_WD2)) + (size_t)seg * 32 * 2816;
    } break;
    case 2: {
      const int v0 = seg * 32; int a0;
      if (v0 < 6144) {
        const int ty = v0 >> 10;
        if (ty == 3 || ty == 4) { const int hv = v0 & 127; const int gi = hv >> 6, sub = (hv & 63) >> 5; a0 = (v0 - hv) + gi * 32 + sub * 64; }
        else a0 = v0;
      } else if (v0 < 6720) a0 = v0;
      else if (v0 == 6720) { a0 = 6720; nvalid4 = 2; }
      else if (v0 == 6752) { a0 = 6720; nvalid4 = 0; }
      else a0 = v0 - 56;
      src = p.in[13] + a0; ld = 8776; gs = p.in[12]; K = 1024;
      dst = (u16*)(p.ws + OFF_WIN) + (size_t)v0 * 1024;
    } break;
    default: {
      src = (job == 3 ? p.in[19] : (job == 4 ? p.in[20] : p.in[21])) + 32 * seg; ld = 1024; K = 1024;
      dst = (u16*)(p.ws + (job == 3 ? OFF_WA : (job == 4 ? OFF_WB : OFF_WO))) + (size_t)seg * 32 * 1024;
    } break;
  }
  const int c4 = t & 7, kr = t >> 3;
#pragma unroll
  for (int ps = 0; ps < 4; ++ps) {
    const int kl = ps * 32 + kr; const int k = kt * 128 + kl;
    float4 v = make_float4(0.f, 0.f, 0.f, 0.f);
    if (c4 < nvalid4) v = *(const float4*)(src + (size_t)k * ld + c4 * 4);
    const float s = gs ? gs[k] : 1.0f;
    float* d = ts + kl * 33 + c4 * 4;
    d[0] = v.x * s; d[1] = v.y * s; d[2] = v.z * s; d[3] = v.w * s;
  }
  __syncthreads();
  {
    const int r = t >> 3, kc = t & 7;
    unsigned o[8];
#pragma unroll
    for (int j = 0; j < 8; ++j) o[j] = pack2(ts[(kc * 16 + 2 * j) * 33 + r], ts[(kc * 16 + 2 * j + 1) * 33 + r]);
    uint4* dp = (uint4*)(dst + (size_t)r * K + kt * 128 + kc * 16);
    dp[0] = make_uint4(o[0], o[1], o[2], o[3]);
    dp[1] = make_uint4(o[4], o[5], o[6], o[7]);
  }
  __syncthreads();
}

DI void phase_prep(const Params& p, char* smem) {
  const int t = threadIdx.x, lane = t & 63;
  if (blockIdx.x == 0 && t < 64) ((unsigned*)(p.ws + OFF_CNT))[t] = 0u;
  for (int e = blockIdx.x * 256 + t; e < NTOKP * 64; e += gridDim.x * 256) {
    const int pos = e >> 6, i = e & 63;
    double inv = 1.0;
    for (int j = 0; j < i; ++j) inv *= 0.8659643233600653;
    const float invf = (float)inv;
    const float ang = (float)pos * invf;
    const double a = (double)ang;
    const double qd = rint(a * 0.6366197723675814);
    const double r = (a - qd * 1.5707963267948966) - qd * 6.123233995736766e-17;
    const double r2 = r * r;
    double sn = r2 * (1.0 / 6227020800.0) - 1.0 / 39916800.0;
    sn = sn * r2 + 1.0 / 362880.0; sn = sn * r2 - 1.0 / 5040.0; sn = sn * r2 + 1.0 / 120.0; sn = sn * r2 - 1.0 / 6.0; sn = sn * r2 * r + r;
    double cn = -r2 * (1.0 / 87178291200.0) + 1.0 / 479001600.0;
    cn = cn * r2 - 1.0 / 3628800.0; cn = cn * r2 + 1.0 / 40320.0; cn = cn * r2 - 1.0 / 720.0; cn = cn * r2 + 1.0 / 24.0; cn = cn * r2 - 0.5; cn = cn * r2 + 1.0;
    const int q = ((int)qd) & 3;
    double c, s;
    if (q == 0) { c = cn; s = sn; } else if (q == 1) { c = -sn; s = cn; } else if (q == 2) { c = -cn; s = -sn; } else { c = sn; s = -cn; }
    ((float2*)(p.ws + OFF_TAB))[e] = make_float2((float)c, (float)s);
  }
  {
    const int wv = blockIdx.x * 4 + (t >> 6), nw = gridDim.x * 4;
    for (int row = wv; row < TPAD; row += nw) {
      u16* xb = (u16*)(p.ws + OFF_XB) + (size_t)row * 1024;
      float* ssp = (float*)(p.ws + OFF_SSP0) + (size_t)row * 16;
      if (row >= T) {
        uint4 z = make_uint4(0, 0, 0, 0);
        ((uint4*)xb)[lane * 2] = z; ((uint4*)xb)[lane * 2 + 1] = z;
        if (lane < 16) ssp[lane] = lane == 0 ? 1024.f : 0.f;
        continue;
      }
      const float4* src = (const float4*)xrow_ptr(p, row);
      float ss = 0.f;
#pragma unroll
      for (int i = 0; i < 4; ++i) {
        const float4 v = src[lane + 64 * i];
        ss += v.x * v.x + v.y * v.y + v.z * v.z + v.w * v.w;
        ((uint2*)xb)[lane + 64 * i] = make_uint2(pack2(v.x, v.y), pack2(v.z, v.w));
      }
#pragma unroll
      for (int m = 32; m >= 1; m >>= 1) ss += shx(ss, m);
      if (lane < 16) ssp[lane] = lane == 0 ? ss : 0.f;
    }
  }
  {
    float* ts = (float*)smem;
    for (int tile = blockIdx.x; tile < 7200; tile += gridDim.x) {
      int job, r = tile;
      if (r < 1408) job = 0;
      else if ((r -= 1408) < 704) job = 1;
      else if ((r -= 704) < 2208) job = 2;
      else if ((r -= 2208) < 256) job = 3;
      else if ((r -= 256) < 256) job = 4;
      else if ((r -= 256) < 256) job = 5;
      else if ((r -= 256) < 1408) job = 6;
      else { r -= 1408; job = 7; }
      const int nkt = (job == 1 || job == 7) ? 22 : 8;
      const int sg = r / nkt, kk = r % nkt;
      switch (job) {
        case 0: wt_tile<0>(p, sg, kk, ts); break;
        case 1: wt_tile<1>(p, sg, kk, ts); break;
        case 2: wt_tile<2>(p, sg, kk, ts); break;
        case 3: wt_tile<3>(p, sg, kk, ts); break;
        case 4: wt_tile<4>(p, sg, kk, ts); break;
        case 5: wt_tile<5>(p, sg, kk, ts); break;
        case 6: wt_tile<6>(p, sg, kk, ts); break;
        default: wt_tile<7>(p, sg, kk, ts); break;
      }
    }
  }
}

DI void gemm_mainloop(const u16* __restrict__ A, int lda, const u16* __restrict__ B, int ldb, int K, int m0, int n0,
                      u16* smem, f32x16 (&acc)[2][2]) {
  u16* As = smem; u16* Bs = smem + 128 * 72;
  const int t = threadIdx.x, lane = t & 63, w = t >> 6, wm = w >> 1, wn = w & 1;
  const int lr = lane & 31, lh = lane >> 5;
  const int lrow = t >> 3, lkc = t & 7;
  const u16* Ap = A + (size_t)(m0 + lrow) * lda + lkc * 8;
  const u16* Bp = B + (size_t)(n0 + lrow) * ldb + lkc * 8;
  uint4 ra0, ra1, ra2, ra3, rb0, rb1, rb2, rb3;
  ra0 = *(const uint4*)(Ap); ra1 = *(const uint4*)(Ap + (size_t)32 * lda); ra2 = *(const uint4*)(Ap + (size_t)64 * lda); ra3 = *(const uint4*)(Ap + (size_t)96 * lda);
  rb0 = *(const uint4*)(Bp); rb1 = *(const uint4*)(Bp + (size_t)32 * ldb); rb2 = *(const uint4*)(Bp + (size_t)64 * ldb); rb3 = *(const uint4*)(Bp + (size_t)96 * ldb);
  for (int k0 = 0; k0 < K; k0 += 64) {
    __syncthreads();
    *(uint4*)(As + (lrow) * 72 + lkc * 8) = ra0; *(uint4*)(As + (lrow + 32) * 72 + lkc * 8) = ra1;
    *(uint4*)(As + (lrow + 64) * 72 + lkc * 8) = ra2; *(uint4*)(As + (lrow + 96) * 72 + lkc * 8) = ra3;
    *(uint4*)(Bs + (lrow) * 72 + lkc * 8) = rb0; *(uint4*)(Bs + (lrow + 32) * 72 + lkc * 8) = rb1;
    *(uint4*)(Bs + (lrow + 64) * 72 + lkc * 8) = rb2; *(uint4*)(Bs + (lrow + 96) * 72 + lkc * 8) = rb3;
    __syncthreads();
    {
      const int kn = (k0 + 64 < K) ? k0 + 64 : k0;
      ra0 = *(const uint4*)(Ap + kn); ra1 = *(const uint4*)(Ap + (size_t)32 * lda + kn); ra2 = *(const uint4*)(Ap + (size_t)64 * lda + kn); ra3 = *(const uint4*)(Ap + (size_t)96 * lda + kn);
      rb0 = *(const uint4*)(Bp + kn); rb1 = *(const uint4*)(Bp + (size_t)32 * ldb + kn); rb2 = *(const uint4*)(Bp + (size_t)64 * ldb + kn); rb3 = *(const uint4*)(Bp + (size_t)96 * ldb + kn);
    }
#pragma unroll
    for (int ks = 0; ks < 4; ++ks) {
      bf16x8 a0 = *(const bf16x8*)(As + (wm * 64 + lr) * 72 + ks * 16 + lh * 8);
      bf16x8 a1 = *(const bf16x8*)(As + (wm * 64 + 32 + lr) * 72 + ks * 16 + lh * 8);
      bf16x8 b0 = *(const bf16x8*)(Bs + (wn * 64 + lr) * 72 + ks * 16 + lh * 8);
      bf16x8 b1 = *(const bf16x8*)(Bs + (wn * 64 + 32 + lr) * 72 + ks * 16 + lh * 8);
      acc[0][0] = MFMA(a0, b0, acc[0][0]);
      acc[0][1] = MFMA(a0, b1, acc[0][1]);
      acc[1][0] = MFMA(a1, b0, acc[1][0]);
      acc[1][1] = MFMA(a1, b1, acc[1][1]);
    }
  }
}

DI void zero_acc(f32x16 (&acc)[2][2]) {
#pragma unroll
  for (int a = 0; a < 2; ++a)
#pragma unroll
    for (int b = 0; b < 2; ++b)
#pragma unroll
      for (int i = 0; i < 16; ++i) acc[a][b][i] = 0.f;
}

DI void load_rs(const float* ssp, int m0, float* rs_s) {
  __syncthreads();
  const int t = threadIdx.x;
  if (t < 128) {
    const float4* q = (const float4*)(ssp + (size_t)(m0 + t) * 16);
    const float4 a = q[0], b = q[1], c = q[2], d = q[3];
    const float s = ((a.x + a.y) + (a.z + a.w)) + ((b.x + b.y) + (b.z + b.w)) + ((c.x + c.y) + (c.z + c.w)) + ((d.x + d.y) + (d.z + d.w));
    rs_s[t] = rsqrtf(s * (1.0f / 1024.0f) + EPS);
  }
}

DI void phase_gateup(const Params& p, char* smem, size_t off_ssp, size_t off_w) {
  const u16* A = (const u16*)(p.ws + OFF_XB);
  const u16* B = (const u16*)(p.ws + off_w);
  const float* ssp = (const float*)(p.ws + off_ssp);
  u16* hid = (u16*)(p.ws + OFF_HID);
  float* rs_s = (float*)(smem + 36864);
  const int t = threadIdx.x, lane = t & 63, w = t >> 6, wm = w >> 1, wn = w & 1, lr = lane & 31, lh = lane >> 5;
  for (int tile = blockIdx.x; tile < NT_M * 44; tile += gridDim.x) {
    const int m0 = (tile / 44) * 128, n0 = (tile % 44) * 128;
    load_rs(ssp, m0, rs_s);
    f32x16 acc[2][2]; zero_acc(acc);
    gemm_mainloop(A, 1024, B, 1024, 1024, m0, n0, (u16*)smem, acc);
    const int hc = ((n0 + wn * 64) >> 1) + lr;
#pragma unroll
    for (int mi = 0; mi < 2; ++mi)
#pragma unroll
      for (int i = 0; i < 16; ++i) {
        const int rl = wm * 64 + mi * 32 + crow(i, lh); const int row = m0 + rl;
        if (row < T) {
          const float r = rs_s[rl];
          const float g = acc[mi][0][i] * r, u = acc[mi][1][i] * r;
          const float hv = g / (1.0f + __expf(-g)) * u;
          hid[(size_t)row * 2816 + hc] = f2bf(hv);
        }
      }
  }
}

template <int RESID_ORIG>
DI void phase_resid(const Params& p, char* smem, const u16* A, int lda, int K, size_t off_w, float factor, size_t off_ssp_out) {
  const u16* B = (const u16*)(p.ws + off_w);
  float* xf = (float*)(p.ws + OFF_XF);
  u16* xb = (u16*)(p.ws + OFF_XB);
  float* sspo = (float*)(p.ws + off_ssp_out);
  const int t = threadIdx.x, lane = t & 63, w = t >> 6, wm = w >> 1, wn = w & 1, lr = lane & 31, lh = lane >> 5;
  for (int tile = blockIdx.x; tile < NT_M * 8; tile += gridDim.x) {
    const int m0 = (tile >> 3) * 128, nt = tile & 7, n0 = nt * 128;
    f32x16 acc[2][2]; zero_acc(acc);
    gemm_mainloop(A, lda, B, K, K, m0, n0, (u16*)smem, acc);
#pragma unroll
    for (int mi = 0; mi < 2; ++mi)
#pragma unroll
      for (int i = 0; i < 16; ++i) {
        const int rl = wm * 64 + mi * 32 + crow(i, lh); const int row = m0 + rl;
        const bool ok = row < T;
        float part = 0.f;
        if (ok) {
          const float* rsrc = RESID_ORIG ? xrow_ptr(p, row) : (xf + (size_t)row * 1024);
#pragma unroll
          for (int ni = 0; ni < 2; ++ni) {
            const int col = n0 + wn * 64 + ni * 32 + lr;
            const float v = rsrc[col] + factor * acc[mi][ni][i];
            xf[(size_t)row * 1024 + col] = v;
            xb[(size_t)row * 1024 + col] = f2bf(v);
            part += v * v;
          }
        }
        part += shx(part, 16); part += shx(part, 8); part += shx(part, 4); part += shx(part, 2); part += shx(part, 1);
        if (ok && lr == 0) sspo[(size_t)row * 16 + nt * 2 + wn] = part;
      }
  }
}

DI void phase_win(const Params& p, char* smem) {
  const u16* A = (const u16*)(p.ws + OFF_XB);
  const u16* B = (const u16*)(p.ws + OFF_WIN);
  const float* ssp = (const float*)(p.ws + OFF_SSP1);
  const float2* tab = (const float2*)(p.ws + OFF_TAB);
  u16* AQ = (u16*)(p.ws + OFF_AQ); u16* BQ = (u16*)(p.ws + OFF_BQ); u16* IQ = (u16*)(p.ws + OFF_IQ);
  float* IW = (float*)(p.ws + OFF_IW); u16* G = (u16*)(p.ws + OFF_G);
  float* out = p.out;
  float* rs_s = (float*)(smem + 36864);
  const int t = threadIdx.x, lane = t & 63, w = t >> 6, wm = w >> 1, wn = w & 1, lr = lane & 31, lh = lane >> 5;
  for (int tile = blockIdx.x; tile < NT_M * 69; tile += gridDim.x) {
    const int m0 = (tile / 69) * 128, n0 = (tile % 69) * 128;
    load_rs(ssp, m0, rs_s);
    f32x16 acc[2][2]; zero_acc(acc);
    gemm_mainloop(A, 1024, B, 1024, 1024, m0, n0, (u16*)smem, acc);
    const int vg = (n0 >> 6) + wn;
#pragma unroll
    for (int mi = 0; mi < 2; ++mi)
#pragma unroll
      for (int i = 0; i < 16; ++i) {
        const int rl = wm * 64 + mi * 32 + crow(i, lh); const int row = m0 + rl;
        if (row >= T) continue;
        const float r = rs_s[rl];
        const float v0 = acc[mi][0][i] * r, v1 = acc[mi][1][i] * r;
        const bool smp = row >= TP;
        const int orow = smp ? row - TP : row;
        const int pos = smp ? (NCACHE + (orow & 31)) : (row >= NTOKP ? row - NTOKP : row);
        if (vg < 32 || (vg >= 96 && vg < 105)) {
          const float2 cs = tab[pos * 64 + 2 * lr];
          const float o0 = v0 * cs.x - v1 * cs.y, o1 = v1 * cs.x + v0 * cs.y;
          if (vg < 16) { u16* d = AQ + (size_t)row * 1024 + vg * 64 + lr; d[0] = f2bf(o0 * QA_SCALE); d[32] = f2bf(o1 * QA_SCALE); }
          else if (vg < 32) { float* d = out + (smp ? O_AKS : O_AKP) + (size_t)orow * 1024 + (vg - 16) * 64 + lr; d[0] = o0; d[32] = o1; }
          else if (vg < 104) { u16* d = IQ + (size_t)row * 512 + (vg - 96) * 64 + lr; d[0] = f2bf(o0); d[32] = f2bf(o1); }
          else { float* d = out + (smp ? O_IKS : O_IKP) + (size_t)orow * 64 + lr; d[0] = o0; d[32] = o1; }
        } else if (vg < 48) {
          float* d = out + (smp ? O_AVS : O_AVP) + (size_t)orow * 1024 + (vg - 32) * 64 + lr; d[0] = v0; d[32] = v1;
        } else if (vg < 80) {
          const int q = vg < 64 ? vg - 48 : vg - 64; const int hh = q >> 1, gi = q & 1;
          const float2 cs = tab[pos * 64 + gi * 32 + lr];
          const float o0 = v0 * cs.x - v1 * cs.y, o1 = v1 * cs.x + v0 * cs.y;
          if (vg < 64) { u16* d = BQ + (size_t)row * 1024 + hh * 128 + gi * 32 + lr; d[0] = f2bf(o0 * QB_SCALE); d[64] = f2bf(o1 * QB_SCALE); }
          else { float* d = out + (smp ? O_BKS : O_BKP) + (size_t)orow * 1024 + hh * 128 + gi * 32 + lr; d[0] = o0; d[64] = o1; }
        } else if (vg < 96) {
          float* d = out + (smp ? O_BVS : O_BVP) + (size_t)orow * 1024 + (vg - 80) * 64 + lr; d[0] = v0; d[32] = v1;
        } else if (vg == 105) {
          if (lr < 8) IW[(size_t)row * 8 + lr] = v0 * IW_SCALE;
        } else {
          u16* d = G + (size_t)row * 2048 + (vg - 106) * 64 + lr;
          d[0] = f2bf(1.0f / (1.0f + __expf(-v0))); d[32] = f2bf(1.0f / (1.0f + __expf(-v1)));
        }
      }
  }
}

DI void phase_merge(const Params& p, char* smem) {
  const u16* OA = (const u16*)(p.ws + OFF_OA); const u16* OB = (const u16*)(p.ws + OFF_OB);
  const u16* WA = (const u16*)(p.ws + OFF_WA); const u16* WB = (const u16*)(p.ws + OFF_WB);
  const u16* G = (const u16*)(p.ws + OFF_G);
  u16* MB = (u16*)(p.ws + OFF_MB);
  const int t = threadIdx.x, lane = t & 63, w = t >> 6, wm = w >> 1, wn = w & 1, lr = lane & 31, lh = lane >> 5;
  for (int tile = blockIdx.x; tile < NT_M * 8; tile += gridDim.x) {
    const int m0 = (tile >> 3) * 128, n0 = (tile & 7) * 128;
    f32x16 acc[2][2], acc2[2][2]; zero_acc(acc); zero_acc(acc2);
    gemm_mainloop(OA, 1024, WA, 1024, 1024, m0, n0, (u16*)smem, acc);
    gemm_mainloop(OB, 1024, WB, 1024, 1024, m0, n0, (u16*)smem, acc2);
#pragma unroll
    for (int mi = 0; mi < 2; ++mi)
#pragma unroll
      for (int i = 0; i < 16; ++i) {
        const int row = m0 + wm * 64 + mi * 32 + crow(i, lh);
        if (row >= T) continue;
#pragma unroll
        for (int ni = 0; ni < 2; ++ni) {
          const int col = n0 + wn * 64 + ni * 32 + lr;
          const float sa = __uint_as_float((unsigned)G[(size_t)row * 2048 + col] << 16);
          const float sb = __uint_as_float((unsigned)G[(size_t)row * 2048 + 1024 + col] << 16);
          MB[(size_t)row * 1024 + col] = f2bf(sa * acc[mi][ni][i] + sb * acc2[mi][ni][i]);
        }
      }
  }
}

template <int MODE>
DI void attn_item(const Params& p, char* smem, int grp, int b, int h, int q0, int nqv, float lam) {
  int t_ = threadIdx.x;
  asm volatile("" : "+v"(t_));
  const int t = t_, lane = t & 63, w = __builtin_amdgcn_readfirstlane(t >> 6), lr = lane & 31, lh = lane >> 5;
  u16* Ks = (u16*)smem;
  u16* Vt = Ks + 64 * 136;
  u16* Qs = Vt + 128 * 72;
  constexpr int NQB = MODE == 0 ? 64 : 128;
  constexpr int KS = MODE == 0 ? 4 : 8;
  const int NK = grp ? NKS : NTOKP;
  const int qsub = MODE == 0 ? (w >> 1) : w;
  const int map = MODE == 0 ? (w & 1) : 0;
  const int qw0 = q0 + qsub * 32;
  const bool wact = (qsub * 32) < nqv;
  int Lw = 0;
  if (wact) Lw = grp ? NKS : (qw0 < 16 ? 16 : 16 + 64 * (((qw0 - 16) >> 6) + 1));
  const int tql = q0 + nqv - 1;
  const int Lblk = grp ? NKS : (tql < 16 ? 16 : 16 + 64 * (((tql - 16) >> 6) + 1));
  const int nkt = (Lblk + 63) >> 6;
  const int ql = qsub * 32 + lr;
  const int tq = q0 + (ql < nqv ? ql : nqv - 1);
  const size_t gr = grp ? (size_t)TP + b * 32 + tq : (size_t)b * NTOKP + tq;
  __syncthreads();
  {
    const u16* Qg = (const u16*)(p.ws + (MODE == 0 ? OFF_AQ : OFF_BQ));
#pragma unroll
    for (int i = 0; i < NQB / 16; ++i) {
      const int c = t + 256 * i; const int q = c >> 4, ch = c & 15;
      const int tqq = q0 + (q < nqv ? q : nqv - 1);
      const size_t grq = grp ? (size_t)TP + b * 32 + tqq : (size_t)b * NTOKP + tqq;
      *(uint4*)(Qs + q * 136 + ch * 8) = *(const uint4*)(Qg + grq * 1024 + h * 128 + ch * 8);
    }
  }
  const u16* Qw = Qs + ql * 136 + map * 64 + lh * 8;
  const u64* mrow = nullptr;
  if (MODE == 1) mrow = grp ? (const u64*)(p.ws + OFF_MASKS) + ((size_t)b * 32 + tq) * NWS : (const u64*)(p.ws + OFF_MASKP) + gr * NWP;
  f32x16 O[4];
  float mrun = -1e30f, lrun = 0.f;
#pragma unroll
  for (int db = 0; db < 4; ++db)
#pragma unroll
    for (int i = 0; i < 16; ++i) O[db][i] = 0.f;
  const int kwhich = MODE == 0 ? 0 : 2;
  for (int kt = 0; kt < nkt; ++kt) {
    __syncthreads();
#pragma unroll
    for (int i = 0; i < 8; ++i) {
      const int c = t + 256 * i; const int key = c >> 5, d4 = c & 31;
      int tk = kt * 64 + key; tk = tk < NK ? tk : NK - 1;
      const float4 v = *(const float4*)(kv_row(p, grp, b, tk, kwhich) + h * 128 + d4 * 4);
      *(uint2*)(Ks + key * 136 + d4 * 4) = make_uint2(pack2(v.x, v.y), pack2(v.z, v.w));
    }
    __builtin_amdgcn_sched_barrier(0);
#pragma unroll
    for (int i = 0; i < 2; ++i) {
      const int c = t + 256 * i; const int kq = c >> 5, d4 = c & 31;
      float4 x[4];
#pragma unroll
      for (int j = 0; j < 4; ++j) {
        int tk = kt * 64 + kq * 4 + j; tk = tk < NK ? tk : NK - 1;
        x[j] = *(const float4*)(kv_row(p, grp, b, tk, kwhich + 1) + h * 128 + d4 * 4);
      }
      u16* vd = Vt + (d4 * 4) * 72 + kq * 4;
      *(uint2*)(vd) = make_uint2(pack2(x[0].x, x[1].x), pack2(x[2].x, x[3].x));
      *(uint2*)(vd + 72) = make_uint2(pack2(x[0].y, x[1].y), pack2(x[2].y, x[3].y));
      *(uint2*)(vd + 144) = make_uint2(pack2(x[0].z, x[1].z), pack2(x[2].z, x[3].z));
      *(uint2*)(vd + 216) = make_uint2(pack2(x[0].w, x[1].w), pack2(x[2].w, x[3].w));
    }
    __builtin_amdgcn_sched_barrier(0);
    __syncthreads();
    if (wact && kt * 64 < Lw) {
      f32x16 st0, st1;
#pragma unroll
      for (int i = 0; i < 16; ++i) { st0[i] = 0.f; st1[i] = 0.f; }
#pragma unroll
      for (int ks = 0; ks < KS; ++ks) {
        const bf16x8 k0 = *(const bf16x8*)(Ks + lr * 136 + map * 64 + ks * 16 + lh * 8);
        const bf16x8 k1 = *(const bf16x8*)(Ks + (32 + lr) * 136 + map * 64 + ks * 16 + lh * 8);
        const bf16x8 qf = *(const bf16x8*)(Qw + ks * 16);
        st0 = MFMA(k0, qf, st0);
        st1 = MFMA(k1, qf, st1);
      }
      if (MODE == 0) {
        if (kt * 64 + 64 > Lw) {
#pragma unroll
          for (int i = 0; i < 16; ++i) {
            const int key = kt * 64 + crow(i, lh);
            if (key >= Lw) st0[i] = -INFINITY;
            if (key + 32 >= Lw) st1[i] = -INFINITY;
          }
        }
      } else {
        const u64 mw = mrow[kt];
        const unsigned lo = (unsigned)mw >> (4 * lh), hi = (unsigned)(mw >> 32) >> (4 * lh);
#pragma unroll
        for (int i = 0; i < 16; ++i) {
          const int bit = (i & 3) + 8 * (i >> 2);
          if (!((lo >> bit) & 1u)) st0[i] = -INFINITY;
          if (!((hi >> bit) & 1u)) st1[i] = -INFINITY;
        }
      }
      float tmax = -INFINITY;
#pragma unroll
      for (int i = 0; i < 16; ++i) tmax = fmaxf(tmax, fmaxf(st0[i], st1[i]));
      tmax = fmaxf(tmax, shx(tmax, 32));
      const float mnew = fmaxf(mrun, tmax);
      const float alpha = fexp2(mrun - mnew);
      mrun = mnew;
      float ps = 0.f;
#pragma unroll
      for (int i = 0; i < 16; ++i) {
        st0[i] = fexp2(st0[i] - mnew); st1[i] = fexp2(st1[i] - mnew);
        ps += st0[i] + st1[i];
      }
      lrun = lrun * alpha + ps;
#pragma unroll
      for (int db = 0; db < 4; ++db)
#pragma unroll
        for (int i = 0; i < 16; ++i) O[db][i] *= alpha;
      bf16x8 pf[4];
#pragma unroll
      for (int c = 0; c < 4; ++c) {
        bf16x8 pk;
#pragma unroll
        for (int j = 0; j < 8; ++j) pk[j] = (short)f2bf((c < 2) ? st0[(c & 1) * 8 + j] : st1[(c & 1) * 8 + j]);
        pf[c] = pk;
      }
#pragma unroll
      for (int db = 0; db < 4; ++db)
#pragma unroll
        for (int c = 0; c < 4; ++c) {
          const int kk = (c >> 1) * 32 + (c & 1) * 16 + 4 * lh;
          const bf16x4 v0 = *(const bf16x4*)(Vt + (db * 32 + lr) * 72 + kk);
          const bf16x4 v1 = *(const bf16x4*)(Vt + (db * 32 + lr) * 72 + kk + 8);
          const bf16x8 vf = __builtin_shufflevector(v0, v1, 0, 1, 2, 3, 4, 5, 6, 7);
          O[db] = MFMA(vf, pf[c], O[db]);
        }
    }
  }
  const float ltot = lrun + shx(lrun, 32);
  const float inv = 1.0f / ltot;
  const bool qok = ql < nqv;
  if (MODE == 0) {
    float* Ex = (float*)smem;
    __syncthreads();
    if (map == 1) {
      const float sc = inv * lam;
#pragma unroll
      for (int db = 0; db < 4; ++db)
#pragma unroll
        for (int i = 0; i < 16; ++i) Ex[(qsub * 128 + db * 32 + crow(i, lh)) * 33 + lr] = O[db][i] * sc;
    }
    __syncthreads();
    if (map == 0) {
      float ss = 0.f;
#pragma unroll
      for (int db = 0; db < 4; ++db)
#pragma unroll
        for (int i = 0; i < 16; ++i) {
          const float v = O[db][i] * inv - Ex[(qsub * 128 + db * 32 + crow(i, lh)) * 33 + lr];
          O[db][i] = v; ss += v * v;
        }
      ss += shx(ss, 32);
      const float rn = rsqrtf(ss * (1.0f / 128.0f) + EPS) * 0.8f;
      const float* sub = p.in[18];
      u16* dst = (u16*)(p.ws + OFF_OA) + gr * 1024 + h * 128;
      if (wact && qok) {
#pragma unroll
        for (int db = 0; db < 4; ++db)
#pragma unroll
          for (int g = 0; g < 4; ++g) {
            const int d = db * 32 + 8 * g + 4 * lh;
            const float4 sg = *(const float4*)(sub + d);
            *(uint2*)(dst + d) = make_uint2(pack2(O[db][4 * g] * rn * sg.x, O[db][4 * g + 1] * rn * sg.y),
                                            pack2(O[db][4 * g + 2] * rn * sg.z, O[db][4 * g + 3] * rn * sg.w));
          }
      }
    }
  } else {
    u16* dst = (u16*)(p.ws + OFF_OB) + gr * 1024 + h * 128;
    if (wact && qok) {
#pragma unroll
      for (int db = 0; db < 4; ++db)
#pragma unroll
        for (int g = 0; g < 4; ++g) {
          const int d = db * 32 + 8 * g + 4 * lh;
          *(uint2*)(dst + d) = make_uint2(pack2(O[db][4 * g] * inv, O[db][4 * g + 1] * inv),
                                          pack2(O[db][4 * g + 2] * inv, O[db][4 * g + 3] * inv));
        }
    }
  }
}

DI unsigned ford(float f) { unsigned u = __float_as_uint(f); return u ^ ((u >> 31) ? 0xFFFFFFFFu : 0x80000000u); }

DI void idx_item(const Params& p, char* smem, int grp, int b, int cidx) {
  int t_ = threadIdx.x;
  asm volatile("" : "+v"(t_));
  const int t = t_, lane = t & 63, w = __builtin_amdgcn_readfirstlane(t >> 6), lr = lane & 31, lh = lane >> 5;
  u16* IQs = (u16*)smem;
  u16* IKs = IQs + 64 * 520;
  float* IWs = (float*)(smem + 66560 + 9216);
  float* SCb = (float*)(p.ws + OFF_SC);
  int q0, nqv, L, Lpad, NK; float* SC;
  if (!grp) {
    NK = NTOKP;
    if (cidx == 0) { q0 = 0; nqv = 16; L = 16; Lpad = 64; SC = SCb + SC_META + (size_t)b * 4096; }
    else { const int c = cidx - 1; q0 = 16 + 64 * c; nqv = 64; L = 80 + 64 * c; Lpad = 64 * (c + 2); SC = SCb + (size_t)b * SC_BSTRIDE + 4096ull * (size_t)(c * (c + 3) / 2); }
  } else { NK = NKS; q0 = 0; nqv = 32; L = NKS; Lpad = 2112; SC = SCb + SC_SAMP + (size_t)b * 64 * 2112; }
  const int nkt = (L + 63) >> 6;
  const u16* IQg = (const u16*)(p.ws + OFF_IQ);
  const float* IWg = (const float*)(p.ws + OFF_IW);
  __syncthreads();
#pragma unroll 4
  for (int i = 0; i < 16; ++i) {
    const int c = t + 256 * i; const int q = c >> 6, ch = c & 63;
    const int tq = q0 + (q < nqv ? q : nqv - 1);
    const size_t gr = grp ? (size_t)TP + b * 32 + tq : (size_t)b * NTOKP + tq;
    *(uint4*)(IQs + q * 520 + ch * 8) = *(const uint4*)(IQg + gr * 512 + ch * 8);
  }
#pragma unroll
  for (int i = 0; i < 2; ++i) {
    const int e = t + 256 * i; const int q = e >> 3, hd = e & 7;
    const int tq = q0 + (q < nqv ? q : nqv - 1);
    const size_t gr = grp ? (size_t)TP + b * 32 + tq : (size_t)b * NTOKP + tq;
    IWs[e] = IWg[gr * 8 + hd];
  }
  const int wq = w >> 1, wk = w & 1;
  for (int kt = 0; kt < nkt; ++kt) {
    __syncthreads();
#pragma unroll
    for (int i = 0; i < 4; ++i) {
      const int c = t + 256 * i; const int key = c >> 4, d4 = c & 15;
      int tk = kt * 64 + key; tk = tk < NK ? tk : NK - 1;
      const float4 v = *(const float4*)(ik_row(p, grp, b, tk) + d4 * 4);
      *(uint2*)(IKs + key * 72 + d4 * 4) = make_uint2(pack2(v.x, v.y), pack2(v.z, v.w));
    }
    __syncthreads();
    bf16x8 kf[4];
#pragma unroll
    for (int ks = 0; ks < 4; ++ks) kf[ks] = *(const bf16x8*)(IKs + (wk * 32 + lr) * 72 + ks * 16 + lh * 8);
    float sc[16];
#pragma unroll
    for (int i = 0; i < 16; ++i) sc[i] = 0.f;
#pragma unroll
    for (int hd = 0; hd < 8; ++hd) {
      f32x16 st;
#pragma unroll
      for (int i = 0; i < 16; ++i) st[i] = 0.f;
#pragma unroll
      for (int ks = 0; ks < 4; ++ks) {
        const bf16x8 qfr = *(const bf16x8*)(IQs + (wq * 32 + lr) * 520 + hd * 64 + ks * 16 + lh * 8);
        st = MFMA(kf[ks], qfr, st);
      }
      const float wv = IWs[(wq * 32 + lr) * 8 + hd];
#pragma unroll
      for (int i = 0; i < 16; ++i) sc[i] += wv * fmaxf(st[i], 0.f);
    }
    float* srow = SC + (size_t)(wq * 32 + lr) * Lpad + kt * 64 + wk * 32 + 4 * lh;
#pragma unroll
    for (int g = 0; g < 4; ++g) *(float4*)(srow + 8 * g) = make_float4(sc[4 * g], sc[4 * g + 1], sc[4 * g + 2], sc[4 * g + 3]);
  }
  __threadfence();
  __syncthreads();
  for (int j = 0; j < 16; ++j) {
    const int q = w * 16 + j;
    if (q >= nqv) break;
    const int tq = q0 + q;
    u64* mrow = grp ? (u64*)(p.ws + OFF_MASKS) + ((size_t)b * 32 + tq) * NWS : (u64*)(p.ws + OFF_MASKP) + ((size_t)b * NTOKP + tq) * NWP;
    if (L <= 256) {
      for (int i = 0; i < nkt; ++i) {
        const u64 wd = __ballot(i * 64 + lane < L);
        if (lane == 0) mrow[i] = wd;
      }
      continue;
    }
    const unsigned* srow = (const unsigned*)(SC + (size_t)q * Lpad);
    int Lr = L;
    asm volatile("" : "+v"(Lr));
    int nkr = nkt;
    asm volatile("" : "+s"(nkr));
    int lanev = lane;
    asm volatile("" : "+v"(lanev));
    unsigned v[129];
#pragma unroll
    for (int g = 0; g < 17; ++g) {
      if (g * 8 < nkt) {
#pragma unroll
        for (int jj = 0; jj < 8; ++jj) {
          const int i = g * 8 + jj; if (i >= 129) continue; const int key = i * 64 + lanev;
          const unsigned u = ford(__uint_as_float(__hip_atomic_load(srow + key, __ATOMIC_RELAXED, __HIP_MEMORY_SCOPE_AGENT)));
          v[i] = key < Lr ? u : 0u;
        }
        __builtin_amdgcn_sched_barrier(0);
      } else {
#pragma unroll
        for (int jj = 0; jj < 8; ++jj) if (g * 8 + jj < 129) v[g * 8 + jj] = 0u;
      }
    }
    unsigned Tt = 0u;
    for (int bit = 31; bit >= 0; --bit) {
      const unsigned cand = Tt | (1u << bit);
      int cnt = 0;
#pragma unroll
      for (int g = 0; g < 17; ++g) {
        if (g * 8 < nkt) {
#pragma unroll
          for (int jj = 0; jj < 8; ++jj) if (g * 8 + jj < 129) cnt += (v[g * 8 + jj] >= cand) ? 1 : 0;
          __builtin_amdgcn_sched_barrier(0);
        }
      }
#pragma unroll
      for (int m = 32; m >= 1; m >>= 1) cnt += __shfl_xor(cnt, m, 64);
      if (cnt >= 256) Tt = cand;
    }
    int cgt = 0;
#pragma unroll
    for (int g = 0; g < 17; ++g) {
      if (g * 8 < nkt) {
#pragma unroll
        for (int jj = 0; jj < 8; ++jj) if (g * 8 + jj < 129) cgt += (v[g * 8 + jj] > Tt) ? 1 : 0;
        __builtin_amdgcn_sched_barrier(0);
      }
    }
#pragma unroll
    for (int m = 32; m >= 1; m >>= 1) cgt += __shfl_xor(cgt, m, 64);
    const int need = 256 - cgt;
    int run = 0;
    const u64 lmask = (1ull << lane) - 1ull;
#pragma unroll
    for (int g = 0; g < 17; ++g) {
      if (g * 8 < nkt) {
#pragma unroll
        for (int jj = 0; jj < 8; ++jj) {
          const int i = g * 8 + jj; if (i >= 129) continue;
          const bool eq = v[i] == Tt;
          const u64 em = __ballot(eq);
          const int pre = run + __popcll(em & lmask);
          const bool sel = (v[i] > Tt) || (eq && pre < need);
          run += __popcll(em);
          const u64 wd = __ballot(sel);
          if (i < nkr) { if (lane == 0) mrow[i] = wd; }
          __builtin_amdgcn_sched_barrier(0);
        }
      }
    }
  }
}

DI int next_item(unsigned* cnt, int* s_item) {
  __syncthreads();
  if (threadIdx.x == 0) *s_item = (int)atomicAdd(cnt, 1u);
  __syncthreads();
  return *s_item;
}

DI void phase_attn_a(const Params& p, char* smem) {
  unsigned* cnt = (unsigned*)(p.ws + OFF_CNT);
  int* s_item = (int*)(smem + 77824);
  float lam;
  {
    const int lane = threadIdx.x & 63;
    float a = p.in[14][lane] * p.in[15][lane], c = p.in[16][lane] * p.in[17][lane];
#pragma unroll
    for (int m = 32; m >= 1; m >>= 1) { a += shx(a, m); c += shx(c, m); }
    lam = expf(a) - expf(c) + 0.2f;
  }
  while (true) {
    const int it = next_item(cnt, s_item);
    if (it >= 274 + 2064 + 128) break;
#ifndef NO_IDX
    if (it < 258) idx_item(p, smem, 0, it & 1, 128 - (it >> 1));
    else if (it < 274) idx_item(p, smem, 1, it - 258, 0);
#else
    if (it < 274) {}
#endif
#ifndef NO_DIFF
    else if (it < 274 + 2064) {
      const int j = it - 274; const int ci = 128 - j / 16, bh = j & 15;
      attn_item<0>(p, smem, 0, bh >> 3, bh & 7, ci == 0 ? 0 : 16 + (ci - 1) * 64, ci == 0 ? 16 : 64, lam);
    } else {
      const int j = it - (274 + 2064);
      attn_item<0>(p, smem, 1, j >> 3, j & 7, 0, 32, lam);
    }
#endif
  }
}

DI void phase_attn_b(const Params& p, char* smem) {
  unsigned* cnt = (unsigned*)(p.ws + OFF_CNT) + 1;
  int* s_item = (int*)(smem + 77824);
  while (true) {
    const int it = next_item(cnt, s_item);
    if (it >= 1040 + 128) break;
    if (it < 1040) {
      const int qt = 64 - it / 16, bh = it & 15;
      attn_item<1>(p, smem, 0, bh >> 3, bh & 7, qt == 0 ? 0 : 16 + (qt - 1) * 128, qt == 0 ? 16 : 128, 0.f);
    } else {
      const int j = it - 1040;
      attn_item<1>(p, smem, 1, j >> 3, j & 7, 0, 32, 0.f);
    }
  }
}

DI void phase_final(const Params& p) {
  const int t = threadIdx.x, lane = t & 63;
  const int wv = blockIdx.x * 4 + (t >> 6), nw = gridDim.x * 4;
  const float* xf = (const float*)(p.ws + OFF_XF);
  const float* ssp = (const float*)(p.ws + OFF_SSP3);
  const float4* gf = (const float4*)p.in[26];
  for (int row = wv; row < T; row += nw) {
    float* dst;
    if (row < TP) {
      const int b = row >= NTOKP ? 1 : 0; const int tok = row - b * NTOKP;
      if (tok < 16) continue;
      dst = p.out + O_YP + ((size_t)b * 8192 + (tok - 16)) * 1024;
    } else dst = p.out + O_YS + (size_t)(row - TP) * 1024;
    float s = 0.f;
#pragma unroll
    for (int i = 0; i < 16; ++i) s += ssp[(size_t)row * 16 + i];
    const float r = rsqrtf(s * (1.0f / 1024.0f) + EPS);
#pragma unroll
    for (int i = 0; i < 4; ++i) {
      const float4 v = ((const float4*)(xf + (size_t)row * 1024))[lane + 64 * i];
      const float4 g = gf[lane + 64 * i];
      ((float4*)dst)[lane + 64 * i] = make_float4(v.x * r * g.x, v.y * r * g.y, v.z * r * g.z, v.w * r * g.w);
    }
  }
}

#ifndef PHM
#define PHM 0x7ff
#endif
#define PHON(n) ((PHM >> n) & 1)
__global__ void __launch_bounds__(256, 2) mega(Params p) {
  extern __shared__ __attribute__((aligned(16))) char smem[];
  cg::grid_group grid = cg::this_grid();
  if (PHON(0)) phase_prep(p, smem);
  grid.sync();
  if (PHON(1)) phase_gateup(p, smem, OFF_SSP0, OFF_WGU1);
  grid.sync();
  if (PHON(2)) phase_resid<1>(p, smem, (const u16*)(p.ws + OFF_HID), 2816, 2816, OFF_WD1, 0.5f, OFF_SSP1);
  grid.sync();
  if (PHON(3)) phase_win(p, smem);
  grid.sync();
  if (PHON(4)) phase_attn_a(p, smem);
  grid.sync();
  if (PHON(5)) phase_attn_b(p, smem);
  grid.sync();
  if (PHON(6)) phase_merge(p, smem);
  grid.sync();
  if (PHON(7)) phase_resid<0>(p, smem, (const u16*)(p.ws + OFF_MB), 1024, 1024, OFF_WO, 1.0f, OFF_SSP2);
  grid.sync();
  if (PHON(8)) phase_gateup(p, smem, OFF_SSP2, OFF_WGU2);
  grid.sync();
  if (PHON(9)) phase_resid<0>(p, smem, (const u16*)(p.ws + OFF_HID), 2816, 2816, OFF_WD2, 0.5f, OFF_SSP3);
  grid.sync();
  if (PHON(10)) phase_final(p);
}

extern "C" void kernel_launch(void* const* d_in, const int* in_sizes, int n_in, void* d_out, int out_size, void* d_ws,
                              size_t ws_size, hipStream_t stream) {
  Params p{};
  for (int i = 0; i < 27; ++i) p.in[i] = (const float*)d_in[i];
  p.out = (float*)d_out;
  p.ws = (char*)d_ws;
  static int grid_blocks = 0;
  if (!grid_blocks) {
    hipFuncSetAttribute((const void*)mega, hipFuncAttributeMaxDynamicSharedMemorySize, SMEM_BYTES);
    int dev = 0, cus = 0, per_cu = 0;
    hipGetDevice(&dev);
    hipDeviceGetAttribute(&cus, hipDeviceAttributeMultiprocessorCount, dev);
    hipOccupancyMaxActiveBlocksPerMultiprocessor(&per_cu, mega, 256, SMEM_BYTES);
    if (per_cu > 2) per_cu = 2;
    if (per_cu < 1) per_cu = 1;
    grid_blocks = cus * per_cu;
  }
  if (ws_size < WS_END) fprintf(stderr, "workspace too small: %zu < %zu\n", ws_size, (size_t)WS_END);
  void* args[] = {&p};
  hipError_t e = hipLaunchCooperativeKernel((void*)mega, dim3(grid_blocks), dim3(256), args, SMEM_BYTES, stream);
  if (e != hipSuccess) fprintf(stderr, "cooperative launch failed: %s (grid %d)\n", hipGetErrorString(e), grid_blocks);
}
```

```cpp
#include <hip/hip_runtime.h>
#include <hip/hip_cooperative_groups.h>
#include <stdint.h>
#include <cstdio>
namespace cg = cooperative_groups;

typedef __attribute__((ext_vector_type(8))) short bf16x8;
typedef __attribute__((ext_vector_type(4))) short bf16x4;
typedef __attribute__((ext_vector_type(16))) float f32x16;
typedef unsigned short u16;
typedef unsigned long long u64;
#define MFMA(a, b, c) __builtin_amdgcn_mfma_f32_32x32x16_bf16((a), (b), (c), 0, 0, 0)
#define DI __device__ __forceinline__

constexpr int NTOKP = 8208;
constexpr int TP = 2 * NTOKP;
constexpr int TS = 512;
constexpr int T = TP + TS;
constexpr int TPAD = 17024;
constexpr int NT_M = 133;
constexpr int NCACHE = 2064;
constexpr int NKS = 2096;
constexpr int NWP = 129;
constexpr int NWS = 33;
constexpr float EPS = 1e-6f;
constexpr float LOG2E = 1.4426950408889634f;
constexpr float QA_SCALE = 0.125f * LOG2E;
constexpr float QB_SCALE = 0.08838834764831845f * LOG2E;
constexpr float IW_SCALE = 0.125f * 0.35355339059327373f;

constexpr size_t O_YP = 0;
constexpr size_t O_YS = O_YP + 2ull * 8192 * 1024;
constexpr size_t O_AKP = O_YS + 512ull * 1024;
constexpr size_t SZ_NEWP = (size_t)TP * 1024;
constexpr size_t O_AVP = O_AKP + SZ_NEWP;
constexpr size_t O_BKP = O_AVP + SZ_NEWP;
constexpr size_t O_BVP = O_BKP + SZ_NEWP;
constexpr size_t O_IKP = O_BVP + SZ_NEWP;
constexpr size_t O_AKS = O_IKP + (size_t)TP * 64;
constexpr size_t SZ_NEWS = (size_t)TS * 1024;
constexpr size_t O_AVS = O_AKS + SZ_NEWS;
constexpr size_t O_BKS = O_AVS + SZ_NEWS;
constexpr size_t O_BVS = O_BKS + SZ_NEWS;
constexpr size_t O_IKS = O_BVS + SZ_NEWS;

constexpr size_t al256(size_t x) { return (x + 255) & ~size_t(255); }
constexpr size_t SZ_WGU = 5632ull * 1024 * 2, SZ_WD = 1024ull * 2816 * 2, SZ_WIN = 8832ull * 1024 * 2, SZ_WSQ = 1024ull * 1024 * 2;
constexpr int VTPAD = 8256;
constexpr size_t OFF_WA = 0;
constexpr size_t OFF_WB = OFF_WA + SZ_WSQ;
constexpr size_t OFF_WO = OFF_WB + SZ_WSQ;
constexpr size_t OFF_WGU2 = OFF_WO + SZ_WSQ;
constexpr size_t OFF_WD2 = OFF_WGU2 + SZ_WGU;
constexpr size_t OFF_XF = OFF_WD2 + SZ_WD;
constexpr size_t SZ_SSP = (size_t)TPAD * 16 * 4;
constexpr size_t OFF_SSP0 = OFF_XF + (size_t)TPAD * 1024 * 4;
constexpr size_t OFF_SSP1 = OFF_SSP0 + SZ_SSP;
constexpr size_t OFF_SSP2 = OFF_SSP1 + SZ_SSP;
constexpr size_t OFF_SSP3 = OFF_SSP2 + SZ_SSP;
constexpr size_t OFF_TAB = OFF_SSP3 + SZ_SSP;
constexpr size_t OFF_AQ = OFF_TAB + (size_t)NTOKP * 64 * 8;
constexpr size_t OFF_MB = OFF_AQ;
constexpr size_t OFF_BQ = OFF_AQ + (size_t)TPAD * 1024 * 2;
constexpr size_t OFF_IQ = OFF_BQ + (size_t)TPAD * 1024 * 2;
constexpr size_t OFF_IW = OFF_IQ + (size_t)TPAD * 512 * 2;
constexpr size_t OFF_G = OFF_IW + (size_t)TPAD * 8 * 4;
constexpr size_t OFF_OA = OFF_G + (size_t)TPAD * 2048 * 2;
constexpr size_t OFF_MASKP = OFF_OA + (size_t)TPAD * 1024 * 2;
constexpr size_t OFF_MASKS = OFF_MASKP + al256((size_t)TP * NWP * 8);
constexpr size_t OFF_CNT = OFF_MASKS + al256((size_t)TS * NWS * 8);
constexpr size_t OFF_AKB = OFF_CNT + 256;
constexpr size_t OFF_BKB = OFF_AKB + (size_t)TP * 1024 * 2;
constexpr size_t SZ_VT = 2ull * 8 * 128 * VTPAD * 2;
constexpr size_t OFF_AVT = OFF_BKB + (size_t)TP * 1024 * 2;
constexpr size_t OFF_BVT = OFF_AVT + SZ_VT;
constexpr size_t OFF_IKB = OFF_BVT + SZ_VT;
constexpr size_t OFF_DEAD = OFF_IKB + al256((size_t)TP * 64 * 2);
constexpr size_t OFF_WGU1 = OFF_DEAD;
constexpr size_t OFF_WD1 = OFF_WGU1 + SZ_WGU;
constexpr size_t OFF_WIN = OFF_WD1 + SZ_WD;
constexpr size_t OFF_XB = OFF_WIN + SZ_WIN;
constexpr size_t OFF_HID = OFF_XB + (size_t)TPAD * 1024 * 2;
constexpr size_t OFF_OB = OFF_HID + (size_t)TPAD * 2816 * 2;
constexpr size_t OFF_SC = OFF_DEAD;
constexpr size_t SC_BSTRIDE = 4096ull * (128 * 131 / 2);
constexpr size_t SC_META = 2 * SC_BSTRIDE;
constexpr size_t SC_SAMP = SC_META + 2 * 4096;
constexpr size_t SC_FLOATS = SC_SAMP + 16ull * 64 * 2112;
constexpr size_t WS_END = OFF_SC + SC_FLOATS * 4 + 4096;
static_assert(WS_END <= 736544256ull, "workspace budget");
static_assert(OFF_OB + (size_t)TPAD * 1024 * 2 <= WS_END, "dead region fits");

constexpr int SMEM_BYTES = 77824 + 64;

struct Params {
  const float* in[27];
  float* out;
  char* ws;
};

typedef __attribute__((ext_vector_type(2))) float f32x2_t;
typedef __attribute__((ext_vector_type(2))) __bf16 bf16x2_t;
DI unsigned pack2(float a, float b) {
  f32x2_t v = {a, b};
  return __builtin_bit_cast(unsigned, __builtin_convertvector(v, bf16x2_t));
}
DI u16 f2bf(float x) { return (u16)(pack2(x, x) & 0xffffu); }
DI int crow(int i, int h) { return (i & 3) + 8 * (i >> 2) + 4 * h; }
DI float fexp2(float x) { return __builtin_amdgcn_exp2f(x); }
DI float shx(float v, int m) { return __shfl_xor(v, m, 64); }

DI const float* xrow_ptr(const Params& p, int row) {
  if (row < TP) {
    int b = row >= NTOKP ? 1 : 0;
    int tok = row - b * NTOKP;
    if (tok < 16) return p.in[7] + (size_t)tok * 1024;
    return p.in[0] + ((size_t)b * 8192 + (tok - 16)) * 1024;
  }
  return p.in[1] + (size_t)(row - TP) * 1024;
}

DI const float* kv_row(const Params& p, int grp, int b, int tk, int which) {
  if (!grp) return p.out + O_AKP + (size_t)which * SZ_NEWP + ((size_t)b * NTOKP + tk) * 1024;
  if (tk < NCACHE) return (which == 0 ? p.in[2] : which == 1 ? p.in[3] : which == 2 ? p.in[4] : p.in[5]) + ((size_t)b * NCACHE + tk) * 1024;
  return p.out + O_AKS + (size_t)which * SZ_NEWS + ((size_t)b * 32 + (tk - NCACHE)) * 1024;
}
DI const float* ik_row(const Params& p, int grp, int b, int tk) {
  if (!grp) return p.out + O_IKP + ((size_t)b * NTOKP + tk) * 64;
  if (tk < NCACHE) return p.in[6] + ((size_t)b * NCACHE + tk) * 64;
  return p.out + O_IKS + ((size_t)b * 32 + (tk - NCACHE)) * 64;
}

template <int job>
DI void wt_tile(const Params& p, int seg, int kt, float* ts) {
  const int t = threadIdx.x;
  const float* src = nullptr; int ld = 0; const float* gs = nullptr; u16* dst = nullptr; int K = 1024; int nvalid4 = 8;
  switch (job) {
    case 0: case 6: {
      const int j = seg >> 1;
      const float* wg = job == 0 ? p.in[9] : p.in[23]; const float* wu = job == 0 ? p.in[10] : p.in[24];
      src = ((seg & 1) ? wu : wg) + 32 * j; ld = 2816; gs = job == 0 ? p.in[8] : p.in[22];
      dst = (u16*)(p.ws + (job == 0 ? OFF_WGU1 : OFF_WGU2)) + (size_t)seg * 32 * 1024; K = 1024;
    } break;
    case 1: case 7: {
      src = (job == 1 ? p.in[11] : p.in[25]) + 32 * seg; ld = 1024; K = 2816;
      dst = (u16*)(p.ws + (job == 1 ? OFF_WD1 : OFF_WD2)) + (size_t)seg * 32 * 2816;
    } break;
    case 2: {
      const int v0 = seg * 32; int a0;
      if (v0 < 6144) {
        const int ty = v0 >> 10;
        if (ty == 3 || ty == 4) { const int hv = v0 & 127; const int gi = hv >> 6, sub = (hv & 63) >> 5; a0 = (v0 - hv) + gi * 32 + sub * 64; }
        else a0 = v0;
      } else if (v0 < 6720) a0 = v0;
      else if (v0 == 6720) { a0 = 6720; nvalid4 = 2; }
      else if (v0 == 6752) { a0 = 6720; nvalid4 = 0; }
      else a0 = v0 - 56;
      src = p.in[13] + a0; ld = 8776; gs = p.in[12]; K = 1024;
      dst = (u16*)(p.ws + OFF_WIN) + (size_t)v0 * 1024;
    } break;
    default: {
      src = (job == 3 ? p.in[19] : (job == 4 ? p.in[20] : p.in[21])) + 32 * seg; ld = 1024; K = 1024;
      dst = (u16*)(p.ws + (job == 3 ? OFF_WA : (job == 4 ? OFF_WB : OFF_WO))) + (size_t)seg * 32 * 1024;
    } break;
  }
  const int c4 = t & 7, kr = t >> 3;
#pragma unroll
  for (int ps = 0; ps < 4; ++ps) {
    const int kl = ps * 32 + kr; const int k = kt * 128 + kl;
    float4 v = make_float4(0.f, 0.f, 0.f, 0.f);
    if (c4 < nvalid4) v = *(const float4*)(src + (size_t)k * ld + c4 * 4);
    const float s = gs ? gs[k] : 1.0f;
    float* d = ts + kl * 33 + c4 * 4;
    d[0] = v.x * s; d[1] = v.y * s; d[2] = v.z * s; d[3] = v.w * s;
  }
  __syncthreads();
  {
    const int r = t >> 3, kc = t & 7;
    unsigned o[8];
#pragma unroll
    for (int j = 0; j < 8; ++j) o[j] = pack2(ts[(kc * 16 + 2 * j) * 33 + r], ts[(kc * 16 + 2 * j + 1) * 33 + r]);
    uint4* dp = (uint4*)(dst + (size_t)r * K + kt * 128 + kc * 16);
    dp[0] = make_uint4(o[0], o[1], o[2], o[3]);
    dp[1] = make_uint4(o[4], o[5], o[6], o[7]);
  }
  __syncthreads();
}

DI void phase_prep(const Params& p, char* smem) {
  const int t = threadIdx.x, lane = t & 63;
  if (blockIdx.x == 0 && t < 64) ((unsigned*)(p.ws + OFF_CNT))[t] = 0u;
  for (int e = blockIdx.x * 256 + t; e < NTOKP * 64; e += gridDim.x * 256) {
    const int pos = e >> 6, i = e & 63;
    double inv = 1.0;
    for (int j = 0; j < i; ++j) inv *= 0.8659643233600653;
    const float invf = (float)inv;
    const float ang = (float)pos * invf;
    const double a = (double)ang;
    const double qd = rint(a * 0.6366197723675814);
    const double r = (a - qd * 1.5707963267948966) - qd * 6.123233995736766e-17;
    const double r2 = r * r;
    double sn = r2 * (1.0 / 6227020800.0) - 1.0 / 39916800.0;
    sn = sn * r2 + 1.0 / 362880.0; sn = sn * r2 - 1.0 / 5040.0; sn = sn * r2 + 1.0 / 120.0; sn = sn * r2 - 1.0 / 6.0; sn = sn * r2 * r + r;
    double cn = -r2 * (1.0 / 87178291200.0) + 1.0 / 479001600.0;
    cn = cn * r2 - 1.0 / 3628800.0; cn = cn * r2 + 1.0 / 40320.0; cn = cn * r2 - 1.0 / 720.0; cn = cn * r2 + 1.0 / 24.0; cn = cn * r2 - 0.5; cn = cn * r2 + 1.0;
    const int q = ((int)qd) & 3;
    double c, s;
    if (q == 0) { c = cn; s = sn; } else if (q == 1) { c = -sn; s = cn; } else if (q == 2) { c = -cn; s = -sn; } else { c = sn; s = -cn; }
    ((float2*)(p.ws + OFF_TAB))[e] = make_float2((float)c, (float)s);
  }
  for (int e = blockIdx.x * 256 + t; e < 2 * 2048 * 6; e += gridDim.x * 256) {
    const int which = e / (2048 * 6), r = e % (2048 * 6);
    const int row = r / 6, ch = r % 6;
    u16* vt = (u16*)(p.ws + (which ? OFF_BVT : OFF_AVT)) + (size_t)row * VTPAD + NTOKP + ch * 8;
    *(uint4*)vt = make_uint4(0, 0, 0, 0);
  }
  {
    const int wv = blockIdx.x * 4 + (t >> 6), nw = gridDim.x * 4;
    for (int row = wv; row < TPAD; row += nw) {
      u16* xb = (u16*)(p.ws + OFF_XB) + (size_t)row * 1024;
      float* ssp = (float*)(p.ws + OFF_SSP0) + (size_t)row * 16;
      if (row >= T) {
        uint4 z = make_uint4(0, 0, 0, 0);
        ((uint4*)xb)[lane * 2] = z; ((uint4*)xb)[lane * 2 + 1] = z;
        if (lane < 16) ssp[lane] = lane == 0 ? 1024.f : 0.f;
        continue;
      }
      const float4* src = (const float4*)xrow_ptr(p, row);
      float ss = 0.f;
#pragma unroll
      for (int i = 0; i < 4; ++i) {
        const float4 v = src[lane + 64 * i];
        ss += v.x * v.x + v.y * v.y + v.z * v.z + v.w * v.w;
        ((uint2*)xb)[lane + 64 * i] = make_uint2(pack2(v.x, v.y), pack2(v.z, v.w));
      }
#pragma unroll
      for (int m = 32; m >= 1; m >>= 1) ss += shx(ss, m);
      if (lane < 16) ssp[lane] = lane == 0 ? ss : 0.f;
    }
  }
  {
    float* ts = (float*)smem;
    for (int tile = blockIdx.x; tile < 7200; tile += gridDim.x) {
      int job, r = tile;
      if (r < 1408) job = 0;
      else if ((r -= 1408) < 704) job = 1;
      else if ((r -= 704) < 2208) job = 2;
      else if ((r -= 2208) < 256) job = 3;
      else if ((r -= 256) < 256) job = 4;
      else if ((r -= 256) < 256) job = 5;
      else if ((r -= 256) < 1408) job = 6;
      else { r -= 1408; job = 7; }
      const int nkt = (job == 1 || job == 7) ? 22 : 8;
      const int sg = r / nkt, kk = r % nkt;
      switch (job) {
        case 0: wt_tile<0>(p, sg, kk, ts); break;
        case 1: wt_tile<1>(p, sg, kk, ts); break;
        case 2: wt_tile<2>(p, sg, kk, ts); break;
        case 3: wt_tile<3>(p, sg, kk, ts); break;
        case 4: wt_tile<4>(p, sg, kk, ts); break;
        case 5: wt_tile<5>(p, sg, kk, ts); break;
        case 6: wt_tile<6>(p, sg, kk, ts); break;
        default: wt_tile<7>(p, sg, kk, ts); break;
      }
    }
  }
}

DI void gemm_mainloop(const u16* __restrict__ A, int lda, const u16* __restrict__ B, int ldb, int K, int m0, int n0,
                      u16* smem, f32x16 (&acc)[2][2]) {
  u16* As = smem; u16* Bs = smem + 128 * 72;
  const int t = threadIdx.x, lane = t & 63, w = t >> 6, wm = w >> 1, wn = w & 1;
  const int lr = lane & 31, lh = lane >> 5;
  const int lrow = t >> 3, lkc = t & 7;
  const u16* Ap = A + (size_t)(m0 + lrow) * lda + lkc * 8;
  const u16* Bp = B + (size_t)(n0 + lrow) * ldb + lkc * 8;
  uint4 ra0, ra1, ra2, ra3, rb0, rb1, rb2, rb3;
  ra0 = *(const uint4*)(Ap); ra1 = *(const uint4*)(Ap + (size_t)32 * lda); ra2 = *(const uint4*)(Ap + (size_t)64 * lda); ra3 = *(const uint4*)(Ap + (size_t)96 * lda);
  rb0 = *(const uint4*)(Bp); rb1 = *(const uint4*)(Bp + (size_t)32 * ldb); rb2 = *(const uint4*)(Bp + (size_t)64 * ldb); rb3 = *(const uint4*)(Bp + (size_t)96 * ldb);
  for (int k0 = 0; k0 < K; k0 += 64) {
    __syncthreads();
    *(uint4*)(As + (lrow) * 72 + lkc * 8) = ra0; *(uint4*)(As + (lrow + 32) * 72 + lkc * 8) = ra1;
    *(uint4*)(As + (lrow + 64) * 72 + lkc * 8) = ra2; *(uint4*)(As + (lrow + 96) * 72 + lkc * 8) = ra3;
    *(uint4*)(Bs + (lrow) * 72 + lkc * 8) = rb0; *(uint4*)(Bs + (lrow + 32) * 72 + lkc * 8) = rb1;
    *(uint4*)(Bs + (lrow + 64) * 72 + lkc * 8) = rb2; *(uint4*)(Bs + (lrow + 96) * 72 + lkc * 8) = rb3;
    __syncthreads();
    {
      const int kn = (k0 + 64 < K) ? k0 + 64 : k0;
      ra0 = *(const uint4*)(Ap + kn); ra1 = *(const uint4*)(Ap + (size_t)32 * lda + kn); ra2 = *(const uint4*)(Ap + (size_t)64 * lda + kn); ra3 = *(const uint4*)(Ap + (size_t)96 * lda + kn);
      rb0 = *(const uint4*)(Bp + kn); rb1 = *(const uint4*)(Bp + (size_t)32 * ldb + kn); rb2 = *(const uint4*)(Bp + (size_t)64 * ldb + kn); rb3 = *(const uint4*)(Bp + (size_t)96 * ldb + kn);
    }
#pragma unroll
    for (int ks = 0; ks < 4; ++ks) {
      bf16x8 a0 = *(const bf16x8*)(As + (wm * 64 + lr) * 72 + ks * 16 + lh * 8);
      bf16x8 a1 = *(const bf16x8*)(As + (wm * 64 + 32 + lr) * 72 + ks * 16 + lh * 8);
      bf16x8 b0 = *(const bf16x8*)(Bs + (wn * 64 + lr) * 72 + ks * 16 + lh * 8);
      bf16x8 b1 = *(const bf16x8*)(Bs + (wn * 64 + 32 + lr) * 72 + ks * 16 + lh * 8);
      acc[0][0] = MFMA(a0, b0, acc[0][0]);
      acc[0][1] = MFMA(a0, b1, acc[0][1]);
      acc[1][0] = MFMA(a1, b0, acc[1][0]);
      acc[1][1] = MFMA(a1, b1, acc[1][1]);
    }
  }
}

DI void zero_acc(f32x16 (&acc)[2][2]) {
#pragma unroll
  for (int a = 0; a < 2; ++a)
#pragma unroll
    for (int b = 0; b < 2; ++b)
#pragma unroll
      for (int i = 0; i < 16; ++i) acc[a][b][i] = 0.f;
}

DI void load_rs(const float* ssp, int m0, float* rs_s) {
  __syncthreads();
  const int t = threadIdx.x;
  if (t < 128) {
    const float4* q = (const float4*)(ssp + (size_t)(m0 + t) * 16);
    const float4 a = q[0], b = q[1], c = q[2], d = q[3];
    const float s = ((a.x + a.y) + (a.z + a.w)) + ((b.x + b.y) + (b.z + b.w)) + ((c.x + c.y) + (c.z + c.w)) + ((d.x + d.y) + (d.z + d.w));
    rs_s[t] = rsqrtf(s * (1.0f / 1024.0f) + EPS);
  }
}

DI void phase_gateup(const Params& p, char* smem, size_t off_ssp, size_t off_w) {
  const u16* A = (const u16*)(p.ws + OFF_XB);
  const u16* B = (const u16*)(p.ws + off_w);
  const float* ssp = (const float*)(p.ws + off_ssp);
  u16* hid = (u16*)(p.ws + OFF_HID);
  float* rs_s = (float*)(smem + 36864);
  const int t = threadIdx.x, lane = t & 63, w = t >> 6, wm = w >> 1, wn = w & 1, lr = lane & 31, lh = lane >> 5;
  for (int tile = blockIdx.x; tile < NT_M * 44; tile += gridDim.x) {
    const int m0 = (tile / 44) * 128, n0 = (tile % 44) * 128;
    load_rs(ssp, m0, rs_s);
    f32x16 acc[2][2]; zero_acc(acc);
    gemm_mainloop(A, 1024, B, 1024, 1024, m0, n0, (u16*)smem, acc);
    const int hc = ((n0 + wn * 64) >> 1) + lr;
#pragma unroll
    for (int mi = 0; mi < 2; ++mi)
#pragma unroll
      for (int i = 0; i < 16; ++i) {
        const int rl = wm * 64 + mi * 32 + crow(i, lh); const int row = m0 + rl;
        if (row < T) {
          const float r = rs_s[rl];
          const float g = acc[mi][0][i] * r, u = acc[mi][1][i] * r;
          const float hv = g / (1.0f + __expf(-g)) * u;
          hid[(size_t)row * 2816 + hc] = f2bf(hv);
        }
      }
  }
}

template <int RESID_ORIG>
DI void phase_resid(const Params& p, char* smem, const u16* A, int lda, int K, size_t off_w, float factor, size_t off_ssp_out) {
  const u16* B = (const u16*)(p.ws + off_w);
  float* xf = (float*)(p.ws + OFF_XF);
  u16* xb = (u16*)(p.ws + OFF_XB);
  float* sspo = (float*)(p.ws + off_ssp_out);
  const int t = threadIdx.x, lane = t & 63, w = t >> 6, wm = w >> 1, wn = w & 1, lr = lane & 31, lh = lane >> 5;
  for (int tile = blockIdx.x; tile < NT_M * 8; tile += gridDim.x) {
    const int m0 = (tile >> 3) * 128, nt = tile & 7, n0 = nt * 128;
    f32x16 acc[2][2]; zero_acc(acc);
    gemm_mainloop(A, lda, B, K, K, m0, n0, (u16*)smem, acc);
#pragma unroll
    for (int mi = 0; mi < 2; ++mi)
#pragma unroll
      for (int i = 0; i < 16; ++i) {
        const int rl = wm * 64 + mi * 32 + crow(i, lh); const int row = m0 + rl;
        const bool ok = row < T;
        float part = 0.f;
        if (ok) {
          const float* rsrc = RESID_ORIG ? xrow_ptr(p, row) : (xf + (size_t)row * 1024);
#pragma unroll
          for (int ni = 0; ni < 2; ++ni) {
            const int col = n0 + wn * 64 + ni * 32 + lr;
            const float v = rsrc[col] + factor * acc[mi][ni][i];
            xf[(size_t)row * 1024 + col] = v;
            xb[(size_t)row * 1024 + col] = f2bf(v);
            part += v * v;
          }
        }
        part += shx(part, 16); part += shx(part, 8); part += shx(part, 4); part += shx(part, 2); part += shx(part, 1);
        if (ok && lr == 0) sspo[(size_t)row * 16 + nt * 2 + wn] = part;
      }
  }
}

DI void phase_win(const Params& p, char* smem) {
  const u16* A = (const u16*)(p.ws + OFF_XB);
  const u16* B = (const u16*)(p.ws + OFF_WIN);
  const float* ssp = (const float*)(p.ws + OFF_SSP1);
  const float2* tab = (const float2*)(p.ws + OFF_TAB);
  u16* AQ = (u16*)(p.ws + OFF_AQ); u16* BQ = (u16*)(p.ws + OFF_BQ); u16* IQ = (u16*)(p.ws + OFF_IQ);
  float* IW = (float*)(p.ws + OFF_IW); u16* G = (u16*)(p.ws + OFF_G);
  float* out = p.out;
  float* rs_s = (float*)(smem + 36864);
  const int t = threadIdx.x, lane = t & 63, w = t >> 6, wm = w >> 1, wn = w & 1, lr = lane & 31, lh = lane >> 5;
  for (int tile = blockIdx.x; tile < NT_M * 69; tile += gridDim.x) {
    const int m0 = (tile / 69) * 128, n0 = (tile % 69) * 128;
    load_rs(ssp, m0, rs_s);
    f32x16 acc[2][2]; zero_acc(acc);
    gemm_mainloop(A, 1024, B, 1024, 1024, m0, n0, (u16*)smem, acc);
    const int vg = (n0 >> 6) + wn;
    if ((vg >= 32 && vg < 48) || (vg >= 80 && vg < 96)) {
      const int q = vg < 48 ? vg - 32 : vg - 80;
      u16* vtb = (u16*)(p.ws + (vg < 48 ? OFF_AVT : OFF_BVT));
#pragma unroll
      for (int mi = 0; mi < 2; ++mi)
#pragma unroll
        for (int g = 0; g < 4; ++g) {
          const int rl = wm * 64 + mi * 32 + 8 * g + 4 * lh; const int row = m0 + rl;
          if (row < TP) {
            const int bb = row >= NTOKP ? 1 : 0; const int tok = row - bb * NTOKP;
            const float r0 = rs_s[rl], r1 = rs_s[rl + 1], r2 = rs_s[rl + 2], r3 = rs_s[rl + 3];
#pragma unroll
            for (int ni = 0; ni < 2; ++ni) {
              const int d = (q & 1) * 64 + ni * 32 + lr;
              u16* dst = vtb + ((size_t)(bb * 8 + (q >> 1)) * 128 + d) * VTPAD + tok;
              *(uint2*)dst = make_uint2(pack2(acc[mi][ni][4 * g] * r0, acc[mi][ni][4 * g + 1] * r1),
                                        pack2(acc[mi][ni][4 * g + 2] * r2, acc[mi][ni][4 * g + 3] * r3));
            }
          }
        }
    }
#pragma unroll
    for (int mi = 0; mi < 2; ++mi)
#pragma unroll
      for (int i = 0; i < 16; ++i) {
        const int rl = wm * 64 + mi * 32 + crow(i, lh); const int row = m0 + rl;
        if (row >= T) continue;
        const float r = rs_s[rl];
        const float v0 = acc[mi][0][i] * r, v1 = acc[mi][1][i] * r;
        const bool smp = row >= TP;
        const int orow = smp ? row - TP : row;
        const int pos = smp ? (NCACHE + (orow & 31)) : (row >= NTOKP ? row - NTOKP : row);
        if (vg < 32 || (vg >= 96 && vg < 105)) {
          const float2 cs = tab[pos * 64 + 2 * lr];
          const float o0 = v0 * cs.x - v1 * cs.y, o1 = v1 * cs.x + v0 * cs.y;
          if (vg < 16) { u16* d = AQ + (size_t)row * 1024 + vg * 64 + lr; d[0] = f2bf(o0 * QA_SCALE); d[32] = f2bf(o1 * QA_SCALE); }
          else if (vg < 32) {
            float* d = out + (smp ? O_AKS : O_AKP) + (size_t)orow * 1024 + (vg - 16) * 64 + lr; d[0] = o0; d[32] = o1;
            if (!smp) { u16* db = (u16*)(p.ws + OFF_AKB) + (size_t)row * 1024 + (vg - 16) * 64 + lr; db[0] = f2bf(o0); db[32] = f2bf(o1); }
          }
          else if (vg < 104) { u16* d = IQ + (size_t)row * 512 + (vg - 96) * 64 + lr; d[0] = f2bf(o0); d[32] = f2bf(o1); }
          else {
            float* d = out + (smp ? O_IKS : O_IKP) + (size_t)orow * 64 + lr; d[0] = o0; d[32] = o1;
            if (!smp) { u16* db = (u16*)(p.ws + OFF_IKB) + (size_t)row * 64 + lr; db[0] = f2bf(o0); db[32] = f2bf(o1); }
          }
        } else if (vg < 48) {
          float* d = out + (smp ? O_AVS : O_AVP) + (size_t)orow * 1024 + (vg - 32) * 64 + lr; d[0] = v0; d[32] = v1;
        } else if (vg < 80) {
          const int q = vg < 64 ? vg - 48 : vg - 64; const int hh = q >> 1, gi = q & 1;
          const float2 cs = tab[pos * 64 + gi * 32 + lr];
          const float o0 = v0 * cs.x - v1 * cs.y, o1 = v1 * cs.x + v0 * cs.y;
          if (vg < 64) { u16* d = BQ + (size_t)row * 1024 + hh * 128 + gi * 32 + lr; d[0] = f2bf(o0 * QB_SCALE); d[64] = f2bf(o1 * QB_SCALE); }
          else {
            float* d = out + (smp ? O_BKS : O_BKP) + (size_t)orow * 1024 + hh * 128 + gi * 32 + lr; d[0] = o0; d[64] = o1;
            if (!smp) { u16* db = (u16*)(p.ws + OFF_BKB) + (size_t)row * 1024 + hh * 128 + gi * 32 + lr; db[0] = f2bf(o0); db[64] = f2bf(o1); }
          }
        } else if (vg < 96) {
          float* d = out + (smp ? O_BVS : O_BVP) + (size_t)orow * 1024 + (vg - 80) * 64 + lr; d[0] = v0; d[32] = v1;
        } else if (vg == 105) {
          if (lr < 8) IW[(size_t)row * 8 + lr] = v0 * IW_SCALE;
        } else {
          u16* d = G + (size_t)row * 2048 + (vg - 106) * 64 + lr;
          d[0] = f2bf(1.0f / (1.0f + __expf(-v0))); d[32] = f2bf(1.0f / (1.0f + __expf(-v1)));
        }
      }
  }
}

DI void phase_merge(const Params& p, char* smem) {
  const u16* OA = (const u16*)(p.ws + OFF_OA); const u16* OB = (const u16*)(p.ws + OFF_OB);
  const u16* WA = (const u16*)(p.ws + OFF_WA); const u16* WB = (const u16*)(p.ws + OFF_WB);
  const u16* G = (const u16*)(p.ws + OFF_G);
  u16* MB = (u16*)(p.ws + OFF_MB);
  const int t = threadIdx.x, lane = t & 63, w = t >> 6, wm = w >> 1, wn = w & 1, lr = lane & 31, lh = lane >> 5;
  for (int tile = blockIdx.x; tile < NT_M * 8; tile += gridDim.x) {
    const int m0 = (tile >> 3) * 128, n0 = (tile & 7) * 128;
    f32x16 acc[2][2], acc2[2][2]; zero_acc(acc); zero_acc(acc2);
    gemm_mainloop(OA, 1024, WA, 1024, 1024, m0, n0, (u16*)smem, acc);
    gemm_mainloop(OB, 1024, WB, 1024, 1024, m0, n0, (u16*)smem, acc2);
#pragma unroll
    for (int mi = 0; mi < 2; ++mi)
#pragma unroll
      for (int i = 0; i < 16; ++i) {
        const int row = m0 + wm * 64 + mi * 32 + crow(i, lh);
        if (row >= T) continue;
#pragma unroll
        for (int ni = 0; ni < 2; ++ni) {
          const int col = n0 + wn * 64 + ni * 32 + lr;
          const float sa = __uint_as_float((unsigned)G[(size_t)row * 2048 + col] << 16);
          const float sb = __uint_as_float((unsigned)G[(size_t)row * 2048 + 1024 + col] << 16);
          MB[(size_t)row * 1024 + col] = f2bf(sa * acc[mi][ni][i] + sb * acc2[mi][ni][i]);
        }
      }
  }
}

template <int MODE>
DI void attn_item(const Params& p, char* smem, int grp, int b, int h, int q0, int nqv, float lam) {
  int t_ = threadIdx.x;
  asm volatile("" : "+v"(t_));
  const int t = t_, lane = t & 63, w = __builtin_amdgcn_readfirstlane(t >> 6), lr = lane & 31, lh = lane >> 5;
  u16* Ks = (u16*)smem;
  u16* Vt = Ks + 64 * 136;
  u16* Qs = Vt + 128 * 72;
  constexpr int NQB = MODE == 0 ? 64 : 128;
  constexpr int KS = MODE == 0 ? 4 : 8;
  const int NK = grp ? NKS : NTOKP;
  const int qsub = MODE == 0 ? (w >> 1) : w;
  const int map = MODE == 0 ? (w & 1) : 0;
  const int qw0 = q0 + qsub * 32;
  const bool wact = (qsub * 32) < nqv;
  int Lw = 0;
  if (wact) Lw = grp ? NKS : (qw0 < 16 ? 16 : 16 + 64 * (((qw0 - 16) >> 6) + 1));
  const int tql = q0 + nqv - 1;
  const int Lblk = grp ? NKS : (tql < 16 ? 16 : 16 + 64 * (((tql - 16) >> 6) + 1));
  const int nkt = (Lblk + 63) >> 6;
  const int ql = qsub * 32 + lr;
  const int tq = q0 + (ql < nqv ? ql : nqv - 1);
  const size_t gr = grp ? (size_t)TP + b * 32 + tq : (size_t)b * NTOKP + tq;
  __syncthreads();
  {
    const u16* Qg = (const u16*)(p.ws + (MODE == 0 ? OFF_AQ : OFF_BQ));
#pragma unroll
    for (int i = 0; i < NQB / 16; ++i) {
      const int c = t + 256 * i; const int q = c >> 4, ch = c & 15;
      const int tqq = q0 + (q < nqv ? q : nqv - 1);
      const size_t grq = grp ? (size_t)TP + b * 32 + tqq : (size_t)b * NTOKP + tqq;
      *(uint4*)(Qs + q * 136 + ch * 8) = *(const uint4*)(Qg + grq * 1024 + h * 128 + ch * 8);
    }
  }
  const u16* Qw = Qs + ql * 136 + map * 64 + lh * 8;
  const u64* mrow = nullptr;
  if (MODE == 1) mrow = grp ? (const u64*)(p.ws + OFF_MASKS) + ((size_t)b * 32 + tq) * NWS : (const u64*)(p.ws + OFF_MASKP) + gr * NWP;
  f32x16 O[4];
  float mrun = -1e30f, lrun = 0.f;
#pragma unroll
  for (int db = 0; db < 4; ++db)
#pragma unroll
    for (int i = 0; i < 16; ++i) O[db][i] = 0.f;
  const int kwhich = MODE == 0 ? 0 : 2;
  const u16* Kg = (const u16*)(p.ws + (MODE == 0 ? OFF_AKB : OFF_BKB)) + (size_t)b * NTOKP * 1024 + h * 128 + (t & 15) * 8;
  const u16* Vg = (const u16*)(p.ws + (MODE == 0 ? OFF_AVT : OFF_BVT)) + ((size_t)(b * 8 + h) * 128 + (t >> 3)) * VTPAD + (t & 7) * 8;
  const int kkey = t >> 4;
  uint4 rk0, rk1, rk2, rk3, rv0, rv1, rv2, rv3;
  rk0 = rk1 = rk2 = rk3 = rv0 = rv1 = rv2 = rv3 = make_uint4(0, 0, 0, 0);
  if (!grp) {
    int k0 = kkey, k1 = kkey + 16, k2 = kkey + 32, k3 = kkey + 48;
    k0 = k0 < NTOKP ? k0 : NTOKP - 1; k1 = k1 < NTOKP ? k1 : NTOKP - 1; k2 = k2 < NTOKP ? k2 : NTOKP - 1; k3 = k3 < NTOKP ? k3 : NTOKP - 1;
    rk0 = *(const uint4*)(Kg + (size_t)k0 * 1024); rk1 = *(const uint4*)(Kg + (size_t)k1 * 1024);
    rk2 = *(const uint4*)(Kg + (size_t)k2 * 1024); rk3 = *(const uint4*)(Kg + (size_t)k3 * 1024);
    rv0 = *(const uint4*)(Vg); rv1 = *(const uint4*)(Vg + (size_t)32 * VTPAD);
    rv2 = *(const uint4*)(Vg + (size_t)64 * VTPAD); rv3 = *(const uint4*)(Vg + (size_t)96 * VTPAD);
  }
  for (int kt = 0; kt < nkt; ++kt) {
    __syncthreads();
    if (!grp) {
      *(uint4*)(Ks + kkey * 136 + (t & 15) * 8) = rk0; *(uint4*)(Ks + (kkey + 16) * 136 + (t & 15) * 8) = rk1;
      *(uint4*)(Ks + (kkey + 32) * 136 + (t & 15) * 8) = rk2; *(uint4*)(Ks + (kkey + 48) * 136 + (t & 15) * 8) = rk3;
      *(uint4*)(Vt + (t >> 3) * 72 + (t & 7) * 8) = rv0; *(uint4*)(Vt + ((t >> 3) + 32) * 72 + (t & 7) * 8) = rv1;
      *(uint4*)(Vt + ((t >> 3) + 64) * 72 + (t & 7) * 8) = rv2; *(uint4*)(Vt + ((t >> 3) + 96) * 72 + (t & 7) * 8) = rv3;
    } else {
#pragma unroll
    for (int i = 0; i < 8; ++i) {
      const int c = t + 256 * i; const int key = c >> 5, d4 = c & 31;
      int tk = kt * 64 + key; tk = tk < NK ? tk : NK - 1;
      const float4 v = *(const float4*)(kv_row(p, grp, b, tk, kwhich) + h * 128 + d4 * 4);
      *(uint2*)(Ks + key * 136 + d4 * 4) = make_uint2(pack2(v.x, v.y), pack2(v.z, v.w));
    }
    __builtin_amdgcn_sched_barrier(0);
#pragma unroll
    for (int i = 0; i < 2; ++i) {
      const int c = t + 256 * i; const int kq = c >> 5, d4 = c & 31;
      float4 x[4];
#pragma unroll
      for (int j = 0; j < 4; ++j) {
        int tk = kt * 64 + kq * 4 + j; tk = tk < NK ? tk : NK - 1;
        x[j] = *(const float4*)(kv_row(p, grp, b, tk, kwhich + 1) + h * 128 + d4 * 4);
      }
      u16* vd = Vt + (d4 * 4) * 72 + kq * 4;
      *(uint2*)(vd) = make_uint2(pack2(x[0].x, x[1].x), pack2(x[2].x, x[3].x));
      *(uint2*)(vd + 72) = make_uint2(pack2(x[0].y, x[1].y), pack2(x[2].y, x[3].y));
      *(uint2*)(vd + 144) = make_uint2(pack2(x[0].z, x[1].z), pack2(x[2].z, x[3].z));
      *(uint2*)(vd + 216) = make_uint2(pack2(x[0].w, x[1].w), pack2(x[2].w, x[3].w));
    }
    __builtin_amdgcn_sched_barrier(0);
    }
    __syncthreads();
    if (!grp && kt + 1 < nkt) {
      const int kb = (kt + 1) * 64 + kkey;
      int k0 = kb, k1 = kb + 16, k2 = kb + 32, k3 = kb + 48;
      k0 = k0 < NTOKP ? k0 : NTOKP - 1; k1 = k1 < NTOKP ? k1 : NTOKP - 1; k2 = k2 < NTOKP ? k2 : NTOKP - 1; k3 = k3 < NTOKP ? k3 : NTOKP - 1;
      rk0 = *(const uint4*)(Kg + (size_t)k0 * 1024); rk1 = *(const uint4*)(Kg + (size_t)k1 * 1024);
      rk2 = *(const uint4*)(Kg + (size_t)k2 * 1024); rk3 = *(const uint4*)(Kg + (size_t)k3 * 1024);
      const u16* vp = Vg + (kt + 1) * 64;
      rv0 = *(const uint4*)(vp); rv1 = *(const uint4*)(vp + (size_t)32 * VTPAD);
      rv2 = *(const uint4*)(vp + (size_t)64 * VTPAD); rv3 = *(const uint4*)(vp + (size_t)96 * VTPAD);
    }
    if (wact && kt * 64 < Lw) {
      f32x16 st0, st1;
#pragma unroll
      for (int i = 0; i < 16; ++i) { st0[i] = 0.f; st1[i] = 0.f; }
#pragma unroll
      for (int ks = 0; ks < KS; ++ks) {
        const bf16x8 k0 = *(const bf16x8*)(Ks + lr * 136 + map * 64 + ks * 16 + lh * 8);
        const bf16x8 k1 = *(const bf16x8*)(Ks + (32 + lr) * 136 + map * 64 + ks * 16 + lh * 8);
        const bf16x8 qf = *(const bf16x8*)(Qw + ks * 16);
        st0 = MFMA(k0, qf, st0);
        st1 = MFMA(k1, qf, st1);
      }
      if (MODE == 0) {
        if (kt * 64 + 64 > Lw) {
#pragma unroll
          for (int i = 0; i < 16; ++i) {
            const int key = kt * 64 + crow(i, lh);
            if (key >= Lw) st0[i] = -INFINITY;
            if (key + 32 >= Lw) st1[i] = -INFINITY;
          }
        }
      } else {
        const u64 mw = mrow[kt];
        const unsigned lo = (unsigned)mw >> (4 * lh), hi = (unsigned)(mw >> 32) >> (4 * lh);
#pragma unroll
        for (int i = 0; i < 16; ++i) {
          const int bit = (i & 3) + 8 * (i >> 2);
          if (!((lo >> bit) & 1u)) st0[i] = -INFINITY;
          if (!((hi >> bit) & 1u)) st1[i] = -INFINITY;
        }
      }
      float tmax = -INFINITY;
#pragma unroll
      for (int i = 0; i < 16; ++i) tmax = fmaxf(tmax, fmaxf(st0[i], st1[i]));
      tmax = fmaxf(tmax, shx(tmax, 32));
      const float mnew = fmaxf(mrun, tmax);
      const float alpha = fexp2(mrun - mnew);
      mrun = mnew;
      float ps = 0.f;
#pragma unroll
      for (int i = 0; i < 16; ++i) {
        st0[i] = fexp2(st0[i] - mnew); st1[i] = fexp2(st1[i] - mnew);
        ps += st0[i] + st1[i];
      }
      lrun = lrun * alpha + ps;
#pragma unroll
      for (int db = 0; db < 4; ++db)
#pragma unroll
        for (int i = 0; i < 16; ++i) O[db][i] *= alpha;
      bf16x8 pf[4];
#pragma unroll
      for (int c = 0; c < 4; ++c) {
        bf16x8 pk;
#pragma unroll
        for (int j = 0; j < 8; ++j) pk[j] = (short)f2bf((c < 2) ? st0[(c & 1) * 8 + j] : st1[(c & 1) * 8 + j]);
        pf[c] = pk;
      }
#pragma unroll
      for (int db = 0; db < 4; ++db)
#pragma unroll
        for (int c = 0; c < 4; ++c) {
          const int kk = (c >> 1) * 32 + (c & 1) * 16 + 4 * lh;
          const bf16x4 v0 = *(const bf16x4*)(Vt + (db * 32 + lr) * 72 + kk);
          const bf16x4 v1 = *(const bf16x4*)(Vt + (db * 32 + lr) * 72 + kk + 8);
          const bf16x8 vf = __builtin_shufflevector(v0, v1, 0, 1, 2, 3, 4, 5, 6, 7);
          O[db] = MFMA(vf, pf[c], O[db]);
        }
    }
  }
  const float ltot = lrun + shx(lrun, 32);
  const float inv = 1.0f / ltot;
  const bool qok = ql < nqv;
  if (MODE == 0) {
    float* Ex = (float*)smem;
    __syncthreads();
    if (map == 1) {
      const float sc = inv * lam;
#pragma unroll
      for (int db = 0; db < 4; ++db)
#pragma unroll
        for (int i = 0; i < 16; ++i) Ex[(qsub * 128 + db * 32 + crow(i, lh)) * 33 + lr] = O[db][i] * sc;
    }
    __syncthreads();
    if (map == 0) {
      float ss = 0.f;
#pragma unroll
      for (int db = 0; db < 4; ++db)
#pragma unroll
        for (int i = 0; i < 16; ++i) {
          const float v = O[db][i] * inv - Ex[(qsub * 128 + db * 32 + crow(i, lh)) * 33 + lr];
          O[db][i] = v; ss += v * v;
        }
      ss += shx(ss, 32);
      const float rn = rsqrtf(ss * (1.0f / 128.0f) + EPS) * 0.8f;
      const float* sub = p.in[18];
      u16* dst = (u16*)(p.ws + OFF_OA) + gr * 1024 + h * 128;
      if (wact && qok) {
#pragma unroll
        for (int db = 0; db < 4; ++db)
#pragma unroll
          for (int g = 0; g < 4; ++g) {
            const int d = db * 32 + 8 * g + 4 * lh;
            const float4 sg = *(const float4*)(sub + d);
            *(uint2*)(dst + d) = make_uint2(pack2(O[db][4 * g] * rn * sg.x, O[db][4 * g + 1] * rn * sg.y),
                                            pack2(O[db][4 * g + 2] * rn * sg.z, O[db][4 * g + 3] * rn * sg.w));
          }
      }
    }
  } else {
    u16* dst = (u16*)(p.ws + OFF_OB) + gr * 1024 + h * 128;
    if (wact && qok) {
#pragma unroll
      for (int db = 0; db < 4; ++db)
#pragma unroll
        for (int g = 0; g < 4; ++g) {
          const int d = db * 32 + 8 * g + 4 * lh;
          *(uint2*)(dst + d) = make_uint2(pack2(O[db][4 * g] * inv, O[db][4 * g + 1] * inv),
                                          pack2(O[db][4 * g + 2] * inv, O[db][4 * g + 3] * inv));
        }
    }
  }
}

DI unsigned ford(float f) { unsigned u = __float_as_uint(f); return u ^ ((u >> 31) ? 0xFFFFFFFFu : 0x80000000u); }

DI void idx_item(const Params& p, char* smem, int grp, int b, int cidx) {
  int t_ = threadIdx.x;
  asm volatile("" : "+v"(t_));
  const int t = t_, lane = t & 63, w = __builtin_amdgcn_readfirstlane(t >> 6), lr = lane & 31, lh = lane >> 5;
  u16* IQs = (u16*)smem;
  u16* IKs = IQs + 64 * 520;
  float* IWs = (float*)(smem + 66560 + 9216);
  float* SCb = (float*)(p.ws + OFF_SC);
  int q0, nqv, L, Lpad, NK; float* SC;
  if (!grp) {
    NK = NTOKP;
    if (cidx == 0) { q0 = 0; nqv = 16; L = 16; Lpad = 64; SC = SCb + SC_META + (size_t)b * 4096; }
    else { const int c = cidx - 1; q0 = 16 + 64 * c; nqv = 64; L = 80 + 64 * c; Lpad = 64 * (c + 2); SC = SCb + (size_t)b * SC_BSTRIDE + 4096ull * (size_t)(c * (c + 3) / 2); }
  } else { NK = NKS; q0 = 0; nqv = 32; L = NKS; Lpad = 2112; SC = SCb + SC_SAMP + (size_t)b * 64 * 2112; }
  const int nkt = (L + 63) >> 6;
  const u16* IQg = (const u16*)(p.ws + OFF_IQ);
  const float* IWg = (const float*)(p.ws + OFF_IW);
  __syncthreads();
#pragma unroll 4
  for (int i = 0; i < 16; ++i) {
    const int c = t + 256 * i; const int q = c >> 6, ch = c & 63;
    const int tq = q0 + (q < nqv ? q : nqv - 1);
    const size_t gr = grp ? (size_t)TP + b * 32 + tq : (size_t)b * NTOKP + tq;
    *(uint4*)(IQs + q * 520 + ch * 8) = *(const uint4*)(IQg + gr * 512 + ch * 8);
  }
#pragma unroll
  for (int i = 0; i < 2; ++i) {
    const int e = t + 256 * i; const int q = e >> 3, hd = e & 7;
    const int tq = q0 + (q < nqv ? q : nqv - 1);
    const size_t gr = grp ? (size_t)TP + b * 32 + tq : (size_t)b * NTOKP + tq;
    IWs[e] = IWg[gr * 8 + hd];
  }
  const int wq = w >> 1, wk = w & 1;
  const u16* IKg = (const u16*)(p.ws + OFF_IKB) + (size_t)b * NTOKP * 64 + (t & 7) * 8;
  const int ikey = t >> 3;
  uint4 ri0 = make_uint4(0, 0, 0, 0), ri1 = ri0;
  if (!grp) {
    int k0 = ikey, k1 = ikey + 32;
    k0 = k0 < NTOKP ? k0 : NTOKP - 1; k1 = k1 < NTOKP ? k1 : NTOKP - 1;
    ri0 = *(const uint4*)(IKg + (size_t)k0 * 64); ri1 = *(const uint4*)(IKg + (size_t)k1 * 64);
  }
  for (int kt = 0; kt < nkt; ++kt) {
    __syncthreads();
    if (!grp) {
      *(uint4*)(IKs + ikey * 72 + (t & 7) * 8) = ri0; *(uint4*)(IKs + (ikey + 32) * 72 + (t & 7) * 8) = ri1;
    } else {
#pragma unroll
    for (int i = 0; i < 4; ++i) {
      const int c = t + 256 * i; const int key = c >> 4, d4 = c & 15;
      int tk = kt * 64 + key; tk = tk < NK ? tk : NK - 1;
      const float4 v = *(const float4*)(ik_row(p, grp, b, tk) + d4 * 4);
      *(uint2*)(IKs + key * 72 + d4 * 4) = make_uint2(pack2(v.x, v.y), pack2(v.z, v.w));
    }
    }
    __syncthreads();
    if (!grp && kt + 1 < nkt) {
      int k0 = (kt + 1) * 64 + ikey, k1 = k0 + 32;
      k0 = k0 < NTOKP ? k0 : NTOKP - 1; k1 = k1 < NTOKP ? k1 : NTOKP - 1;
      ri0 = *(const uint4*)(IKg + (size_t)k0 * 64); ri1 = *(const uint4*)(IKg + (size_t)k1 * 64);
    }
    bf16x8 kf[4];
#pragma unroll
    for (int ks = 0; ks < 4; ++ks) kf[ks] = *(const bf16x8*)(IKs + (wk * 32 + lr) * 72 + ks * 16 + lh * 8);
    float sc[16];
#pragma unroll
    for (int i = 0; i < 16; ++i) sc[i] = 0.f;
#pragma unroll
    for (int hd = 0; hd < 8; ++hd) {
      f32x16 st;
#pragma unroll
      for (int i = 0; i < 16; ++i) st[i] = 0.f;
#pragma unroll
      for (int ks = 0; ks < 4; ++ks) {
        const bf16x8 qfr = *(const bf16x8*)(IQs + (wq * 32 + lr) * 520 + hd * 64 + ks * 16 + lh * 8);
        st = MFMA(kf[ks], qfr, st);
      }
      const float wv = IWs[(wq * 32 + lr) * 8 + hd];
#pragma unroll
      for (int i = 0; i < 16; ++i) sc[i] += wv * fmaxf(st[i], 0.f);
    }
    float* srow = SC + (size_t)(wq * 32 + lr) * Lpad + kt * 64 + wk * 32 + 4 * lh;
#pragma unroll
    for (int g = 0; g < 4; ++g) *(float4*)(srow + 8 * g) = make_float4(sc[4 * g], sc[4 * g + 1], sc[4 * g + 2], sc[4 * g + 3]);
  }
  __threadfence();
  __syncthreads();
  for (int j = 0; j < 16; ++j) {
    const int q = w * 16 + j;
    if (q >= nqv) break;
    const int tq = q0 + q;
    u64* mrow = grp ? (u64*)(p.ws + OFF_MASKS) + ((size_t)b * 32 + tq) * NWS : (u64*)(p.ws + OFF_MASKP) + ((size_t)b * NTOKP + tq) * NWP;
    if (L <= 256) {
      for (int i = 0; i < nkt; ++i) {
        const u64 wd = __ballot(i * 64 + lane < L);
        if (lane == 0) mrow[i] = wd;
      }
      continue;
    }
    const unsigned* srow = (const unsigned*)(SC + (size_t)q * Lpad);
    int Lr = L;
    asm volatile("" : "+v"(Lr));
    int nkr = __builtin_amdgcn_readfirstlane(nkt);
    asm volatile("" : "+s"(nkr));
    int lanev = lane;
    asm volatile("" : "+v"(lanev));
    unsigned v[129];
#pragma unroll
    for (int g = 0; g < 17; ++g) {
      if (g * 8 < nkt) {
#pragma unroll
        for (int jj = 0; jj < 8; ++jj) {
          const int i = g * 8 + jj; if (i >= 129) continue; const int key = i * 64 + lanev;
          const unsigned u = ford(__uint_as_float(__hip_atomic_load(srow + key, __ATOMIC_RELAXED, __HIP_MEMORY_SCOPE_AGENT)));
          v[i] = key < Lr ? u : 0u;
        }
        __builtin_amdgcn_sched_barrier(0);
      } else {
#pragma unroll
        for (int jj = 0; jj < 8; ++jj) if (g * 8 + jj < 129) v[g * 8 + jj] = 0u;
      }
    }
    unsigned Tt = 0u;
    for (int bit = 31; bit >= 0; --bit) {
      const unsigned cand = Tt | (1u << bit);
      int cnt = 0;
#pragma unroll
      for (int g = 0; g < 17; ++g) {
        if (g * 8 < nkt) {
#pragma unroll
          for (int jj = 0; jj < 8; ++jj) if (g * 8 + jj < 129) cnt += (v[g * 8 + jj] >= cand) ? 1 : 0;
          __builtin_amdgcn_sched_barrier(0);
        }
      }
#pragma unroll
      for (int m = 32; m >= 1; m >>= 1) cnt += __shfl_xor(cnt, m, 64);
      if (cnt >= 256) Tt = cand;
    }
    int cgt = 0;
#pragma unroll
    for (int g = 0; g < 17; ++g) {
      if (g * 8 < nkt) {
#pragma unroll
        for (int jj = 0; jj < 8; ++jj) if (g * 8 + jj < 129) cgt += (v[g * 8 + jj] > Tt) ? 1 : 0;
        __builtin_amdgcn_sched_barrier(0);
      }
    }
#pragma unroll
    for (int m = 32; m >= 1; m >>= 1) cgt += __shfl_xor(cgt, m, 64);
    const int need = 256 - cgt;
    int run = 0;
    const u64 lmask = (1ull << lane) - 1ull;
#pragma unroll
    for (int g = 0; g < 17; ++g) {
      if (g * 8 < nkt) {
#pragma unroll
        for (int jj = 0; jj < 8; ++jj) {
          const int i = g * 8 + jj; if (i >= 129) continue;
          const bool eq = v[i] == Tt;
          const u64 em = __ballot(eq);
          const int pre = run + __popcll(em & lmask);
          const bool sel = (v[i] > Tt) || (eq && pre < need);
          run += __popcll(em);
          const u64 wd = __ballot(sel);
          if (i < nkr) { if (lane == 0) mrow[i] = wd; }
          __builtin_amdgcn_sched_barrier(0);
        }
      }
    }
  }
}

DI int next_item(unsigned* cnt, int* s_item) {
  __syncthreads();
  if (threadIdx.x == 0) *s_item = (int)atomicAdd(cnt, 1u);
  __syncthreads();
  return __builtin_amdgcn_readfirstlane(*s_item);
}

DI void phase_attn_a(const Params& p, char* smem, int cidx = 0) {
  unsigned* cnt = (unsigned*)(p.ws + OFF_CNT) + cidx;
  int* s_item = (int*)(smem + 77824);
  float lam;
  {
    const int lane = threadIdx.x & 63;
    float a = p.in[14][lane] * p.in[15][lane], c = p.in[16][lane] * p.in[17][lane];
#pragma unroll
    for (int m = 32; m >= 1; m >>= 1) { a += shx(a, m); c += shx(c, m); }
    lam = expf(a) - expf(c) + 0.2f;
  }
  while (true) {
    const int it = next_item(cnt, s_item);
    if (it >= 274 + 2064 + 128) break;
#ifndef NO_IDX
    if (it < 258) idx_item(p, smem, 0, it & 1, 128 - (it >> 1));
    else if (it < 274) idx_item(p, smem, 1, it - 258, 0);
#else
    if (it < 274) {}
#endif
#ifndef NO_DIFF
    else if (it < 274 + 128) {
      const int j = it - 274;
      attn_item<0>(p, smem, 1, j >> 3, j & 7, 0, 32, lam);
    } else {
      const int j = it - (274 + 128); const int ci = 128 - j / 16, bh = j & 15;
      attn_item<0>(p, smem, 0, bh >> 3, bh & 7, ci == 0 ? 0 : 16 + (ci - 1) * 64, ci == 0 ? 16 : 64, lam);
    }
#endif
  }
}

DI void phase_attn_b(const Params& p, char* smem) {
  unsigned* cnt = (unsigned*)(p.ws + OFF_CNT) + 1;
  int* s_item = (int*)(smem + 77824);
  while (true) {
    const int it = next_item(cnt, s_item);
    if (it >= 1040 + 128) break;
    if (it < 128) {
      attn_item<1>(p, smem, 1, it >> 3, it & 7, 0, 32, 0.f);
    } else {
      const int j = it - 128; const int qt = 64 - j / 16, bh = j & 15;
      attn_item<1>(p, smem, 0, bh >> 3, bh & 7, qt == 0 ? 0 : 16 + (qt - 1) * 128, qt == 0 ? 16 : 128, 0.f);
    }
  }
}

DI void phase_final(const Params& p) {
  const int t = threadIdx.x, lane = t & 63;
  const int wv = blockIdx.x * 4 + (t >> 6), nw = gridDim.x * 4;
  const float* xf = (const float*)(p.ws + OFF_XF);
  const float* ssp = (const float*)(p.ws + OFF_SSP3);
  const float4* gf = (const float4*)p.in[26];
  for (int row = wv; row < T; row += nw) {
    float* dst;
    if (row < TP) {
      const int b = row >= NTOKP ? 1 : 0; const int tok = row - b * NTOKP;
      if (tok < 16) continue;
      dst = p.out + O_YP + ((size_t)b * 8192 + (tok - 16)) * 1024;
    } else dst = p.out + O_YS + (size_t)(row - TP) * 1024;
    float s = 0.f;
#pragma unroll
    for (int i = 0; i < 16; ++i) s += ssp[(size_t)row * 16 + i];
    const float r = rsqrtf(s * (1.0f / 1024.0f) + EPS);
#pragma unroll
    for (int i = 0; i < 4; ++i) {
      const float4 v = ((const float4*)(xf + (size_t)row * 1024))[lane + 64 * i];
      const float4 g = gf[lane + 64 * i];
      ((float4*)dst)[lane + 64 * i] = make_float4(v.x * r * g.x, v.y * r * g.y, v.z * r * g.z, v.w * r * g.w);
    }
  }
}

#ifndef PHM
#define PHM 0x7ff
#endif
#define PHON(n) ((PHM >> n) & 1)
__global__ void __launch_bounds__(256, 2) mega(Params p) {
  extern __shared__ __attribute__((aligned(16))) char smem[];
  cg::grid_group grid = cg::this_grid();
  if (PHON(0)) phase_prep(p, smem);
  grid.sync();
  if (PHON(1)) phase_gateup(p, smem, OFF_SSP0, OFF_WGU1);
  grid.sync();
#ifdef DUP_GEMM
  phase_gateup(p, smem, OFF_SSP0, OFF_WGU1);
  grid.sync();
#endif
  if (PHON(2)) phase_resid<1>(p, smem, (const u16*)(p.ws + OFF_HID), 2816, 2816, OFF_WD1, 0.5f, OFF_SSP1);
  grid.sync();
  if (PHON(3)) phase_win(p, smem);
  grid.sync();
#ifdef DUP_GEMM
  phase_win(p, smem);
  grid.sync();
#endif
  if (PHON(4)) phase_attn_a(p, smem);
  grid.sync();
#ifdef DUP_P4
  phase_attn_a(p, smem, 2);
  grid.sync();
#endif
  if (PHON(5)) phase_attn_b(p, smem);
  grid.sync();
  if (PHON(6)) phase_merge(p, smem);
  grid.sync();
  if (PHON(7)) phase_resid<0>(p, smem, (const u16*)(p.ws + OFF_MB), 1024, 1024, OFF_WO, 1.0f, OFF_SSP2);
  grid.sync();
  if (PHON(8)) phase_gateup(p, smem, OFF_SSP2, OFF_WGU2);
  grid.sync();
  if (PHON(9)) phase_resid<0>(p, smem, (const u16*)(p.ws + OFF_HID), 2816, 2816, OFF_WD2, 0.5f, OFF_SSP3);
  grid.sync();
  if (PHON(10)) phase_final(p);
}

extern "C" void kernel_launch(void* const* d_in, const int* in_sizes, int n_in, void* d_out, int out_size, void* d_ws,
                              size_t ws_size, hipStream_t stream) {
  Params p{};
  for (int i = 0; i < 27; ++i) p.in[i] = (const float*)d_in[i];
  p.out = (float*)d_out;
  p.ws = (char*)d_ws;
  static int grid_blocks = 0;
  if (!grid_blocks) {
    hipFuncSetAttribute((const void*)mega, hipFuncAttributeMaxDynamicSharedMemorySize, SMEM_BYTES);
    int dev = 0, cus = 0, per_cu = 0;
    hipGetDevice(&dev);
    hipDeviceGetAttribute(&cus, hipDeviceAttributeMultiprocessorCount, dev);
    hipOccupancyMaxActiveBlocksPerMultiprocessor(&per_cu, mega, 256, SMEM_BYTES);
    if (per_cu > 2) per_cu = 2;
    if (per_cu < 1) per_cu = 1;
    grid_blocks = cus * per_cu;
  }
  if (ws_size < WS_END) fprintf(stderr, "workspace too small: %zu < %zu\n", ws_size, (size_t)WS_END);
  void* args[] = {&p};
  hipError_t e = hipLaunchCooperativeKernel((void*)mega, dim3(grid_blocks), dim3(256), args, SMEM_BYTES, stream);
  if (e != hipSuccess) fprintf(stderr, "cooperative launch failed: %s (grid %d)\n", hipGetErrorString(e), grid_blocks);
}
```

```cpp
#include <hip/hip_runtime.h>
#include <hip/hip_cooperative_groups.h>
#include <stdint.h>
#include <cstdio>
namespace cg = cooperative_groups;

typedef __attribute__((ext_vector_type(8))) short bf16x8;
typedef __attribute__((ext_vector_type(4))) short bf16x4;
typedef __attribute__((ext_vector_type(16))) float f32x16;
typedef unsigned short u16;
typedef unsigned long long u64;
#define MFMA(a, b, c) __builtin_amdgcn_mfma_f32_32x32x16_bf16((a), (b), (c), 0, 0, 0)
#define DI __device__ __forceinline__

constexpr int NTOKP = 8208;
constexpr int TP = 2 * NTOKP;
constexpr int TS = 512;
constexpr int T = TP + TS;
constexpr int TPAD = 17152;
constexpr int NT_M = 67;
constexpr int NTHR = 512;
constexpr int NCACHE = 2064;
constexpr int NKS = 2096;
constexpr int NWP = 129;
constexpr int NWS = 33;
constexpr float EPS = 1e-6f;
constexpr float LOG2E = 1.4426950408889634f;
constexpr float QA_SCALE = 0.125f * LOG2E;
constexpr float QB_SCALE = 0.08838834764831845f * LOG2E;
constexpr float IW_SCALE = 0.125f * 0.35355339059327373f;

constexpr size_t O_YP = 0;
constexpr size_t O_YS = O_YP + 2ull * 8192 * 1024;
constexpr size_t O_AKP = O_YS + 512ull * 1024;
constexpr size_t SZ_NEWP = (size_t)TP * 1024;
constexpr size_t O_AVP = O_AKP + SZ_NEWP;
constexpr size_t O_BKP = O_AVP + SZ_NEWP;
constexpr size_t O_BVP = O_BKP + SZ_NEWP;
constexpr size_t O_IKP = O_BVP + SZ_NEWP;
constexpr size_t O_AKS = O_IKP + (size_t)TP * 64;
constexpr size_t SZ_NEWS = (size_t)TS * 1024;
constexpr size_t O_AVS = O_AKS + SZ_NEWS;
constexpr size_t O_BKS = O_AVS + SZ_NEWS;
constexpr size_t O_BVS = O_BKS + SZ_NEWS;
constexpr size_t O_IKS = O_BVS + SZ_NEWS;

constexpr size_t al256(size_t x) { return (x + 255) & ~size_t(255); }
constexpr size_t SZ_WGU = 5632ull * 1024 * 2, SZ_WD = 1024ull * 2816 * 2, SZ_WIN = 8960ull * 1024 * 2, SZ_WSQ = 1024ull * 1024 * 2;
constexpr int VTPAD = 8256;
constexpr size_t OFF_WA = 0;
constexpr size_t OFF_WB = OFF_WA + SZ_WSQ;
constexpr size_t OFF_WO = OFF_WB + SZ_WSQ;
constexpr size_t OFF_WGU2 = OFF_WO + SZ_WSQ;
constexpr size_t OFF_WD2 = OFF_WGU2 + SZ_WGU;
constexpr size_t OFF_XF = OFF_WD2 + SZ_WD;
constexpr size_t SZ_SSP = (size_t)TPAD * 16 * 4;
constexpr size_t OFF_SSP0 = OFF_XF + (size_t)TPAD * 1024 * 4;
constexpr size_t OFF_SSP1 = OFF_SSP0 + SZ_SSP;
constexpr size_t OFF_SSP2 = OFF_SSP1 + SZ_SSP;
constexpr size_t OFF_SSP3 = OFF_SSP2 + SZ_SSP;
constexpr size_t OFF_TAB = OFF_SSP3 + SZ_SSP;
constexpr size_t OFF_AQ = OFF_TAB + (size_t)NTOKP * 64 * 8;
constexpr size_t OFF_MB = OFF_AQ;
constexpr size_t OFF_BQ = OFF_AQ + (size_t)TPAD * 1024 * 2;
constexpr size_t OFF_IQ = OFF_BQ + (size_t)TPAD * 1024 * 2;
constexpr size_t OFF_IW = OFF_IQ + (size_t)TPAD * 512 * 2;
constexpr size_t OFF_G = OFF_IW + (size_t)TPAD * 8 * 4;
constexpr size_t OFF_OA = OFF_G + (size_t)TPAD * 2048 * 2;
constexpr size_t OFF_MASKP = OFF_OA + (size_t)TPAD * 1024 * 2;
constexpr size_t OFF_MASKS = OFF_MASKP + al256((size_t)TP * NWP * 8);
constexpr size_t OFF_CNT = OFF_MASKS + al256((size_t)TS * NWS * 8);
constexpr size_t OFF_XBAR = OFF_CNT + 256;
constexpr size_t SZ_XBAR = 3456 * 4 + 256;
constexpr size_t OFF_AKB = OFF_XBAR + ((SZ_XBAR + 255) & ~size_t(255));
constexpr size_t OFF_BKB = OFF_AKB + (size_t)TP * 1024 * 2;
constexpr size_t SZ_VT = 2ull * 8 * 128 * VTPAD * 2;
constexpr size_t OFF_AVT = OFF_BKB + (size_t)TP * 1024 * 2;
constexpr size_t OFF_BVT = OFF_AVT + SZ_VT;
constexpr size_t OFF_IKB = OFF_BVT + SZ_VT;
constexpr size_t OFF_DEAD = OFF_IKB + al256((size_t)TP * 64 * 2);
constexpr size_t OFF_WGU1 = OFF_DEAD;
constexpr size_t OFF_WD1 = OFF_WGU1 + SZ_WGU;
constexpr size_t OFF_WIN = OFF_WD1 + SZ_WD;
constexpr size_t OFF_XB = OFF_WIN + SZ_WIN;
constexpr size_t OFF_HID = OFF_XB + (size_t)TPAD * 1024 * 2;
constexpr size_t OFF_OB = OFF_HID + (size_t)TPAD * 2816 * 2;
constexpr size_t OFF_SC = OFF_DEAD;
constexpr size_t SC_BSTRIDE = 4096ull * (128 * 131 / 2);
constexpr size_t SC_META = 2 * SC_BSTRIDE;
constexpr size_t SC_SAMP = SC_META + 2 * 4096;
constexpr size_t SC_FLOATS = SC_SAMP + 16ull * 64 * 2112;
constexpr size_t WS_END = OFF_SC + SC_FLOATS * 4 + 4096;
static_assert(WS_END <= 736544256ull, "workspace budget");
static_assert(OFF_OB + (size_t)TPAD * 1024 * 2 <= WS_END, "dead region fits");

constexpr int SMEM_ITEM = 149504;
constexpr int SMEM_BYTES = SMEM_ITEM + 64;

struct Params {
  const float* in[27];
  float* out;
  char* ws;
};

typedef __attribute__((ext_vector_type(2))) float f32x2_t;
typedef __attribute__((ext_vector_type(2))) __bf16 bf16x2_t;
DI unsigned pack2(float a, float b) {
  f32x2_t v = {a, b};
  return __builtin_bit_cast(unsigned, __builtin_convertvector(v, bf16x2_t));
}
DI u16 f2bf(float x) { return (u16)(pack2(x, x) & 0xffffu); }
DI int tid_opaque() { int t = threadIdx.x; asm volatile("" : "+v"(t)); return t; }
DI int crow(int i, int h) { return (i & 3) + 8 * (i >> 2) + 4 * h; }
DI float fexp2(float x) { return __builtin_amdgcn_exp2f(x); }
DI float shx(float v, int m) { return __shfl_xor(v, m, 64); }

DI const float* xrow_ptr(const Params& p, int row) {
  if (row < TP) {
    int b = row >= NTOKP ? 1 : 0;
    int tok = row - b * NTOKP;
    if (tok < 16) return p.in[7] + (size_t)tok * 1024;
    return p.in[0] + ((size_t)b * 8192 + (tok - 16)) * 1024;
  }
  return p.in[1] + (size_t)(row - TP) * 1024;
}

DI const float* kv_row(const Params& p, int grp, int b, int tk, int which) {
  if (!grp) return p.out + O_AKP + (size_t)which * SZ_NEWP + ((size_t)b * NTOKP + tk) * 1024;
  if (tk < NCACHE) return (which == 0 ? p.in[2] : which == 1 ? p.in[3] : which == 2 ? p.in[4] : p.in[5]) + ((size_t)b * NCACHE + tk) * 1024;
  return p.out + O_AKS + (size_t)which * SZ_NEWS + ((size_t)b * 32 + (tk - NCACHE)) * 1024;
}
DI const float* ik_row(const Params& p, int grp, int b, int tk) {
  if (!grp) return p.out + O_IKP + ((size_t)b * NTOKP + tk) * 64;
  if (tk < NCACHE) return p.in[6] + ((size_t)b * NCACHE + tk) * 64;
  return p.out + O_IKS + ((size_t)b * 32 + (tk - NCACHE)) * 64;
}

#define XB_TMO      128
#define XB_XCNT(j)  (256  + 64 * (j))
#define XB_XSUB(j)  (1280 + 64 * (j))
#define XB_XGEN(j)  (2304 + 64 * (j))
#define XB_TOP      3328
#define XB_TOPGEN   3392
#define XCD_BAR_WORDS 3456
#define XB_SPIN_CAP (1u << 18)
#define LAS __attribute__((address_space(3)))

__device__ __forceinline__ unsigned xb_ld(unsigned* p)              { return __hip_atomic_load(p, __ATOMIC_RELAXED, __HIP_MEMORY_SCOPE_AGENT); }
__device__ __forceinline__ unsigned xb_add(unsigned* p, unsigned v) { return __hip_atomic_fetch_add(p, v, __ATOMIC_RELAXED, __HIP_MEMORY_SCOPE_AGENT); }
__device__ __forceinline__ unsigned xb_xcc_id() { return (unsigned)__builtin_amdgcn_s_getreg((3 << 11) | 20) & 0xFu; }
#define XB_SPIN(cond, bar) do { unsigned _sp = 0; while (cond) { __builtin_amdgcn_s_sleep(1); \
    if ((++_sp & 255u) == 0u) { if (xb_ld(&(bar)[XB_TMO])) break; if (_sp > XB_SPIN_CAP) { atomicAdd(&(bar)[XB_TMO], 1u); break; } } } } while (0)

struct XcdBarrier {
    unsigned* bar; unsigned x;
    volatile LAS unsigned* st;
};

__device__ __forceinline__ XcdBarrier xcd_barrier_post(unsigned* bar, volatile LAS unsigned* st) {
    XcdBarrier b; b.bar = bar; b.x = xb_xcc_id(); b.st = st;
    if (threadIdx.x == 0) (void)xb_add(&bar[XB_XCNT(b.x)], 1u);
    return b;
}
__device__ __forceinline__ void xcd_barrier_complete(unsigned* bar, unsigned x, unsigned& nloc, unsigned& nx) {
    const unsigned G = gridDim.x * gridDim.y * gridDim.z;
    unsigned sum, cnt, mine, sp = 0u;
    for (;;) {
        sum = 0u; cnt = 0u; mine = 0u;
#pragma unroll
        for (unsigned j = 0; j < 16; ++j) { const unsigned c = xb_ld(&bar[XB_XCNT(j)]); sum += c; cnt += (c > 0u) ? 1u : 0u; mine = (j == x) ? c : mine; }
        if (sum == G) break;
        __builtin_amdgcn_s_sleep(1);
        if ((++sp & 255u) == 0u) { if (xb_ld(&bar[XB_TMO])) break; if (sp > XB_SPIN_CAP) { atomicAdd(&bar[XB_TMO], 1u); break; } }
    }
    nloc = mine > 0u ? mine : 1u; nx = cnt > 0u ? cnt : 1u;
}

__device__ __forceinline__ void xcd_barrier(const XcdBarrier& b) {
    asm volatile("s_waitcnt vmcnt(0)" ::: "memory");
    __syncthreads();
    if (threadIdx.x == 0) {
        unsigned* bar = b.bar;
        __builtin_amdgcn_s_waitcnt(0);
        unsigned nloc = b.st[0], nx = b.st[1];
        if (nloc == 0u) { xcd_barrier_complete(bar, b.x, nloc, nx); b.st[0] = nloc; b.st[1] = nx; }
        const unsigned old = xb_add(&bar[XB_XSUB(b.x)], 1u);
        const unsigned gen = old / nloc;
        if (old + 1u == (gen + 1u) * nloc) {
            __builtin_amdgcn_fence(__ATOMIC_RELEASE, "agent");
            asm volatile("s_waitcnt vmcnt(0)" ::: "memory");
            const unsigned og = xb_add(&bar[XB_TOP], 1u);
            const unsigned tg = og / nx;
            if (og + 1u == (tg + 1u) * nx) xb_add(&bar[XB_TOPGEN], 1u);
            else XB_SPIN(xb_ld(&bar[XB_TOPGEN]) == tg, bar);
            __builtin_amdgcn_fence(__ATOMIC_ACQUIRE, "agent");
            xb_add(&bar[XB_XGEN(b.x)], 1u);
            asm volatile("s_waitcnt vmcnt(0)" ::: "memory");
        } else {
            XB_SPIN(xb_ld(&bar[XB_XGEN(b.x)]) == gen, bar);
            __builtin_amdgcn_fence(__ATOMIC_ACQUIRE, "agent");
            asm volatile("s_waitcnt vmcnt(0)" ::: "memory");
        }
    }
    __syncthreads();
}


DI void gbar(const Params& p, char* smem) {
  XcdBarrier b; b.bar = (unsigned*)(p.ws + OFF_XBAR); b.x = xb_xcc_id(); b.st = (volatile LAS unsigned*)(smem + SMEM_ITEM + 48);
  xcd_barrier(b);
}
template <int job>
DI void wt_tile(const Params& p, int seg, int kt, float* ts) {
  const int t = threadIdx.x & 255;
  ts += (threadIdx.x >> 8) * (128 * 33);
  const float* src = nullptr; int ld = 0; const float* gs = nullptr; u16* dst = nullptr; int K = 1024; int nvalid4 = 8;
  switch (job) {
    case 0: case 6: {
      const float* wg = job == 0 ? p.in[9] : p.in[23]; const float* wu = job == 0 ? p.in[10] : p.in[24];
      const int c4g = threadIdx.x & 7;
      src = (c4g < 4 ? wg : wu) + 16 * seg - (c4g < 4 ? 0 : 16); ld = 2816; gs = job == 0 ? p.in[8] : p.in[22];
      dst = (u16*)(p.ws + (job == 0 ? OFF_WGU1 : OFF_WGU2)) + (size_t)seg * 32 * 1024; K = 1024;
    } break;
    case 1: case 7: {
      src = (job == 1 ? p.in[11] : p.in[25]) + 32 * seg; ld = 1024; K = 2816;
      dst = (u16*)(p.ws + (job == 1 ? OFF_WD1 : OFF_WD2)) + (size_t)seg * 32 * 2816;
    } break;
    case 2: {
      const int G = seg; const int c4g = threadIdx.x & 7; const int hf = c4g >> 2;
      int a0 = 0; bool valid = true;
      if (G < 64) { const int base = G < 32 ? 0 : 1024; const int q = G & 31; a0 = base + (q >> 1) * 64 + (q & 1) * 16 + hf * 32; }
      else if (G < 96) a0 = 2048 + (G - 64) * 32 + hf * 16;
      else if (G < 160) { const int base = G < 128 ? 3072 : 4096; const int q = (G - 96) & 31; a0 = base + (q >> 2) * 128 + (q & 3) * 16 + hf * 64; }
      else if (G < 192) a0 = 5120 + (G - 160) * 32 + hf * 16;
      else if (G < 208) { const int q = G - 192; a0 = 6144 + (q >> 1) * 64 + (q & 1) * 16 + hf * 32; }
      else if (G < 210) { a0 = 6656 + (G - 208) * 16 + hf * 32; }
      else if (G == 210) { a0 = 6720; valid = c4g < 2; }
      else if (G < 275) a0 = 6728 + (G - 211) * 32 + hf * 16;
      else valid = false;
      if (!valid) a0 = 0;
      src = p.in[13] + a0 - (valid ? hf * 16 : c4g * 4); ld = 8776; gs = p.in[12]; K = 1024;
      nvalid4 = valid ? 8 : 0;
      dst = (u16*)(p.ws + OFF_WIN) + (size_t)G * 32 * 1024;
    } break;
    default: {
      src = (job == 3 ? p.in[19] : (job == 4 ? p.in[20] : p.in[21])) + 32 * seg; ld = 1024; K = 1024;
      dst = (u16*)(p.ws + (job == 3 ? OFF_WA : (job == 4 ? OFF_WB : OFF_WO))) + (size_t)seg * 32 * 1024;
    } break;
  }
  const int c4 = t & 7, kr = t >> 3;
  {
#pragma unroll
  for (int ps = 0; ps < 4; ++ps) {
    const int kl = ps * 32 + kr; const int k = kt * 128 + kl;
    float4 v = make_float4(0.f, 0.f, 0.f, 0.f);
    if (c4 < nvalid4) v = *(const float4*)(src + (size_t)k * ld + c4 * 4);
    const float s = gs ? gs[k] : 1.0f;
    float* d = ts + kl * 33 + c4 * 4;
    d[0] = v.x * s; d[1] = v.y * s; d[2] = v.z * s; d[3] = v.w * s;
  }
  }
  __syncthreads();
  {
    const int r = t >> 3, kc = t & 7;
    unsigned o[8];
#pragma unroll
    for (int j = 0; j < 8; ++j) o[j] = pack2(ts[(kc * 16 + 2 * j) * 33 + r], ts[(kc * 16 + 2 * j + 1) * 33 + r]);
    uint4* dp = (uint4*)(dst + (size_t)r * K + kt * 128 + kc * 16);
    dp[0] = make_uint4(o[0], o[1], o[2], o[3]);
    dp[1] = make_uint4(o[4], o[5], o[6], o[7]);
  }
  __syncthreads();
}

DI void phase_prep(const Params& p, char* smem) {
  const int t = tid_opaque(), lane = t & 63;
  for (int e = blockIdx.x * NTHR + t; e < NTOKP * 64; e += gridDim.x * NTHR) {
    const int pos = e >> 6, i = e & 63;
    double inv = 1.0;
    for (int j = 0; j < i; ++j) inv *= 0.8659643233600653;
    const float invf = (float)inv;
    const float ang = (float)pos * invf;
    const double a = (double)ang;
    const double qd = rint(a * 0.6366197723675814);
    const double r = (a - qd * 1.5707963267948966) - qd * 6.123233995736766e-17;
    const double r2 = r * r;
    double sn = r2 * (1.0 / 6227020800.0) - 1.0 / 39916800.0;
    sn = sn * r2 + 1.0 / 362880.0; sn = sn * r2 - 1.0 / 5040.0; sn = sn * r2 + 1.0 / 120.0; sn = sn * r2 - 1.0 / 6.0; sn = sn * r2 * r + r;
    double cn = -r2 * (1.0 / 87178291200.0) + 1.0 / 479001600.0;
    cn = cn * r2 - 1.0 / 3628800.0; cn = cn * r2 + 1.0 / 40320.0; cn = cn * r2 - 1.0 / 720.0; cn = cn * r2 + 1.0 / 24.0; cn = cn * r2 - 0.5; cn = cn * r2 + 1.0;
    const int q = ((int)qd) & 3;
    double c, s;
    if (q == 0) { c = cn; s = sn; } else if (q == 1) { c = -sn; s = cn; } else if (q == 2) { c = -cn; s = -sn; } else { c = sn; s = -cn; }
    ((float2*)(p.ws + OFF_TAB))[e] = make_float2((float)c, (float)s);
  }
  for (int e = blockIdx.x * NTHR + t; e < 2 * 2048 * 6; e += gridDim.x * NTHR) {
    const int which = e / (2048 * 6), r = e % (2048 * 6);
    const int row = r / 6, ch = r % 6;
    u16* vt = (u16*)(p.ws + (which ? OFF_BVT : OFF_AVT)) + (size_t)row * VTPAD + NTOKP + ch * 8;
    *(uint4*)vt = make_uint4(0, 0, 0, 0);
  }
  {
    const int wv = blockIdx.x * 8 + (t >> 6), nw = gridDim.x * 8;
    for (int row = wv; row < TPAD; row += nw) {
      u16* xb = (u16*)(p.ws + OFF_XB) + (size_t)row * 1024;
      float* ssp = (float*)(p.ws + OFF_SSP0) + (size_t)row * 16;
      if (row >= T) {
        uint4 z = make_uint4(0, 0, 0, 0);
        ((uint4*)xb)[lane * 2] = z; ((uint4*)xb)[lane * 2 + 1] = z;
        if (lane < 16) ssp[lane] = lane == 0 ? 1024.f : 0.f;
        continue;
      }
      const float4* src = (const float4*)xrow_ptr(p, row);
      float ss = 0.f;
#pragma unroll
      for (int i = 0; i < 4; ++i) {
        const float4 v = src[lane + 64 * i];
        ss += v.x * v.x + v.y * v.y + v.z * v.z + v.w * v.w;
        ((uint2*)xb)[lane + 64 * i] = make_uint2(pack2(v.x, v.y), pack2(v.z, v.w));
      }
#pragma unroll
      for (int m = 32; m >= 1; m >>= 1) ss += shx(ss, m);
      if (lane < 16) ssp[lane] = lane == 0 ? ss : 0.f;
    }
  }
  {
    float* ts = (float*)smem;
    for (int tb = blockIdx.x * 2; tb < 7232; tb += gridDim.x * 2) {
      const int tile = __builtin_amdgcn_readfirstlane(tb + (int)(threadIdx.x >> 8));
      if (tile >= 7232) { __syncthreads(); __syncthreads(); continue; }
      int job, r = tile;
      if (r < 1408) job = 0;
      else if ((r -= 1408) < 704) job = 1;
      else if ((r -= 704) < 2240) job = 2;
      else if ((r -= 2240) < 256) job = 3;
      else if ((r -= 256) < 256) job = 4;
      else if ((r -= 256) < 256) job = 5;
      else if ((r -= 256) < 1408) job = 6;
      else { r -= 1408; job = 7; }
      const int nkt = (job == 1 || job == 7) ? 22 : 8;
      const int sg = r / nkt, kk = r % nkt;
      switch (job) {
        case 0: wt_tile<0>(p, sg, kk, ts); break;
        case 1: wt_tile<1>(p, sg, kk, ts); break;
        case 2: wt_tile<2>(p, sg, kk, ts); break;
        case 3: wt_tile<3>(p, sg, kk, ts); break;
        case 4: wt_tile<4>(p, sg, kk, ts); break;
        case 5: wt_tile<5>(p, sg, kk, ts); break;
        case 6: wt_tile<6>(p, sg, kk, ts); break;
        default: wt_tile<7>(p, sg, kk, ts); break;
      }
    }
  }
}

constexpr int GSTAGE = (256 + 128) * 72;
constexpr int RS_OFF = 2 * GSTAGE * 2;
#define G_DECL uint4 gs0, gs1, gs2, gs3, gs4, gs5, gs6, gs7, gs8, gs9, gs10, gs11, gs12, gs13, gs14, gs15, gs16, gs17; float4 gq0, gq1, gq2, gq3;
#define G_LOAD(S0, S1, S2, S3, S4, S5, kn) { \
    S0 = *(const uint4*)(Ap + (kn)); S1 = *(const uint4*)(Ap + (size_t)64 * lda_ + (kn)); \
    S2 = *(const uint4*)(Ap + (size_t)128 * lda_ + (kn)); S3 = *(const uint4*)(Ap + (size_t)192 * lda_ + (kn)); \
    S4 = *(const uint4*)(Bp + (kn)); S5 = *(const uint4*)(Bp + (size_t)64 * ldb_ + (kn)); }
#define G_STORE(S0, S1, S2, S3, S4, S5, st) { \
    u16* An_ = smem_ + (st) * GSTAGE; u16* Bn_ = An_ + 256 * 72; \
    *(uint4*)(An_ + (lrow) * 72 + lkc * 8) = S0; *(uint4*)(An_ + (lrow + 64) * 72 + lkc * 8) = S1; \
    *(uint4*)(An_ + (lrow + 128) * 72 + lkc * 8) = S2; *(uint4*)(An_ + (lrow + 192) * 72 + lkc * 8) = S3; \
    *(uint4*)(Bn_ + (lrow) * 72 + lkc * 8) = S4; *(uint4*)(Bn_ + (lrow + 64) * 72 + lkc * 8) = S5; }
#define G_LOAD_A(kn) G_LOAD(gs0, gs1, gs2, gs3, gs4, gs5, kn)
#define G_LOAD_B(kn) G_LOAD(gs6, gs7, gs8, gs9, gs10, gs11, kn)
#define G_LOAD_C(kn) G_LOAD(gs12, gs13, gs14, gs15, gs16, gs17, kn)
#define G_STORE_A(st) G_STORE(gs0, gs1, gs2, gs3, gs4, gs5, st)
#define G_STORE_B(st) G_STORE(gs6, gs7, gs8, gs9, gs10, gs11, st)
#define G_STORE_C(st) G_STORE(gs12, gs13, gs14, gs15, gs16, gs17, st)
#define G_COMPUTE(st, SWAPC, ACC) { \
    const u16* As_ = smem_ + (st) * GSTAGE; const u16* Bs_ = As_ + 256 * 72; \
    _Pragma("unroll") for (int kk = 0; kk < 4; ++kk) { \
      bf16x8 a0 = *(const bf16x8*)(As_ + (gwm * 64 + glr) * 72 + kk * 16 + glh * 8); \
      bf16x8 a1 = *(const bf16x8*)(As_ + (gwm * 64 + 32 + glr) * 72 + kk * 16 + glh * 8); \
      bf16x8 b0 = *(const bf16x8*)(Bs_ + (gwn * 64 + glr) * 72 + kk * 16 + glh * 8); \
      bf16x8 b1 = *(const bf16x8*)(Bs_ + (gwn * 64 + 32 + glr) * 72 + kk * 16 + glh * 8); \
      if (SWAPC) { \
        ACC[0][0] = MFMA(b0, a0, ACC[0][0]); ACC[0][1] = MFMA(b1, a0, ACC[0][1]); \
        ACC[1][0] = MFMA(b0, a1, ACC[1][0]); ACC[1][1] = MFMA(b1, a1, ACC[1][1]); \
      } else { \
        ACC[0][0] = MFMA(a0, b0, ACC[0][0]); ACC[0][1] = MFMA(a0, b1, ACC[0][1]); \
        ACC[1][0] = MFMA(a1, b0, ACC[1][0]); ACC[1][1] = MFMA(a1, b1, ACC[1][1]); } } }
#define G_STEP(k, SL, SS, SWAPC, ACC) if ((k) < nk_) { \
    if ((k) + 3 < nk_) G_LOAD_##SL(((k) + 3) << 6) \
    G_COMPUTE((k) & 1, SWAPC, ACC) \
    if ((k) + 1 < nk_) G_STORE_##SS(((k) + 1) & 1) \
    __syncthreads(); }
#define G_ISSUE(A_, LDA, B_, LDB, M0, N0, SSP) { \
    const int t_ = tid_opaque(); const int lrow = t_ >> 3, lkc = t_ & 7; const int lda_ = (LDA), ldb_ = (LDB); \
    const u16* Ap = (A_) + (size_t)((M0) + lrow) * lda_ + lkc * 8; \
    const u16* Bp = (B_) + (size_t)((N0) + lrow) * ldb_ + lkc * 8; \
    G_LOAD_A(0) G_LOAD_B(64) G_LOAD_C(128) \
    const float* ssp_ = (SSP); \
    if (ssp_ && t_ < 256) { const float4* q_ = (const float4*)(ssp_ + (size_t)((M0) + t_) * 16); gq0 = q_[0]; gq1 = q_[1]; gq2 = q_[2]; gq3 = q_[3]; } }
#define G_RSFIN(RS) { const int t_ = tid_opaque(); if (t_ < 256) { \
    const float s_ = ((gq0.x + gq0.y) + (gq0.z + gq0.w)) + ((gq1.x + gq1.y) + (gq1.z + gq1.w)) + ((gq2.x + gq2.y) + (gq2.z + gq2.w)) + ((gq3.x + gq3.y) + (gq3.z + gq3.w)); \
    (RS)[t_] = rsqrtf(s_ * (1.0f / 1024.0f) + EPS); } }
#define G_RUN(A_, LDA, B_, LDB, K_, M0, N0, SMEM, ACC, SWAPC) { \
    const int t_ = tid_opaque(), glane = t_ & 63, gw = t_ >> 6, gwm = gw >> 1, gwn = gw & 1; \
    const int glr = glane & 31, glh = glane >> 5; const int lrow = t_ >> 3, lkc = t_ & 7; const int lda_ = (LDA), ldb_ = (LDB); \
    u16* smem_ = (SMEM); \
    const u16* Ap = (A_) + (size_t)((M0) + lrow) * lda_ + lkc * 8; \
    const u16* Bp = (B_) + (size_t)((N0) + lrow) * ldb_ + lkc * 8; \
    const int nk_ = (K_) >> 6; \
    G_STORE_A(0) \
    __syncthreads(); \
    for (int ks = 0; ks < nk_; ks += 3) { \
      G_STEP(ks, A, B, SWAPC, ACC) \
      G_STEP(ks + 1, B, C, SWAPC, ACC) \
      G_STEP(ks + 2, C, A, SWAPC, ACC) } }

DI bool gemm_tile(int vbid, int it, int nt_n, int& m0, int& n0) {
  if (gridDim.x == 256) {
    const int x = vbid & 7, r = vbid >> 3;
    const int L = (it * 8 + x) * 32 + r;
    if (L >= NT_M * nt_n) return false;
    const int full = (NT_M / 4) * 4 * nt_n;
    int m, n;
    if (L < full) { const int band = L / (4 * nt_n), idx = L - band * 4 * nt_n; n = idx >> 2; m = band * 4 + (idx & 3); }
    else { const int idx = L - full; constexpr int rem = NT_M % 4; n = idx / rem; m = (NT_M / 4) * 4 + idx % rem; }
    m0 = m * 256; n0 = n * 128;
    return true;
  }
  const int tile = blockIdx.x + it * gridDim.x;
  m0 = (tile / nt_n) * 256; n0 = (tile % nt_n) * 128;
  return tile < NT_M * nt_n;
}
DI int gemm_rounds(int nt_n) {
  return (NT_M * nt_n + gridDim.x - 1) / gridDim.x;
}

DI void zero_acc(f32x16 (&acc)[2][2]) {
#pragma unroll
  for (int a = 0; a < 2; ++a)
#pragma unroll
    for (int b = 0; b < 2; ++b)
#pragma unroll
      for (int i = 0; i < 16; ++i) acc[a][b][i] = 0.f;
}

DI void load_rs(const float* ssp, int m0, float* rs_s) {
  __syncthreads();
  const int t = threadIdx.x;
  if (t < 256) {
    const float4* q = (const float4*)(ssp + (size_t)(m0 + t) * 16);
    const float4 a = q[0], b = q[1], c = q[2], d = q[3];
    const float s = ((a.x + a.y) + (a.z + a.w)) + ((b.x + b.y) + (b.z + b.w)) + ((c.x + c.y) + (c.z + c.w)) + ((d.x + d.y) + (d.z + d.w));
    rs_s[t] = rsqrtf(s * (1.0f / 1024.0f) + EPS);
  }
}

typedef __attribute__((ext_vector_type(4))) float f32x4;
constexpr int P8_HT = 128 * 64;
constexpr int RS8_OFF = 8 * P8_HT * 2;
DI int p8_lds_byte(int r, int c) {
  const int st = (r >> 4) * 2 + (c >> 5), rr = r & 15, cc = c & 31, ob = rr * 64 + cc * 2;
  return st * 1024 + (ob ^ (((ob >> 9) & 1) << 5));
}
DI void p8_stage_rc(int b, int& R, int& C) {
  const int st = b / 1024, sb = b % 1024, swz = sb ^ (((sb >> 9) & 1) << 5);
  R = (st >> 1) * 16 + swz / 64; C = (st & 1) * 32 + (swz % 64) / 2;
}
typedef __attribute__((address_space(3))) unsigned lds_u32;
typedef __attribute__((address_space(3))) unsigned char lds_u8;
typedef __attribute__((address_space(3))) bf16x8 lds_bf16x8;
DI void gemm8_tile(const u16* __restrict__ A, const u16* __restrict__ Bt, const int K, const int brow, const int bcol,
                   u16* shm, f32x4 (&acc)[2][2][4][2], const int klen = 0) {
#define P8_SA(b, h) (((b) * 2 + (h)) * 16384)
#define P8_SB(b, h) ((4 + (b) * 2 + (h)) * 16384)
#define P8_STAGE(P, BASE, br, kt) do { const char* _gb = (const char*)(BASE) + ((long)(br) * K + (long)(kt) * 64) * 2; \
    __builtin_amdgcn_global_load_lds((const unsigned*)(_gb + so0), (lds_u32*)(lds + (P) + lo0), 16, 0, 0); \
    __builtin_amdgcn_global_load_lds((const unsigned*)(_gb + (long)K * 128 + so0), (lds_u32*)(lds + (P) + lo0 + 8192), 16, 0, 0); } while (0)
#define P8_LDA(dst, b, h) _Pragma("unroll") for (int m = 0; m < 4; ++m) _Pragma("unroll") for (int k = 0; k < 2; ++k) \
    dst[m][k] = *(const lds_bf16x8*)(lds + P8_SA(b, h) + aoff + m * 2048 + k * 1024)
#define P8_LDB(dst, b, h) _Pragma("unroll") for (int n = 0; n < 2; ++n) _Pragma("unroll") for (int k = 0; k < 2; ++k) \
    dst[n][k] = *(const lds_bf16x8*)(lds + P8_SB(b, h) + boff + n * 2048 + k * 1024)
#define P8_MMA(ai, bj, At_, Bt_) do { __builtin_amdgcn_s_setprio(1); \
    _Pragma("unroll") for (int m = 0; m < 4; ++m) _Pragma("unroll") for (int n = 0; n < 2; ++n) _Pragma("unroll") for (int k = 0; k < 2; ++k) \
      acc[ai][bj][m][n] = __builtin_amdgcn_mfma_f32_16x16x32_bf16(Bt_[n][k], At_[m][k], acc[ai][bj][m][n], 0, 0, 0); \
    __builtin_amdgcn_s_setprio(0); } while (0)
#define P8_WAIT_V(n) asm volatile("s_waitcnt vmcnt(" #n ")" ::: "memory")
#define P8_WAIT_L(n) asm volatile("s_waitcnt lgkmcnt(" #n ")" ::: "memory")
#define P8_BAR __builtin_amdgcn_s_barrier()
#define P8_SCHED __builtin_amdgcn_sched_barrier(0)
  const int HALF = 128;
  const int tid8 = tid_opaque();
  const int wid = __builtin_amdgcn_readfirstlane(tid8 >> 6), lane = tid8 & 63, wr = wid >> 2, wc = wid & 3, fr = lane & 15, fq = lane >> 4;
  lds_u8* lds = (lds_u8*)shm;
  const int lo0 = tid8 * 16;
  const int aoff = p8_lds_byte(wr * 64 + fr, fq * 8), boff = p8_lds_byte(wc * 32 + fr, fq * 8);
  unsigned so0;
  { int r_, c_; p8_stage_rc(lo0, r_, c_); so0 = (unsigned)(r_ * K + c_) * 2u; }
  bf16x8 At[4][2], B0[2][2], B1[2][2];
  const int nt = (klen ? klen : K) / 64;
  P8_STAGE(P8_SB(0, 0), Bt, bcol, 0); P8_STAGE(P8_SA(0, 0), A, brow, 0);
  P8_STAGE(P8_SB(0, 1), Bt, bcol + HALF, 0); P8_STAGE(P8_SA(0, 1), A, brow + HALF, 0);
  if (wr == 1) P8_BAR;
  P8_WAIT_V(4); P8_BAR;
  P8_STAGE(P8_SB(1, 0), Bt, bcol, 1); P8_STAGE(P8_SA(1, 0), A, brow, 1); P8_STAGE(P8_SB(1, 1), Bt, bcol + HALF, 1);
  P8_WAIT_V(6); P8_BAR;
  for (int t = 0; t < nt - 2; t += 2) {
    P8_LDB(B0, 0, 0); P8_SCHED; P8_LDA(At, 0, 0); P8_STAGE(P8_SA(1, 1), A, brow + HALF, t + 1);
    P8_WAIT_L(8); P8_BAR; P8_WAIT_L(0); P8_MMA(0, 0, At, B0); P8_BAR; P8_SCHED;
    P8_LDB(B1, 0, 1); P8_STAGE(P8_SB(0, 0), Bt, bcol, t + 2);
    P8_BAR; P8_WAIT_L(0); P8_MMA(0, 1, At, B1); P8_BAR;
    P8_LDA(At, 0, 1); P8_STAGE(P8_SA(0, 0), A, brow, t + 2);
    P8_BAR; P8_WAIT_L(0); P8_MMA(1, 0, At, B0); P8_BAR; P8_SCHED;
    P8_STAGE(P8_SB(0, 1), Bt, bcol + HALF, t + 2);
    P8_WAIT_V(6); P8_BAR; P8_MMA(1, 1, At, B1); P8_BAR;
    P8_LDB(B0, 1, 0); P8_SCHED; P8_LDA(At, 1, 0); P8_STAGE(P8_SA(0, 1), A, brow + HALF, t + 2);
    P8_WAIT_L(8); P8_BAR; P8_WAIT_L(0); P8_MMA(0, 0, At, B0); P8_BAR; P8_SCHED;
    P8_LDB(B1, 1, 1); P8_STAGE(P8_SB(1, 0), Bt, bcol, t + 3);
    P8_BAR; P8_WAIT_L(0); P8_MMA(0, 1, At, B1); P8_BAR;
    P8_LDA(At, 1, 1); P8_STAGE(P8_SA(1, 0), A, brow, t + 3);
    P8_BAR; P8_WAIT_L(0); P8_MMA(1, 0, At, B0); P8_BAR; P8_SCHED;
    P8_STAGE(P8_SB(1, 1), Bt, bcol + HALF, t + 3);
    P8_WAIT_V(6); P8_BAR; P8_MMA(1, 1, At, B1); P8_BAR;
  }
  { P8_LDB(B0, 0, 0); P8_LDA(At, 0, 0); P8_STAGE(P8_SA(1, 1), A, brow + HALF, nt - 1);
    P8_BAR; P8_WAIT_L(0); P8_MMA(0, 0, At, B0); P8_BAR;
    P8_LDB(B1, 0, 1); P8_BAR; P8_WAIT_L(0); P8_MMA(0, 1, At, B1); P8_BAR;
    P8_LDA(At, 0, 1); P8_WAIT_V(4); P8_BAR; P8_WAIT_L(0); P8_MMA(1, 0, At, B0); P8_MMA(1, 1, At, B1); P8_BAR; }
  { P8_LDB(B0, 1, 0); P8_LDA(At, 1, 0); P8_WAIT_V(2); P8_BAR; P8_WAIT_L(0); P8_MMA(0, 0, At, B0); P8_BAR;
    P8_LDB(B1, 1, 1); P8_WAIT_V(0); P8_BAR; P8_WAIT_L(0); P8_MMA(0, 1, At, B1); P8_BAR;
    P8_LDA(At, 1, 1); P8_BAR; P8_WAIT_L(0); P8_MMA(1, 0, At, B0); P8_MMA(1, 1, At, B1); P8_BAR; }
  if (wr == 0) P8_BAR;
}

DI void phase_gateup(const Params& p, char* smem, size_t off_ssp, size_t off_w, int vbid) {
  const u16* A = (const u16*)(p.ws + OFF_XB);
  const u16* B = (const u16*)(p.ws + off_w);
  const float* ssp = (const float*)(p.ws + off_ssp);
  u16* hid = (u16*)(p.ws + OFF_HID);
  float* rs_s = (float*)(smem + RS8_OFF);
  const int nr = gemm_rounds(22);
  for (int it = 0; it < nr; ++it) {
    int m0, n0;
    if (!gemm_tile(vbid, it, 22, m0, n0)) continue;
    n0 *= 2;
    load_rs(ssp, m0, rs_s);
    __syncthreads();
    f32x4 acc[2][2][4][2];
#pragma unroll
    for (int a_ = 0; a_ < 2; ++a_)
#pragma unroll
      for (int b_ = 0; b_ < 2; ++b_)
#pragma unroll
        for (int m_ = 0; m_ < 4; ++m_)
#pragma unroll
          for (int n_ = 0; n_ < 2; ++n_) acc[a_][b_][m_][n_] = (f32x4){0.f, 0.f, 0.f, 0.f};
    gemm8_tile(A, B, 1024, m0, n0, (u16*)smem, acc);
    const int t = tid_opaque(), lane = t & 63, wid = t >> 6, wr = wid >> 2, wc = wid & 3, fr = lane & 15, fq = lane >> 4;
#pragma unroll
    for (int ai = 0; ai < 2; ++ai)
#pragma unroll
      for (int m = 0; m < 4; ++m) {
        const int rl = ai * 128 + wr * 64 + m * 16 + fr; const int row = m0 + rl;
        if (row < T) {
          const float r = rs_s[rl];
#pragma unroll
          for (int bj = 0; bj < 2; ++bj) {
            float hv[4];
#pragma unroll
            for (int j = 0; j < 4; ++j) {
              const float gg = acc[ai][bj][m][0][j] * r, uu = acc[ai][bj][m][1][j] * r;
              hv[j] = gg / (1.0f + __expf(-gg)) * uu;
            }
            const int hc = ((n0 + bj * 128 + wc * 32) >> 1) + fq * 4;
            *(uint2*)(hid + (size_t)row * 2816 + hc) = make_uint2(pack2(hv[0], hv[1]), pack2(hv[2], hv[3]));
          }
        }
      }
  }
}

DI void phase_merge8(const Params& p, char* smem, int vbid) {
  const u16* OA = (const u16*)(p.ws + OFF_OA); const u16* OB = (const u16*)(p.ws + OFF_OB);
  const u16* WA = (const u16*)(p.ws + OFF_WA); const u16* WB = (const u16*)(p.ws + OFF_WB);
  const u16* G = (const u16*)(p.ws + OFF_G);
  u16* MB = (u16*)(p.ws + OFF_MB);
  float* tmp = (float*)(p.ws + OFF_HID);
  float* part_buf = (float*)(p.ws + OFF_BQ);
  const bool splitmode = gridDim.x == 256;
  const int nr = splitmode ? 1 : gemm_rounds(4);
  const int nitem = splitmode ? 12 * 8 : 0;
  for (int itx = 0; itx < nr + (nitem ? 1 : 0); ++itx) {
    int m0, n0, slice = -1, spass = 0;
    if (itx < nr) {
      if (!gemm_tile(vbid, itx, 4, m0, n0)) continue;
      n0 *= 2;
    } else {
      if (vbid >= nitem) continue;
      const int tl = vbid >> 3; spass = (vbid >> 2) & 1; slice = vbid & 3;
      m0 = (64 + (tl >> 2)) * 256; n0 = (tl & 3) * 256;
    }
#pragma unroll 1
    for (int pass = (slice < 0 ? 0 : spass); pass < (slice < 0 ? 2 : spass + 1); ++pass) {
      __syncthreads();
      f32x4 acc[2][2][4][2];
#pragma unroll
      for (int a_ = 0; a_ < 2; ++a_)
#pragma unroll
        for (int b_ = 0; b_ < 2; ++b_)
#pragma unroll
          for (int m_ = 0; m_ < 4; ++m_)
#pragma unroll
            for (int n_ = 0; n_ < 2; ++n_) acc[a_][b_][m_][n_] = (f32x4){0.f, 0.f, 0.f, 0.f};
      {
        const int koff = slice < 0 ? 0 : slice * 256;
        gemm8_tile((pass ? OB : OA) + koff, (pass ? WB : WA) + koff, 1024, m0, n0, (u16*)smem, acc, slice < 0 ? 1024 : 256);
      }
      const int t = tid_opaque(), lane = t & 63, wid = t >> 6, wr = wid >> 2, wc = wid & 3, fr = lane & 15, fq = lane >> 4;
      float* pb = part_buf + (size_t)(pass * 4 + (slice < 0 ? 0 : slice)) * 768 * 1024;
#pragma unroll
      for (int ai = 0; ai < 2; ++ai)
#pragma unroll
        for (int m = 0; m < 4; ++m) {
          const int row = m0 + ai * 128 + wr * 64 + m * 16 + fr;
          if (row >= T) continue;
#pragma unroll
          for (int bj = 0; bj < 2; ++bj)
#pragma unroll
            for (int n = 0; n < 2; ++n) {
              const int col = n0 + bj * 128 + wc * 32 + n * 16 + fq * 4;
              if (slice >= 0) {
                *(float4*)(pb + (size_t)(row - 16384) * 1024 + col) = make_float4(acc[ai][bj][m][n][0], acc[ai][bj][m][n][1], acc[ai][bj][m][n][2], acc[ai][bj][m][n][3]);
                continue;
              }
              const uint2 gg = *(const uint2*)(G + (size_t)row * 2048 + pass * 1024 + col);
              const float g0 = __uint_as_float(gg.x << 16), g1 = __uint_as_float(gg.x & 0xffff0000u);
              const float g2 = __uint_as_float(gg.y << 16), g3 = __uint_as_float(gg.y & 0xffff0000u);
              float4 v = make_float4(g0 * acc[ai][bj][m][n][0], g1 * acc[ai][bj][m][n][1], g2 * acc[ai][bj][m][n][2], g3 * acc[ai][bj][m][n][3]);
              float* tp = tmp + (size_t)row * 1024 + col;
              if (pass == 0) *(float4*)tp = v;
              else {
                const float4 u = *(const float4*)tp;
                *(uint2*)(MB + (size_t)row * 1024 + col) = make_uint2(pack2(u.x + v.x, u.y + v.y), pack2(u.z + v.z, u.w + v.w));
              }
            }
        }
    }
  }
  if (splitmode) {
    gbar(p, smem);
    const int t = tid_opaque(), lane = t & 63;
    const int wv = vbid * 8 + (t >> 6);
    for (int rr = wv; rr < T - 16384; rr += 256 * 8) {
      const int row = 16384 + rr;
#pragma unroll
      for (int i = 0; i < 4; ++i) {
        const int col = (lane + 64 * i) * 4;
        float4 sa = make_float4(0.f, 0.f, 0.f, 0.f), sb = sa;
        for (int sl = 0; sl < 4; ++sl) {
          const float4 qa = *(const float4*)(part_buf + ((size_t)sl * 768 + rr) * 1024 + col);
          const float4 qb = *(const float4*)(part_buf + ((size_t)(4 + sl) * 768 + rr) * 1024 + col);
          sa.x += qa.x; sa.y += qa.y; sa.z += qa.z; sa.w += qa.w;
          sb.x += qb.x; sb.y += qb.y; sb.z += qb.z; sb.w += qb.w;
        }
        const uint2 ga = *(const uint2*)(G + (size_t)row * 2048 + col);
        const uint2 gb = *(const uint2*)(G + (size_t)row * 2048 + 1024 + col);
        const float m0v = __uint_as_float(ga.x << 16) * sa.x + __uint_as_float(gb.x << 16) * sb.x;
        const float m1v = __uint_as_float(ga.x & 0xffff0000u) * sa.y + __uint_as_float(gb.x & 0xffff0000u) * sb.y;
        const float m2v = __uint_as_float(ga.y << 16) * sa.z + __uint_as_float(gb.y << 16) * sb.z;
        const float m3v = __uint_as_float(ga.y & 0xffff0000u) * sa.w + __uint_as_float(gb.y & 0xffff0000u) * sb.w;
        *(uint2*)(MB + (size_t)row * 1024 + col) = make_uint2(pack2(m0v, m1v), pack2(m2v, m3v));
      }
    }
  }
}

template <int RESID_ORIG>
DI void phase_resid8(const Params& p, char* smem, const u16* A, int K, size_t off_w, float factor, size_t off_ssp_out, int vbid) {
  const u16* B = (const u16*)(p.ws + off_w);
  float* xf = (float*)(p.ws + OFF_XF);
  u16* xb = (u16*)(p.ws + OFF_XB);
  float* sspo = (float*)(p.ws + off_ssp_out);
  float* part_buf = (float*)(p.ws + OFF_G);
  const bool splitmode = gridDim.x == 256;
  const int nslice = K >> 8;
  const int nr = splitmode ? 1 : gemm_rounds(4);
  const int nitem = splitmode ? 12 * nslice : 0;
  for (int itx = 0; itx < nr + (nitem + 255) / 256; ++itx) {
    int m0, n0, slice = -1;
    if (itx < nr) {
      if (!gemm_tile(vbid, itx, 4, m0, n0)) continue;
      n0 *= 2;
    } else {
      const int id = (itx - nr) * 256 + vbid;
      if (id >= nitem) continue;
      const int tl = id / nslice; slice = id - tl * nslice;
      m0 = (64 + (tl >> 2)) * 256; n0 = (tl & 3) * 256;
    }
    __syncthreads();
    f32x4 acc[2][2][4][2];
#pragma unroll
    for (int a_ = 0; a_ < 2; ++a_)
#pragma unroll
      for (int b_ = 0; b_ < 2; ++b_)
#pragma unroll
        for (int m_ = 0; m_ < 4; ++m_)
#pragma unroll
          for (int n_ = 0; n_ < 2; ++n_) acc[a_][b_][m_][n_] = (f32x4){0.f, 0.f, 0.f, 0.f};
    {
      const int koff = slice < 0 ? 0 : slice * 256;
      gemm8_tile(A + koff, B + koff, K, m0, n0, (u16*)smem, acc, slice < 0 ? K : 256);
    }
    const int t = tid_opaque(), lane = t & 63, wid = t >> 6, wr = wid >> 2, wc = wid & 3, fr = lane & 15, fq = lane >> 4;
    const int pn = n0 >> 8;
    if (slice >= 0) {
      float* pb = part_buf + (size_t)slice * 768 * 1024;
#pragma unroll
      for (int ai = 0; ai < 2; ++ai)
#pragma unroll
        for (int m = 0; m < 4; ++m) {
          const int row = m0 + ai * 128 + wr * 64 + m * 16 + fr;
          if (row >= T) continue;
#pragma unroll
          for (int bj = 0; bj < 2; ++bj)
#pragma unroll
            for (int n = 0; n < 2; ++n) {
              const int col = n0 + bj * 128 + wc * 32 + n * 16 + fq * 4;
              *(float4*)(pb + (size_t)(row - 16384) * 1024 + col) = make_float4(acc[ai][bj][m][n][0], acc[ai][bj][m][n][1], acc[ai][bj][m][n][2], acc[ai][bj][m][n][3]);
            }
        }
      continue;
    }
#pragma unroll
    for (int ai = 0; ai < 2; ++ai)
#pragma unroll
      for (int m = 0; m < 4; ++m) {
        const int row = m0 + ai * 128 + wr * 64 + m * 16 + fr;
        const bool ok = row < T;
        float part = 0.f;
        if (ok) {
          const float* rsrc = RESID_ORIG ? xrow_ptr(p, row) : (xf + (size_t)row * 1024);
#pragma unroll
          for (int bj = 0; bj < 2; ++bj)
#pragma unroll
            for (int n = 0; n < 2; ++n) {
              const int col = n0 + bj * 128 + wc * 32 + n * 16 + fq * 4;
              const float4 xr = *(const float4*)(rsrc + col);
              float4 v;
              v.x = xr.x + factor * acc[ai][bj][m][n][0]; v.y = xr.y + factor * acc[ai][bj][m][n][1];
              v.z = xr.z + factor * acc[ai][bj][m][n][2]; v.w = xr.w + factor * acc[ai][bj][m][n][3];
              *(float4*)(xf + (size_t)row * 1024 + col) = v;
              *(uint2*)(xb + (size_t)row * 1024 + col) = make_uint2(pack2(v.x, v.y), pack2(v.z, v.w));
              part += v.x * v.x + v.y * v.y + v.z * v.z + v.w * v.w;
            }
        }
        part += shx(part, 16); part += shx(part, 32);
        if (ok && fq == 0) sspo[(size_t)row * 16 + pn * 4 + wc] = part;
      }
  }
  if (splitmode) {
    gbar(p, smem);
    const int t = tid_opaque(), lane = t & 63;
    const int wv = vbid * 8 + (t >> 6);
    const float* px_ = p.in[0]; const float* ps_ = p.in[1];
    for (int rr = wv; rr < T - 16384; rr += 256 * 8) {
      const int row = 16384 + rr;
      const float* rsrc = RESID_ORIG ? (row < TP ? px_ + (size_t)(8192 + row - NTOKP - 16) * 1024 : ps_ + (size_t)(row - TP) * 1024) : (xf + (size_t)row * 1024);
      float ss = 0.f;
#pragma unroll
      for (int i = 0; i < 4; ++i) {
        const int col = (lane + 64 * i) * 4;
        float4 sum = make_float4(0.f, 0.f, 0.f, 0.f);
        for (int sl = 0; sl < nslice; ++sl) {
          const float4 q = *(const float4*)(part_buf + ((size_t)sl * 768 + rr) * 1024 + col);
          sum.x += q.x; sum.y += q.y; sum.z += q.z; sum.w += q.w;
        }
        const float4 xr = *(const float4*)(rsrc + col);
        float4 v;
        v.x = xr.x + factor * sum.x; v.y = xr.y + factor * sum.y; v.z = xr.z + factor * sum.z; v.w = xr.w + factor * sum.w;
        *(float4*)(xf + (size_t)row * 1024 + col) = v;
        *(uint2*)(xb + (size_t)row * 1024 + col) = make_uint2(pack2(v.x, v.y), pack2(v.z, v.w));
        ss += v.x * v.x + v.y * v.y + v.z * v.z + v.w * v.w;
      }
#pragma unroll
      for (int mm = 32; mm >= 1; mm >>= 1) ss += shx(ss, mm);
      if (lane < 16) sspo[(size_t)row * 16 + lane] = lane == 0 ? ss : 0.f;
    }
  }
}

template <int RESID_ORIG>
DI void phase_resid(const Params& p, char* smem, const u16* A, int lda, int K, size_t off_w, float factor, size_t off_ssp_out, int vbid) {
  const u16* B = (const u16*)(p.ws + off_w);
  float* xf = (float*)(p.ws + OFF_XF);
  u16* xb = (u16*)(p.ws + OFF_XB);
  float* sspo = (float*)(p.ws + off_ssp_out);
  G_DECL
  const int nr = gemm_rounds(8);
  int it = 0, m0 = 0, n0 = 0;
  while (it < nr && !gemm_tile(vbid, it, 8, m0, n0)) ++it;
  if (it < nr) G_ISSUE(A, lda, B, K, m0, n0, (const float*)nullptr)
  while (it < nr) {
    f32x16 acc[2][2]; zero_acc(acc);
    G_RUN(A, lda, B, K, K, m0, n0, (u16*)smem, acc, true)
    const int cm0 = m0, cn0 = n0; const int nt = cn0 >> 7;
    ++it;
    while (it < nr && !gemm_tile(vbid, it, 8, m0, n0)) ++it;
    if (it < nr) G_ISSUE(A, lda, B, K, m0, n0, (const float*)nullptr)
    const int t = tid_opaque(), lane = t & 63, w = t >> 6, wm = w >> 1, wn = w & 1, lr = lane & 31, lh = lane >> 5;
#pragma unroll
    for (int mi = 0; mi < 2; ++mi) {
      const int row = cm0 + wm * 64 + mi * 32 + lr;
      const bool ok = row < T;
      float part = 0.f;
      if (ok) {
        const float* rsrc = RESID_ORIG ? xrow_ptr(p, row) : (xf + (size_t)row * 1024);
#pragma unroll
        for (int ni = 0; ni < 2; ++ni)
#pragma unroll
          for (int g = 0; g < 4; ++g) {
            const int col = cn0 + wn * 64 + ni * 32 + 8 * g + 4 * lh;
            const float4 xr = *(const float4*)(rsrc + col);
            float4 v;
            v.x = xr.x + factor * acc[mi][ni][4 * g]; v.y = xr.y + factor * acc[mi][ni][4 * g + 1];
            v.z = xr.z + factor * acc[mi][ni][4 * g + 2]; v.w = xr.w + factor * acc[mi][ni][4 * g + 3];
            *(float4*)(xf + (size_t)row * 1024 + col) = v;
            *(uint2*)(xb + (size_t)row * 1024 + col) = make_uint2(pack2(v.x, v.y), pack2(v.z, v.w));
            part += v.x * v.x + v.y * v.y + v.z * v.z + v.w * v.w;
          }
      }
      part += shx(part, 32);
      if (ok && lh == 0) sspo[(size_t)row * 16 + nt * 2 + wn] = part;
    }
  }
}

DI void phase_win(const Params& p, char* smem, int vbid) {
  const u16* A = (const u16*)(p.ws + OFF_XB);
  const u16* B = (const u16*)(p.ws + OFF_WIN);
  const float* ssp = (const float*)(p.ws + OFF_SSP1);
  const float2* tab = (const float2*)(p.ws + OFF_TAB);
  u16* AQ = (u16*)(p.ws + OFF_AQ); u16* BQ = (u16*)(p.ws + OFF_BQ); u16* IQ = (u16*)(p.ws + OFF_IQ);
  float* IW = (float*)(p.ws + OFF_IW); u16* G = (u16*)(p.ws + OFF_G);
  float* out = p.out;
  float* rs_all = (float*)(smem + RS_OFF);
  G_DECL
  const int nr = gemm_rounds(69);
  int it = 0, m0n = 0, n0n = 0, par = 0;
  while (it < nr && !gemm_tile(vbid, it, 69, m0n, n0n)) ++it;
  while (it < nr) {
    float* rs_s = rs_all + par * 256; par ^= 1;
    load_rs(ssp, m0n, rs_s);
    G_ISSUE(A, 1024, B, 1024, m0n, n0n, (const float*)nullptr)
    f32x16 acc[2][2]; zero_acc(acc);
    const int vgw = __builtin_amdgcn_readfirstlane((n0n >> 6) + ((tid_opaque() >> 6) & 1));
    const bool swapw = !((vgw >= 32 && vgw < 48) || (vgw >= 80 && vgw < 96));
    if (swapw) G_RUN(A, 1024, B, 1024, 1024, m0n, n0n, (u16*)smem, acc, true)
    else G_RUN(A, 1024, B, 1024, 1024, m0n, n0n, (u16*)smem, acc, false)
    const int m0 = m0n, n0 = n0n;
    const int t = tid_opaque(), lane = t & 63, w = t >> 6, wm = w >> 1, wn = w & 1, lr = lane & 31, lh = lane >> 5;
    const int vg = vgw;
    if (!swapw) {
      const int q = vg < 48 ? vg - 32 : vg - 80;
      u16* vtb = (u16*)(p.ws + (vg < 48 ? OFF_AVT : OFF_BVT));
#pragma unroll
      for (int mi = 0; mi < 2; ++mi)
#pragma unroll
        for (int g = 0; g < 4; ++g) {
          const int rl = wm * 64 + mi * 32 + 8 * g + 4 * lh; const int row = m0 + rl;
          if (row < TP) {
            const int bb = row >= NTOKP ? 1 : 0; const int tok = row - bb * NTOKP;
            const float r0 = rs_s[rl], r1 = rs_s[rl + 1], r2 = rs_s[rl + 2], r3 = rs_s[rl + 3];
#pragma unroll
            for (int ni = 0; ni < 2; ++ni) {
              const int d = (q & 1) * 64 + ni * 32 + lr;
              u16* dst = vtb + ((size_t)(bb * 8 + (q >> 1)) * 128 + d) * VTPAD + tok;
              *(uint2*)dst = make_uint2(pack2(acc[mi][ni][4 * g] * r0, acc[mi][ni][4 * g + 1] * r1),
                                        pack2(acc[mi][ni][4 * g + 2] * r2, acc[mi][ni][4 * g + 3] * r3));
            }
          }
        }
#pragma unroll
      for (int mi = 0; mi < 2; ++mi)
#pragma unroll
        for (int i = 0; i < 16; ++i) {
          const int rl = wm * 64 + mi * 32 + crow(i, lh); const int row = m0 + rl;
          if (row >= T) continue;
          const float r = rs_s[rl];
          const float v0 = acc[mi][0][i] * r, v1 = acc[mi][1][i] * r;
          const bool smp = row >= TP;
          const int orow = smp ? row - TP : row;
          float* d = out + (vg < 48 ? (smp ? O_AVS : O_AVP) : (smp ? O_BVS : O_BVP)) + (size_t)orow * 1024 + q * 64 + lr;
          d[0] = v0; d[32] = v1;
        }
    } else {
#pragma unroll
      for (int mi = 0; mi < 2; ++mi) {
        int rl = wm * 64 + mi * 32 + lr;
        asm volatile("" : "+v"(rl));
        const int row = m0 + rl;
        if (row >= T) continue;
        const float r = rs_s[rl];
        const bool smp = row >= TP;
        const int orow = smp ? row - TP : row;
        const int bb = (!smp && row >= NTOKP) ? 1 : 0;
        const int tok = row - bb * NTOKP;
        const int pos = smp ? (NCACHE + (orow & 31)) : tok;
#pragma unroll
        for (int g = 0; g < 4; ++g) {
          const int c0 = 8 * g + 4 * lh;
          float v0[4], v1[4];
#pragma unroll
          for (int j = 0; j < 4; ++j) { v0[j] = acc[mi][0][4 * g + j] * r; v1[j] = acc[mi][1][4 * g + j] * r; }
          if (vg < 32 || (vg >= 96 && vg < 105)) {
            float o0[4], o1[4];
#pragma unroll
            for (int j = 0; j < 4; ++j) {
              const float2 cs = tab[pos * 64 + 2 * (c0 + j)];
              o0[j] = v0[j] * cs.x - v1[j] * cs.y; o1[j] = v1[j] * cs.x + v0[j] * cs.y;
            }
            if (vg < 16) {
              u16* d = AQ + (size_t)row * 1024 + vg * 64 + c0;
              *(uint2*)d = make_uint2(pack2(o0[0] * QA_SCALE, o0[1] * QA_SCALE), pack2(o0[2] * QA_SCALE, o0[3] * QA_SCALE));
              *(uint2*)(d + 32) = make_uint2(pack2(o1[0] * QA_SCALE, o1[1] * QA_SCALE), pack2(o1[2] * QA_SCALE, o1[3] * QA_SCALE));
            } else if (vg < 32) {
              float* d = out + (smp ? O_AKS : O_AKP) + (size_t)orow * 1024 + (vg - 16) * 64 + c0;
              *(float4*)d = make_float4(o0[0], o0[1], o0[2], o0[3]);
              *(float4*)(d + 32) = make_float4(o1[0], o1[1], o1[2], o1[3]);
              if (!smp) {
                const int q = vg - 16;
                u16* db = (u16*)(p.ws + OFF_AKB) + ((size_t)(bb * 8 + (q >> 1)) * NTOKP + tok) * 128 + (q & 1) * 64 + c0;
                *(uint2*)db = make_uint2(pack2(o0[0], o0[1]), pack2(o0[2], o0[3]));
                *(uint2*)(db + 32) = make_uint2(pack2(o1[0], o1[1]), pack2(o1[2], o1[3]));
              }
            } else if (vg < 104) {
              u16* d = IQ + (size_t)row * 512 + (vg - 96) * 64 + c0;
              *(uint2*)d = make_uint2(pack2(o0[0], o0[1]), pack2(o0[2], o0[3]));
              *(uint2*)(d + 32) = make_uint2(pack2(o1[0], o1[1]), pack2(o1[2], o1[3]));
            } else {
              float* d = out + (smp ? O_IKS : O_IKP) + (size_t)orow * 64 + c0;
              *(float4*)d = make_float4(o0[0], o0[1], o0[2], o0[3]);
              *(float4*)(d + 32) = make_float4(o1[0], o1[1], o1[2], o1[3]);
              if (!smp) {
                u16* db = (u16*)(p.ws + OFF_IKB) + (size_t)row * 64 + c0;
                *(uint2*)db = make_uint2(pack2(o0[0], o0[1]), pack2(o0[2], o0[3]));
                *(uint2*)(db + 32) = make_uint2(pack2(o1[0], o1[1]), pack2(o1[2], o1[3]));
              }
            }
          } else if (vg < 80) {
            const int q = vg < 64 ? vg - 48 : vg - 64; const int hh = q >> 1, gi = q & 1;
            float o0[4], o1[4];
            const float4* tp = (const float4*)(tab + pos * 64 + gi * 32 + c0);
            const float4 t01 = tp[0], t23 = tp[1];
            o0[0] = v0[0] * t01.x - v1[0] * t01.y; o1[0] = v1[0] * t01.x + v0[0] * t01.y;
            o0[1] = v0[1] * t01.z - v1[1] * t01.w; o1[1] = v1[1] * t01.z + v0[1] * t01.w;
            o0[2] = v0[2] * t23.x - v1[2] * t23.y; o1[2] = v1[2] * t23.x + v0[2] * t23.y;
            o0[3] = v0[3] * t23.z - v1[3] * t23.w; o1[3] = v1[3] * t23.z + v0[3] * t23.w;
            if (vg < 64) {
              u16* d = BQ + (size_t)row * 1024 + hh * 128 + gi * 32 + c0;
              *(uint2*)d = make_uint2(pack2(o0[0] * QB_SCALE, o0[1] * QB_SCALE), pack2(o0[2] * QB_SCALE, o0[3] * QB_SCALE));
              *(uint2*)(d + 64) = make_uint2(pack2(o1[0] * QB_SCALE, o1[1] * QB_SCALE), pack2(o1[2] * QB_SCALE, o1[3] * QB_SCALE));
            } else {
              float* d = out + (smp ? O_BKS : O_BKP) + (size_t)orow * 1024 + hh * 128 + gi * 32 + c0;
              *(float4*)d = make_float4(o0[0], o0[1], o0[2], o0[3]);
              *(float4*)(d + 64) = make_float4(o1[0], o1[1], o1[2], o1[3]);
              if (!smp) {
                u16* db = (u16*)(p.ws + OFF_BKB) + ((size_t)(bb * 8 + hh) * NTOKP + tok) * 128 + gi * 32 + c0;
                *(uint2*)db = make_uint2(pack2(o0[0], o0[1]), pack2(o0[2], o0[3]));
                *(uint2*)(db + 64) = make_uint2(pack2(o1[0], o1[1]), pack2(o1[2], o1[3]));
              }
            }
          } else if (vg == 105) {
            if (g == 0) *(float4*)(IW + (size_t)row * 8 + c0) = make_float4(v0[0] * IW_SCALE, v0[1] * IW_SCALE, v0[2] * IW_SCALE, v0[3] * IW_SCALE);
          } else {
            u16* d = G + (size_t)row * 2048 + (vg - 106) * 64 + c0;
            float s0[4], s1[4];
#pragma unroll
            for (int j = 0; j < 4; ++j) { s0[j] = 1.0f / (1.0f + __expf(-v0[j])); s1[j] = 1.0f / (1.0f + __expf(-v1[j])); }
            *(uint2*)d = make_uint2(pack2(s0[0], s0[1]), pack2(s0[2], s0[3]));
            *(uint2*)(d + 32) = make_uint2(pack2(s1[0], s1[1]), pack2(s1[2], s1[3]));
          }
          __builtin_amdgcn_sched_barrier(0);
        }
      }
    }
    ++it;
    while (it < nr && !gemm_tile(vbid, it, 69, m0n, n0n)) ++it;
  }
}

DI void phase_win8(const Params& p, char* smem, int vbid) {
  const u16* A = (const u16*)(p.ws + OFF_XB);
  const u16* B = (const u16*)(p.ws + OFF_WIN);
  const float* ssp = (const float*)(p.ws + OFF_SSP1);
  const float2* tab = (const float2*)(p.ws + OFF_TAB);
  u16* AQ = (u16*)(p.ws + OFF_AQ); u16* BQ = (u16*)(p.ws + OFF_BQ); u16* IQ = (u16*)(p.ws + OFF_IQ);
  float* IW = (float*)(p.ws + OFF_IW); u16* Gt = (u16*)(p.ws + OFF_G);
  float* out = p.out;
  float* rs_s = (float*)(smem + RS8_OFF);
  const int nr = gemm_rounds(35);
  for (int it = 0; it < nr; ++it) {
    int m0, n0;
    if (!gemm_tile(vbid, it, 35, m0, n0)) continue;
    n0 *= 2;
    load_rs(ssp, m0, rs_s);
    __syncthreads();
    f32x4 acc[2][2][4][2];
#pragma unroll
    for (int a_ = 0; a_ < 2; ++a_)
#pragma unroll
      for (int b_ = 0; b_ < 2; ++b_)
#pragma unroll
        for (int m_ = 0; m_ < 4; ++m_)
#pragma unroll
          for (int n_ = 0; n_ < 2; ++n_) acc[a_][b_][m_][n_] = (f32x4){0.f, 0.f, 0.f, 0.f};
    gemm8_tile(A, B, 1024, m0, n0, (u16*)smem, acc);
    const int t = tid_opaque(), lane = t & 63, wid = __builtin_amdgcn_readfirstlane(t >> 6), wr = wid >> 2, wc = wid & 3, fr = lane & 15, fq = lane >> 4;
    const int o = fq * 4;
#pragma unroll
    for (int bj = 0; bj < 2; ++bj) {
      const int G = (n0 >> 5) + bj * 4 + wc;
      if (G >= 275) continue;
#pragma unroll
      for (int ai = 0; ai < 2; ++ai)
#pragma unroll
        for (int m = 0; m < 4; ++m) {
          int rl = ai * 128 + wr * 64 + m * 16 + fr;
          asm volatile("" : "+v"(rl));
          const int row = m0 + rl;
          if (row >= T) continue;
          const float r = rs_s[rl];
          const bool smp = row >= TP;
          const int orow = smp ? row - TP : row;
          const int bb = (!smp && row >= NTOKP) ? 1 : 0;
          const int tok = row - bb * NTOKP;
          const int pos = smp ? (NCACHE + (orow & 31)) : tok;
          float v0[4], v1[4];
#pragma unroll
          for (int j = 0; j < 4; ++j) { v0[j] = acc[ai][bj][m][0][j] * r; v1[j] = acc[ai][bj][m][1][j] * r; }
          if (G < 64 || (G >= 192 && G < 210)) {
            const int q = G < 64 ? (G & 31) : (G < 208 ? G - 192 : G - 208);
            const int g = G < 208 ? (q & 1) : q;
            const int hd = G < 208 ? (q >> 1) : 0;
            const int d0 = 16 * g + o;
            float o0[4], o1[4];
#pragma unroll
            for (int j = 0; j < 4; ++j) {
              const float2 cs = tab[pos * 64 + 2 * (d0 + j)];
              o0[j] = v0[j] * cs.x - v1[j] * cs.y; o1[j] = v1[j] * cs.x + v0[j] * cs.y;
            }
            if (G < 32) {
              u16* d = AQ + (size_t)row * 1024 + hd * 64 + d0;
              *(uint2*)d = make_uint2(pack2(o0[0] * QA_SCALE, o0[1] * QA_SCALE), pack2(o0[2] * QA_SCALE, o0[3] * QA_SCALE));
              *(uint2*)(d + 32) = make_uint2(pack2(o1[0] * QA_SCALE, o1[1] * QA_SCALE), pack2(o1[2] * QA_SCALE, o1[3] * QA_SCALE));
            } else if (G < 64) {
              float* d = out + (smp ? O_AKS : O_AKP) + (size_t)orow * 1024 + hd * 64 + d0;
              *(float4*)d = make_float4(o0[0], o0[1], o0[2], o0[3]);
              *(float4*)(d + 32) = make_float4(o1[0], o1[1], o1[2], o1[3]);
              if (!smp) {
                u16* db = (u16*)(p.ws + OFF_AKB) + ((size_t)(bb * 8 + (hd >> 1)) * NTOKP + tok) * 128 + (hd & 1) * 64 + d0;
                *(uint2*)db = make_uint2(pack2(o0[0], o0[1]), pack2(o0[2], o0[3]));
                *(uint2*)(db + 32) = make_uint2(pack2(o1[0], o1[1]), pack2(o1[2], o1[3]));
              }
            } else if (G < 208) {
              u16* d = IQ + (size_t)row * 512 + hd * 64 + d0;
              *(uint2*)d = make_uint2(pack2(o0[0], o0[1]), pack2(o0[2], o0[3]));
              *(uint2*)(d + 32) = make_uint2(pack2(o1[0], o1[1]), pack2(o1[2], o1[3]));
            } else {
              float* d = out + (smp ? O_IKS : O_IKP) + (size_t)orow * 64 + d0;
              *(float4*)d = make_float4(o0[0], o0[1], o0[2], o0[3]);
              *(float4*)(d + 32) = make_float4(o1[0], o1[1], o1[2], o1[3]);
              if (!smp) {
                u16* db = (u16*)(p.ws + OFF_IKB) + (size_t)row * 64 + d0;
                *(uint2*)db = make_uint2(pack2(o0[0], o0[1]), pack2(o0[2], o0[3]));
                *(uint2*)(db + 32) = make_uint2(pack2(o1[0], o1[1]), pack2(o1[2], o1[3]));
              }
            }
          } else if (G >= 96 && G < 160) {
            const int q = (G - 96) & 31; const int hh = q >> 2, g = q & 3;
            const int d0 = 16 * g + o;
            const float4* tp = (const float4*)(tab + pos * 64 + d0);
            const float4 t01 = tp[0], t23 = tp[1];
            float o0[4], o1[4];
            o0[0] = v0[0] * t01.x - v1[0] * t01.y; o1[0] = v1[0] * t01.x + v0[0] * t01.y;
            o0[1] = v0[1] * t01.z - v1[1] * t01.w; o1[1] = v1[1] * t01.z + v0[1] * t01.w;
            o0[2] = v0[2] * t23.x - v1[2] * t23.y; o1[2] = v1[2] * t23.x + v0[2] * t23.y;
            o0[3] = v0[3] * t23.z - v1[3] * t23.w; o1[3] = v1[3] * t23.z + v0[3] * t23.w;
            if (G < 128) {
              u16* d = BQ + (size_t)row * 1024 + hh * 128 + d0;
              *(uint2*)d = make_uint2(pack2(o0[0] * QB_SCALE, o0[1] * QB_SCALE), pack2(o0[2] * QB_SCALE, o0[3] * QB_SCALE));
              *(uint2*)(d + 64) = make_uint2(pack2(o1[0] * QB_SCALE, o1[1] * QB_SCALE), pack2(o1[2] * QB_SCALE, o1[3] * QB_SCALE));
            } else {
              float* d = out + (smp ? O_BKS : O_BKP) + (size_t)orow * 1024 + hh * 128 + d0;
              *(float4*)d = make_float4(o0[0], o0[1], o0[2], o0[3]);
              *(float4*)(d + 64) = make_float4(o1[0], o1[1], o1[2], o1[3]);
              if (!smp) {
                u16* db = (u16*)(p.ws + OFF_BKB) + ((size_t)(bb * 8 + hh) * NTOKP + tok) * 128 + d0;
                *(uint2*)db = make_uint2(pack2(o0[0], o0[1]), pack2(o0[2], o0[3]));
                *(uint2*)(db + 64) = make_uint2(pack2(o1[0], o1[1]), pack2(o1[2], o1[3]));
              }
            }
          } else if (G < 192) {
            const bool isa = G < 96;
            const int c = (isa ? (G - 64) : (G - 160)) * 32 + o;
            float* d = out + (isa ? (smp ? O_AVS : O_AVP) : (smp ? O_BVS : O_BVP)) + (size_t)orow * 1024 + c;
            *(float4*)d = make_float4(v0[0], v0[1], v0[2], v0[3]);
            *(float4*)(d + 16) = make_float4(v1[0], v1[1], v1[2], v1[3]);
            if (!smp) {
              u16* vt = (u16*)(p.ws + (isa ? OFF_AVT : OFF_BVT)) + ((size_t)(bb * 8 + (c >> 7)) * 128 + (c & 127)) * VTPAD + tok;
#pragma unroll
              for (int j = 0; j < 4; ++j) { vt[(size_t)j * VTPAD] = f2bf(v0[j]); vt[(size_t)(16 + j) * VTPAD] = f2bf(v1[j]); }
            }
          } else if (G == 210) {
            if (fq < 2) *(float4*)(IW + (size_t)row * 8 + o) = make_float4(v0[0] * IW_SCALE, v0[1] * IW_SCALE, v0[2] * IW_SCALE, v0[3] * IW_SCALE);
          } else {
            u16* d = Gt + (size_t)row * 2048 + (G - 211) * 32 + o;
            float s0[4], s1[4];
#pragma unroll
            for (int j = 0; j < 4; ++j) { s0[j] = 1.0f / (1.0f + __expf(-v0[j])); s1[j] = 1.0f / (1.0f + __expf(-v1[j])); }
            *(uint2*)d = make_uint2(pack2(s0[0], s0[1]), pack2(s0[2], s0[3]));
            *(uint2*)(d + 16) = make_uint2(pack2(s1[0], s1[1]), pack2(s1[2], s1[3]));
          }
        }
    }
  }
}

DI void phase_merge(const Params& p, char* smem, int vbid) {
  const u16* OA = (const u16*)(p.ws + OFF_OA); const u16* OB = (const u16*)(p.ws + OFF_OB);
  const u16* WA = (const u16*)(p.ws + OFF_WA); const u16* WB = (const u16*)(p.ws + OFF_WB);
  const u16* G = (const u16*)(p.ws + OFF_G);
  u16* MB = (u16*)(p.ws + OFF_MB);
  G_DECL
  const int nr = gemm_rounds(8);
  int it = 0, m0n = 0, n0n = 0;
  while (it < nr && !gemm_tile(vbid, it, 8, m0n, n0n)) ++it;
  if (it < nr) G_ISSUE(OA, 1024, WA, 1024, m0n, n0n, (const float*)nullptr)
  while (it < nr) {
    const int m0 = m0n, n0 = n0n;
    f32x16 acc[2][2], acc2[2][2]; zero_acc(acc); zero_acc(acc2);
    G_RUN(OA, 1024, WA, 1024, 1024, m0, n0, (u16*)smem, acc, true)
    G_ISSUE(OB, 1024, WB, 1024, m0, n0, (const float*)nullptr)
    G_RUN(OB, 1024, WB, 1024, 1024, m0, n0, (u16*)smem, acc2, true)
    ++it;
    while (it < nr && !gemm_tile(vbid, it, 8, m0n, n0n)) ++it;
    if (it < nr) G_ISSUE(OA, 1024, WA, 1024, m0n, n0n, (const float*)nullptr)
    const int t = tid_opaque(), lane = t & 63, w = t >> 6, wm = w >> 1, wn = w & 1, lr = lane & 31, lh = lane >> 5;
#pragma unroll
    for (int mi = 0; mi < 2; ++mi) {
      const int row = m0 + wm * 64 + mi * 32 + lr;
      if (row >= T) continue;
#pragma unroll
      for (int ni = 0; ni < 2; ++ni)
#pragma unroll
        for (int g = 0; g < 4; ++g) {
          const int col = n0 + wn * 64 + ni * 32 + 8 * g + 4 * lh;
          const uint2 ga = *(const uint2*)(G + (size_t)row * 2048 + col);
          const uint2 gb = *(const uint2*)(G + (size_t)row * 2048 + 1024 + col);
          const float m0v = __uint_as_float(ga.x << 16) * acc[mi][ni][4 * g] + __uint_as_float(gb.x << 16) * acc2[mi][ni][4 * g];
          const float m1v = __uint_as_float(ga.x & 0xffff0000u) * acc[mi][ni][4 * g + 1] + __uint_as_float(gb.x & 0xffff0000u) * acc2[mi][ni][4 * g + 1];
          const float m2v = __uint_as_float(ga.y << 16) * acc[mi][ni][4 * g + 2] + __uint_as_float(gb.y << 16) * acc2[mi][ni][4 * g + 2];
          const float m3v = __uint_as_float(ga.y & 0xffff0000u) * acc[mi][ni][4 * g + 3] + __uint_as_float(gb.y & 0xffff0000u) * acc2[mi][ni][4 * g + 3];
          *(uint2*)(MB + (size_t)row * 1024 + col) = make_uint2(pack2(m0v, m1v), pack2(m2v, m3v));
        }
    }
  }
}

template <int MODE>
DI void attn_item(const Params& p, char* smem, int grp, int b, int h, int q0, int nqv, float lam) {
  int t_ = threadIdx.x;
  asm volatile("" : "+v"(t_));
  const int t = t_, lane = t & 63, w = __builtin_amdgcn_readfirstlane(t >> 6), lr = lane & 31, lh = lane >> 5;
  u16* Ks = (u16*)smem;
  u16* Vt = Ks + 64 * 136;
  u16* Qs = Vt + 128 * 72;
  constexpr int NQB = MODE == 0 ? 128 : 256;
  constexpr int KS = MODE == 0 ? 4 : 8;
  const int NK = grp ? NKS : NTOKP;
  const int qsub = MODE == 0 ? (w >> 1) : w;
  const int map = MODE == 0 ? (w & 1) : 0;
  const int qw0 = q0 + qsub * 32;
  const bool wact = (qsub * 32) < nqv;
  int Lw = 0;
  if (wact) Lw = grp ? NKS : (qw0 < 16 ? 16 : 16 + 64 * (((qw0 - 16) >> 6) + 1));
  const int tql = q0 + nqv - 1;
  const int Lblk = grp ? NKS : (tql < 16 ? 16 : 16 + 64 * (((tql - 16) >> 6) + 1));
  const int nkt = (Lblk + 63) >> 6;
  const int ql = qsub * 32 + lr;
  const int tq = q0 + (ql < nqv ? ql : nqv - 1);
  const size_t gr = grp ? (size_t)TP + b * 32 + tq : (size_t)b * NTOKP + tq;
  __syncthreads();
  bf16x8 qf[KS];
  {
    const u16* Qg = (const u16*)(p.ws + (MODE == 0 ? OFF_AQ : OFF_BQ)) + gr * 1024 + h * 128 + map * 64 + lh * 8;
#pragma unroll
    for (int ks = 0; ks < KS; ++ks) qf[ks] = *(const bf16x8*)(Qg + ks * 16);
  }
  const u64* mrow = nullptr;
  if (MODE == 1) mrow = grp ? (const u64*)(p.ws + OFF_MASKS) + ((size_t)b * 32 + tq) * NWS : (const u64*)(p.ws + OFF_MASKP) + gr * NWP;
  f32x16 O[4];
  float mrun = -1e30f, lrun = 0.f;
#pragma unroll
  for (int db = 0; db < 4; ++db)
#pragma unroll
    for (int i = 0; i < 16; ++i) O[db][i] = 0.f;
  const int kwhich = MODE == 0 ? 0 : 2;
  const u16* Kg = (const u16*)(p.ws + (MODE == 0 ? OFF_AKB : OFF_BKB)) + (size_t)(b * 8 + h) * NTOKP * 128 + (t & 15) * 8;
  const u16* Vg = (const u16*)(p.ws + (MODE == 0 ? OFF_AVT : OFF_BVT)) + ((size_t)(b * 8 + h) * 128 + (t >> 3)) * VTPAD + (t & 7) * 8;
  const int kkey = t >> 4;
  uint4 sa0, sa1, sa2, sa3, sb0, sb1, sb2, sb3, sc0, sc1, sc2, sc3;
  u64 ma = 0, mb = 0, mc = 0;
  sa0 = sa1 = sa2 = sa3 = sb0 = sb1 = sb2 = sb3 = sc0 = sc1 = sc2 = sc3 = make_uint4(0, 0, 0, 0);
  auto issue = [&](int kt, uint4& r0, uint4& r1, uint4& r2, uint4& r3, u64& mwr) {
    if (!grp && kt < nkt) {
      int k0 = kt * 64 + kkey, k1 = k0 + 32;
      k0 = k0 < NTOKP ? k0 : NTOKP - 1; k1 = k1 < NTOKP ? k1 : NTOKP - 1;
      r0 = *(const uint4*)(Kg + (size_t)k0 * 128); r1 = *(const uint4*)(Kg + (size_t)k1 * 128);
      const u16* vp = Vg + kt * 64;
      r2 = *(const uint4*)(vp); r3 = *(const uint4*)(vp + (size_t)64 * VTPAD);
    }
    if (MODE == 1 && kt < nkt) mwr = mrow[kt];
  };
  constexpr int ATT_BUF = 64 * 136 + 128 * 72;
  auto fill = [&](int kt, uint4& r0, uint4& r1, uint4& r2, uint4& r3) {
    u16* Ks = (u16*)smem + (kt & 1) * ATT_BUF; u16* Vt = Ks + 64 * 136;
    if (!grp) {
      *(uint4*)(Ks + kkey * 136 + (t & 15) * 8) = r0; *(uint4*)(Ks + (kkey + 32) * 136 + (t & 15) * 8) = r1;
      *(uint4*)(Vt + (t >> 3) * 72 + (t & 7) * 8) = r2; *(uint4*)(Vt + ((t >> 3) + 64) * 72 + (t & 7) * 8) = r3;
    } else {
#pragma unroll
      for (int i = 0; i < 4; ++i) {
        const int c = t + NTHR * i; const int key = c >> 5, d4 = c & 31;
        int tk = kt * 64 + key; tk = tk < NK ? tk : NK - 1;
        const float4 v = *(const float4*)(kv_row(p, grp, b, tk, kwhich) + h * 128 + d4 * 4);
        *(uint2*)(Ks + key * 136 + d4 * 4) = make_uint2(pack2(v.x, v.y), pack2(v.z, v.w));
      }
      {
        const int kq = t >> 5, d4 = t & 31;
        float4 x[4];
#pragma unroll
        for (int j = 0; j < 4; ++j) {
          int tk = kt * 64 + kq * 4 + j; tk = tk < NK ? tk : NK - 1;
          x[j] = *(const float4*)(kv_row(p, grp, b, tk, kwhich + 1) + h * 128 + d4 * 4);
        }
        u16* vd = Vt + (d4 * 4) * 72 + kq * 4;
        *(uint2*)(vd) = make_uint2(pack2(x[0].x, x[1].x), pack2(x[2].x, x[3].x));
        *(uint2*)(vd + 72) = make_uint2(pack2(x[0].y, x[1].y), pack2(x[2].y, x[3].y));
        *(uint2*)(vd + 144) = make_uint2(pack2(x[0].z, x[1].z), pack2(x[2].z, x[3].z));
        *(uint2*)(vd + 216) = make_uint2(pack2(x[0].w, x[1].w), pack2(x[2].w, x[3].w));
      }
    }
  };
  auto step = [&](int kt, uint4& r0, uint4& r1, uint4& r2, uint4& r3, u64& mwr, uint4& n0, uint4& n1, uint4& n2, uint4& n3) {
    const u64 mw = mwr;
    u16* Ks = (u16*)smem + (kt & 1) * ATT_BUF; u16* Vt = Ks + 64 * 136;
    if (kt + 1 < nkt) fill(kt + 1, n0, n1, n2, n3);
    issue(kt + 3, r0, r1, r2, r3, mwr);
    if (wact && kt * 64 < Lw) {
      f32x16 st0, st1;
#pragma unroll
      for (int i = 0; i < 16; ++i) { st0[i] = 0.f; st1[i] = 0.f; }
      __builtin_amdgcn_s_setprio(1);
#pragma unroll
      for (int ks = 0; ks < KS; ++ks) {
        const bf16x8 k0 = *(const bf16x8*)(Ks + lr * 136 + map * 64 + ks * 16 + lh * 8);
        const bf16x8 k1 = *(const bf16x8*)(Ks + (32 + lr) * 136 + map * 64 + ks * 16 + lh * 8);
        st0 = MFMA(k0, qf[ks], st0);
        st1 = MFMA(k1, qf[ks], st1);
      }
      __builtin_amdgcn_s_setprio(0);
      if (MODE == 0) {
        if (kt * 64 + 64 > Lw) {
#pragma unroll
          for (int i = 0; i < 16; ++i) {
            const int key = kt * 64 + crow(i, lh);
            if (key >= Lw) st0[i] = -INFINITY;
            if (key + 32 >= Lw) st1[i] = -INFINITY;
          }
        }
      } else {
        const unsigned lo = (unsigned)mw >> (4 * lh), hi = (unsigned)(mw >> 32) >> (4 * lh);
#pragma unroll
        for (int i = 0; i < 16; ++i) {
          const int bit = (i & 3) + 8 * (i >> 2);
          if (!((lo >> bit) & 1u)) st0[i] = -INFINITY;
          if (!((hi >> bit) & 1u)) st1[i] = -INFINITY;
        }
      }
      float tmax = -INFINITY;
#pragma unroll
      for (int i = 0; i < 16; ++i) tmax = fmaxf(tmax, fmaxf(st0[i], st1[i]));
      tmax = fmaxf(tmax, shx(tmax, 32));
      const float mnew = fmaxf(mrun, tmax);
      const float alpha = fexp2(mrun - mnew);
      mrun = mnew;
      float ps = 0.f;
#pragma unroll
      for (int i = 0; i < 16; ++i) {
        st0[i] = fexp2(st0[i] - mnew); st1[i] = fexp2(st1[i] - mnew);
        ps += st0[i] + st1[i];
      }
      lrun = lrun * alpha + ps;
      if (__any(alpha != 1.0f)) {
#pragma unroll
        for (int db = 0; db < 4; ++db)
#pragma unroll
          for (int i = 0; i < 16; ++i) O[db][i] *= alpha;
      }
      bf16x8 pf[4];
#pragma unroll
      for (int c = 0; c < 4; ++c) {
        const unsigned u0 = (c < 2) ? pack2(st0[(c & 1) * 8 + 0], st0[(c & 1) * 8 + 1]) : pack2(st1[(c & 1) * 8 + 0], st1[(c & 1) * 8 + 1]);
        const unsigned u1 = (c < 2) ? pack2(st0[(c & 1) * 8 + 2], st0[(c & 1) * 8 + 3]) : pack2(st1[(c & 1) * 8 + 2], st1[(c & 1) * 8 + 3]);
        const unsigned u2 = (c < 2) ? pack2(st0[(c & 1) * 8 + 4], st0[(c & 1) * 8 + 5]) : pack2(st1[(c & 1) * 8 + 4], st1[(c & 1) * 8 + 5]);
        const unsigned u3 = (c < 2) ? pack2(st0[(c & 1) * 8 + 6], st0[(c & 1) * 8 + 7]) : pack2(st1[(c & 1) * 8 + 6], st1[(c & 1) * 8 + 7]);
        pf[c] = __builtin_bit_cast(bf16x8, make_uint4(u0, u1, u2, u3));
      }
      __builtin_amdgcn_s_setprio(1);
#pragma unroll
      for (int db = 0; db < 4; ++db)
#pragma unroll
        for (int c = 0; c < 4; ++c) {
          const int kk = (c >> 1) * 32 + (c & 1) * 16 + 4 * lh;
          const bf16x4 v0 = *(const bf16x4*)(Vt + (db * 32 + lr) * 72 + kk);
          const bf16x4 v1 = *(const bf16x4*)(Vt + (db * 32 + lr) * 72 + kk + 8);
          const bf16x8 vf = __builtin_shufflevector(v0, v1, 0, 1, 2, 3, 4, 5, 6, 7);
          O[db] = MFMA(vf, pf[c], O[db]);
        }
      __builtin_amdgcn_s_setprio(0);
    }
    __syncthreads();
  };
  issue(0, sa0, sa1, sa2, sa3, ma);
  issue(1, sb0, sb1, sb2, sb3, mb);
  issue(2, sc0, sc1, sc2, sc3, mc);
  fill(0, sa0, sa1, sa2, sa3);
  __syncthreads();
  for (int kt = 0; kt < nkt; kt += 3) {
    step(kt, sa0, sa1, sa2, sa3, ma, sb0, sb1, sb2, sb3);
    if (kt + 1 < nkt) step(kt + 1, sb0, sb1, sb2, sb3, mb, sc0, sc1, sc2, sc3);
    if (kt + 2 < nkt) step(kt + 2, sc0, sc1, sc2, sc3, mc, sa0, sa1, sa2, sa3);
  }
  const float ltot = lrun + shx(lrun, 32);
  const float inv = 1.0f / ltot;
  const bool qok = ql < nqv;
  if (MODE == 0) {
    float* Ex = (float*)smem;
    __syncthreads();
    if (map == 1) {
      const float sc = inv * lam;
#pragma unroll
      for (int db = 0; db < 4; ++db)
#pragma unroll
        for (int i = 0; i < 16; ++i) Ex[(qsub * 128 + db * 32 + crow(i, lh)) * 33 + lr] = O[db][i] * sc;
    }
    __syncthreads();
    if (map == 0) {
      float ss = 0.f;
#pragma unroll
      for (int db = 0; db < 4; ++db)
#pragma unroll
        for (int i = 0; i < 16; ++i) {
          const float v = O[db][i] * inv - Ex[(qsub * 128 + db * 32 + crow(i, lh)) * 33 + lr];
          O[db][i] = v; ss += v * v;
        }
      ss += shx(ss, 32);
      const float rn = rsqrtf(ss * (1.0f / 128.0f) + EPS) * 0.8f;
      const float* sub = p.in[18];
      u16* dst = (u16*)(p.ws + OFF_OA) + gr * 1024 + h * 128;
      if (wact && qok) {
#pragma unroll
        for (int db = 0; db < 4; ++db)
#pragma unroll
          for (int g = 0; g < 4; ++g) {
            const int d = db * 32 + 8 * g + 4 * lh;
            const float4 sg = *(const float4*)(sub + d);
            *(uint2*)(dst + d) = make_uint2(pack2(O[db][4 * g] * rn * sg.x, O[db][4 * g + 1] * rn * sg.y),
                                            pack2(O[db][4 * g + 2] * rn * sg.z, O[db][4 * g + 3] * rn * sg.w));
          }
      }
    }
  } else {
    u16* dst = (u16*)(p.ws + OFF_OB) + gr * 1024 + h * 128;
    if (wact && qok) {
#pragma unroll
      for (int db = 0; db < 4; ++db)
#pragma unroll
        for (int g = 0; g < 4; ++g) {
          const int d = db * 32 + 8 * g + 4 * lh;
          *(uint2*)(dst + d) = make_uint2(pack2(O[db][4 * g] * inv, O[db][4 * g + 1] * inv),
                                          pack2(O[db][4 * g + 2] * inv, O[db][4 * g + 3] * inv));
        }
    }
  }
}

DI unsigned ford(float f) { unsigned u = __float_as_uint(f); return u ^ ((u >> 31) ? 0xFFFFFFFFu : 0x80000000u); }

DI void idx_item(const Params& p, char* smem, int grp, int b, int pidx) {
  int t_ = threadIdx.x;
  asm volatile("" : "+v"(t_));
  const int t = t_, lane = t & 63, w = __builtin_amdgcn_readfirstlane(t >> 6), lr = lane & 31, lh = lane >> 5;
  u16* IQs = (u16*)smem;
  u16* IKs = IQs + 128 * 520;
  float* IWs = (float*)(smem + 133120 + 9216);
  float* SCb = (float*)(p.ws + OFF_SC);
  const int half = w >> 2;
  int q0h[2], nqh[2], Lh[2];
  if (!grp) {
    if (pidx == 0) { q0h[0] = 0; nqh[0] = 16; Lh[0] = 16; q0h[1] = 0; nqh[1] = 0; Lh[1] = 0; }
    else {
      const int c0 = 2 * (pidx - 1);
      q0h[0] = 16 + 64 * c0; nqh[0] = 64; Lh[0] = 80 + 64 * c0;
      q0h[1] = 80 + 64 * c0; nqh[1] = 64; Lh[1] = 144 + 64 * c0;
    }
  } else { q0h[0] = 0; nqh[0] = 32; Lh[0] = NKS; q0h[1] = 0; nqh[1] = 0; Lh[1] = 0; }
  const int NK = grp ? NKS : NTOKP;
  const int q0 = half ? q0h[1] : q0h[0], nqv = half ? nqh[1] : nqh[0], L = half ? Lh[1] : Lh[0];
  int Lpad; float* SC;
  if (!grp) {
    if (pidx == 0) { Lpad = 64; SC = SCb + SC_META + (size_t)b * 4096; }
    else { const int c = 2 * (pidx - 1) + half; Lpad = 64 * (c + 2); SC = SCb + (size_t)b * SC_BSTRIDE + 4096ull * (size_t)(c * (c + 3) / 2); }
  } else { Lpad = 2112; SC = SCb + SC_SAMP + (size_t)b * 64 * 2112; }
  const int nkt = (L + 63) >> 6;
  const int Lmax = Lh[1] > Lh[0] ? Lh[1] : Lh[0];
  const int nkt_blk = (Lmax + 63) >> 6;
  const u16* IQg = (const u16*)(p.ws + OFF_IQ);
  const float* IWg = (const float*)(p.ws + OFF_IW);
  __syncthreads();
#pragma unroll 4
  for (int i = 0; i < 16; ++i) {
    const int c = t + NTHR * i; const int q = c >> 6, ch = c & 63;
    const int hh = q >> 6, qq = q & 63;
    const int hq0 = hh ? q0h[1] : q0h[0], hn = hh ? nqh[1] : nqh[0];
    const int tq = hn > 0 ? hq0 + (qq < hn ? qq : hn - 1) : q0h[0];
    const size_t gr = grp ? (size_t)TP + b * 32 + tq : (size_t)b * NTOKP + tq;
    *(uint4*)(IQs + q * 520 + ch * 8) = *(const uint4*)(IQg + gr * 512 + ch * 8);
  }
#pragma unroll
  for (int i = 0; i < 2; ++i) {
    const int e = t + NTHR * i; const int q = e >> 3, hd = e & 7;
    const int hh = q >> 6, qq = q & 63;
    const int hq0 = hh ? q0h[1] : q0h[0], hn = hh ? nqh[1] : nqh[0];
    const int tq = hn > 0 ? hq0 + (qq < hn ? qq : hn - 1) : q0h[0];
    const size_t gr = grp ? (size_t)TP + b * 32 + tq : (size_t)b * NTOKP + tq;
    IWs[e] = IWg[gr * 8 + hd];
  }
  const int wq = w >> 1, wk = w & 1;
  const u16* IKg = (const u16*)(p.ws + OFF_IKB) + (size_t)b * NTOKP * 64 + (t & 7) * 8;
  const int ikey = t >> 3;
  uint4 ri0 = make_uint4(0, 0, 0, 0);
  if (!grp) {
    int k0 = ikey; k0 = k0 < NTOKP ? k0 : NTOKP - 1;
    ri0 = *(const uint4*)(IKg + (size_t)k0 * 64);
  }
  for (int kt = 0; kt < nkt_blk; ++kt) {
    __syncthreads();
    if (!grp) {
      *(uint4*)(IKs + ikey * 72 + (t & 7) * 8) = ri0;
    } else {
#pragma unroll
      for (int i = 0; i < 2; ++i) {
        const int c = t + NTHR * i; const int key = c >> 4, d4 = c & 15;
        int tk = kt * 64 + key; tk = tk < NK ? tk : NK - 1;
        const float4 v = *(const float4*)(ik_row(p, grp, b, tk) + d4 * 4);
        *(uint2*)(IKs + key * 72 + d4 * 4) = make_uint2(pack2(v.x, v.y), pack2(v.z, v.w));
      }
    }
    __syncthreads();
    if (!grp && kt + 1 < nkt_blk) {
      int k0 = (kt + 1) * 64 + ikey; k0 = k0 < NTOKP ? k0 : NTOKP - 1;
      ri0 = *(const uint4*)(IKg + (size_t)k0 * 64);
    }
    if (kt < nkt) {
      bf16x8 kf[4];
#pragma unroll
      for (int ks = 0; ks < 4; ++ks) kf[ks] = *(const bf16x8*)(IKs + (wk * 32 + lr) * 72 + ks * 16 + lh * 8);
      float sc[16];
#pragma unroll
      for (int i = 0; i < 16; ++i) sc[i] = 0.f;
#pragma unroll
      for (int hd = 0; hd < 8; ++hd) {
        f32x16 st;
#pragma unroll
        for (int i = 0; i < 16; ++i) st[i] = 0.f;
#pragma unroll
        for (int ks = 0; ks < 4; ++ks) {
          const bf16x8 qfr = *(const bf16x8*)(IQs + (wq * 32 + lr) * 520 + hd * 64 + ks * 16 + lh * 8);
          st = MFMA(kf[ks], qfr, st);
        }
        const float wv = IWs[(wq * 32 + lr) * 8 + hd];
#pragma unroll
        for (int i = 0; i < 16; ++i) sc[i] += wv * fmaxf(st[i], 0.f);
      }
      float* srow = SC + (size_t)((wq & 1) * 32 + lr) * Lpad + kt * 64 + wk * 32 + 4 * lh;
#pragma unroll
      for (int g = 0; g < 4; ++g) *(float4*)(srow + 8 * g) = make_float4(sc[4 * g], sc[4 * g + 1], sc[4 * g + 2], sc[4 * g + 3]);
    }
  }
  __threadfence();
  __syncthreads();
  for (int j = 0; j < 16; ++j) {
    const int q = (w & 3) * 16 + j;
    if (q >= nqv) break;
    const int tq = q0 + q;
    u64* mrow = grp ? (u64*)(p.ws + OFF_MASKS) + ((size_t)b * 32 + tq) * NWS : (u64*)(p.ws + OFF_MASKP) + ((size_t)b * NTOKP + tq) * NWP;
    if (L <= 256) {
      for (int i = 0; i < nkt; ++i) {
        const u64 wd = __ballot(i * 64 + lane < L);
        if (lane == 0) mrow[i] = wd;
      }
      continue;
    }
    const unsigned* srow = (const unsigned*)(SC + (size_t)q * Lpad);
    int Lr = L;
    asm volatile("" : "+v"(Lr));
    int nkr = __builtin_amdgcn_readfirstlane(nkt);
    asm volatile("" : "+s"(nkr));
    int lanev = lane;
    asm volatile("" : "+v"(lanev));
    unsigned v[129];
#pragma unroll
    for (int g = 0; g < 17; ++g) {
      if (g * 8 < nkt) {
#pragma unroll
        for (int jj = 0; jj < 8; ++jj) {
          const int i = g * 8 + jj; if (i >= 129) continue;
          v[i] = __hip_atomic_load(srow + i * 64 + lanev, __ATOMIC_RELAXED, __HIP_MEMORY_SCOPE_AGENT);
        }
      } else {
#pragma unroll
        for (int jj = 0; jj < 8; ++jj) if (g * 8 + jj < 129) v[g * 8 + jj] = 0u;
      }
    }
#pragma unroll
    for (int g = 0; g < 17; ++g) {
      if (g * 8 < nkt) {
#pragma unroll
        for (int jj = 0; jj < 8; ++jj) {
          const int i = g * 8 + jj; if (i >= 129) continue; const int key = i * 64 + lanev;
          const unsigned u = ford(__uint_as_float(v[i]));
          v[i] = key < Lr ? u : 0u;
        }
        __builtin_amdgcn_sched_barrier(0);
      }
    }
    unsigned Tt = 0u;
    for (int bit = 31; bit >= 0; --bit) {
      const unsigned cand = Tt | (1u << bit);
      int cnt = 0;
#pragma unroll
      for (int g = 0; g < 17; ++g) {
        if (g * 8 < nkt) {
#pragma unroll
          for (int jj = 0; jj < 8; ++jj) if (g * 8 + jj < 129) cnt += (v[g * 8 + jj] >= cand) ? 1 : 0;
          __builtin_amdgcn_sched_barrier(0);
        }
      }
#pragma unroll
      for (int m = 32; m >= 1; m >>= 1) cnt += __shfl_xor(cnt, m, 64);
      if (cnt >= 256) Tt = cand;
    }
    int cgt = 0;
#pragma unroll
    for (int g = 0; g < 17; ++g) {
      if (g * 8 < nkt) {
#pragma unroll
        for (int jj = 0; jj < 8; ++jj) if (g * 8 + jj < 129) cgt += (v[g * 8 + jj] > Tt) ? 1 : 0;
        __builtin_amdgcn_sched_barrier(0);
      }
    }
#pragma unroll
    for (int m = 32; m >= 1; m >>= 1) cgt += __shfl_xor(cgt, m, 64);
    const int need = 256 - cgt;
    int run = 0;
    const u64 lmask = (1ull << lane) - 1ull;
#pragma unroll
    for (int g = 0; g < 17; ++g) {
      if (g * 8 < nkt) {
#pragma unroll
        for (int jj = 0; jj < 8; ++jj) {
          const int i = g * 8 + jj; if (i >= 129) continue;
          const bool eq = v[i] == Tt;
          const u64 em = __ballot(eq);
          const int pre = run + __popcll(em & lmask);
          const bool sel = (v[i] > Tt) || (eq && pre < need);
          run += __popcll(em);
          const u64 wd = __ballot(sel);
          if (i < nkr) { if (lane == 0) mrow[i] = wd; }
          __builtin_amdgcn_sched_barrier(0);
        }
      }
    }
  }
}

DI unsigned xcc_id() { return (unsigned)__builtin_amdgcn_s_getreg((3 << 11) | 20) & 7u; }

DI int next_item(unsigned* cnt, int* s_item, int qlen, int& q, int& tries) {
  __syncthreads();
  if (threadIdx.x == 0) {
    int r = -1;
    while (tries < 8) {
      const int j = (int)atomicAdd(cnt + q, 1u);
      if (j < qlen) { r = (q << 16) | j; break; }
      q = (q + 1) & 7; ++tries;
    }
    s_item[0] = r; s_item[1] = q; s_item[2] = tries;
  }
  __syncthreads();
  q = __builtin_amdgcn_readfirstlane(s_item[1]);
  tries = __builtin_amdgcn_readfirstlane(s_item[2]);
  return __builtin_amdgcn_readfirstlane(s_item[0]);
}

DI void phase_attn_a(const Params& p, char* smem, int cbase = 0) {
  unsigned* cnt = (unsigned*)(p.ws + OFF_CNT) + cbase;
  int* s_item = (int*)(smem + SMEM_ITEM);
  float lam;
  {
    const int lane = threadIdx.x & 63;
    float a = p.in[14][lane] * p.in[15][lane], c = p.in[16][lane] * p.in[17][lane];
#pragma unroll
    for (int m = 32; m >= 1; m >>= 1) { a += shx(a, m); c += shx(c, m); }
    lam = expf(a) - expf(c) + 0.2f;
  }
  int q = (int)xcc_id(), tries = 0;
  while (true) {
    const int it = next_item(cnt, s_item, 165, q, tries);
    if (it < 0) break;
    const int x = it >> 16, j = it & 0xffff;
#ifndef NO_IDX
    if (j < 17) {
      const int k = j * 8 + x;
      if (k < 130) idx_item(p, smem, 0, k & 1, 64 - (k >> 1));
    } else if (j < 19) {
      idx_item(p, smem, 1, 2 * x + (j - 17), 0);
    } else
#else
    if (j < 19) {} else
#endif
    if (j < 35) {
      const int jj = j - 19;
      attn_item<0>(p, smem, 1, 2 * x + (jj >> 3), jj & 7, 0, 32, lam);
    } else {
      const int jj = j - 35; const int bh = 2 * x + jj / 65, qt = 64 - jj % 65;
      attn_item<0>(p, smem, 0, bh >> 3, bh & 7, qt == 0 ? 0 : 16 + (qt - 1) * 128, qt == 0 ? 16 : 128, lam);
    }
  }
}

DI void phase_attn_b(const Params& p, char* smem, int cbase = 8) {
  unsigned* cnt = (unsigned*)(p.ws + OFF_CNT) + cbase;
  int* s_item = (int*)(smem + SMEM_ITEM);
  int q = (int)xcc_id(), tries = 0;
  while (true) {
    const int it = next_item(cnt, s_item, 82, q, tries);
    if (it < 0) break;
    const int x = it >> 16, j = it & 0xffff;
    if (j < 16) {
      attn_item<1>(p, smem, 1, 2 * x + (j >> 3), j & 7, 0, 32, 0.f);
    } else {
      const int jj = j - 16; const int bh = 2 * x + jj / 33, qt = 32 - jj % 33;
      attn_item<1>(p, smem, 0, bh >> 3, bh & 7, qt == 0 ? 0 : 16 + (qt - 1) * 256, qt == 0 ? 16 : 256, 0.f);
    }
  }
}

DI void phase_final(const Params& p) {
  const int t = tid_opaque(), lane = t & 63;
  const int wv = blockIdx.x * 8 + (t >> 6), nw = gridDim.x * 8;
  const float* xf = (const float*)(p.ws + OFF_XF);
  const float* ssp = (const float*)(p.ws + OFF_SSP3);
  const float4* gf = (const float4*)p.in[26];
  for (int row = wv; row < T; row += nw) {
    float* dst;
    if (row < TP) {
      const int b = row >= NTOKP ? 1 : 0; const int tok = row - b * NTOKP;
      if (tok < 16) continue;
      dst = p.out + O_YP + ((size_t)b * 8192 + (tok - 16)) * 1024;
    } else dst = p.out + O_YS + (size_t)(row - TP) * 1024;
    float s = 0.f;
#pragma unroll
    for (int i = 0; i < 16; ++i) s += ssp[(size_t)row * 16 + i];
    const float r = rsqrtf(s * (1.0f / 1024.0f) + EPS);
#pragma unroll
    for (int i = 0; i < 4; ++i) {
      const float4 v = ((const float4*)(xf + (size_t)row * 1024))[lane + 64 * i];
      const float4 g = gf[lane + 64 * i];
      ((float4*)dst)[lane + 64 * i] = make_float4(v.x * r * g.x, v.y * r * g.y, v.z * r * g.z, v.w * r * g.w);
    }
  }
}

#ifndef PHM
#define PHM 0x7ff
#endif
#define PHON(n) ((PHM >> n) & 1)
__global__ void __launch_bounds__(512, 2) mega(Params p) {
  extern __shared__ __attribute__((aligned(16))) char smem[];
  cg::grid_group grid = cg::this_grid();
  volatile LAS unsigned* xst = (volatile LAS unsigned*)(smem + SMEM_ITEM + 48);
  if (threadIdx.x == 0) { xst[0] = 0u; xst[1] = 0u; }
  __syncthreads();
  (void)xcd_barrier_post((unsigned*)(p.ws + OFF_XBAR), xst);
  int* sv = (int*)(smem + SMEM_ITEM) + 8;
  if (threadIdx.x == 0) {
    const unsigned x = xcc_id();
    sv[0] = (int)x;
    sv[1] = (int)atomicAdd((unsigned*)(p.ws + OFF_CNT) + 48 + x, 1u);
  }
  if (PHON(0)) phase_prep(p, smem);
  grid.sync();
  int vbid;
  {
    if (threadIdx.x == 0) {
      const int x = sv[0], r = sv[1];
      int v = -1;
      if (gridDim.x == 256) {
        unsigned cntx[8];
#pragma unroll
        for (int i = 0; i < 8; ++i) cntx[i] = __hip_atomic_load((unsigned*)(p.ws + OFF_CNT) + 48 + i, __ATOMIC_RELAXED, __HIP_MEMORY_SCOPE_AGENT);
        if (r < 32) v = r * 8 + x;
        else {
          int k = r - 32;
#pragma unroll
          for (int i = 0; i < 8; ++i) if (i < x && cntx[i] > 32u) k += (int)cntx[i] - 32;
#pragma unroll
          for (int i = 0; i < 8; ++i) {
            const int freei = cntx[i] < 32u ? 32 - (int)cntx[i] : 0;
            if (v < 0) { if (k < freei) v = ((int)cntx[i] + k) * 8 + i; else k -= freei; }
          }
        }
      }
      sv[2] = v;
    }
    __syncthreads();
    vbid = __builtin_amdgcn_readfirstlane(sv[2]);
    if (vbid < 0) vbid = blockIdx.x;
  }
  if (PHON(1)) phase_gateup(p, smem, OFF_SSP0, OFF_WGU1, vbid);
  gbar(p, smem);
#ifdef DUP_GEMM
  phase_gateup(p, smem, OFF_SSP0, OFF_WGU1, vbid);
  gbar(p, smem);
#endif
  if (PHON(2)) phase_resid8<1>(p, smem, (const u16*)(p.ws + OFF_HID), 2816, OFF_WD1, 0.5f, OFF_SSP1, vbid);
  gbar(p, smem);
#ifdef DUP_G2
  phase_resid<1>(p, smem, (const u16*)(p.ws + OFF_HID), 2816, 2816, OFF_WD1, 0.5f, OFF_SSP1, vbid);
  gbar(p, smem);
#endif
  if (PHON(3)) phase_win8(p, smem, vbid);
  gbar(p, smem);
#ifdef DUP_GEMM
  phase_win8(p, smem, vbid);
  gbar(p, smem);
#endif
  if (PHON(4)) phase_attn_a(p, smem);
  gbar(p, smem);
#ifdef DUP_P4
  phase_attn_a(p, smem, 16);
  gbar(p, smem);
#endif
  if (PHON(5)) phase_attn_b(p, smem);
  gbar(p, smem);
#ifdef DUP_P5
  phase_attn_b(p, smem, 24);
  gbar(p, smem);
#endif
  if (PHON(6)) phase_merge8(p, smem, vbid);
  gbar(p, smem);
#ifdef DUP_G2
  phase_merge(p, smem, vbid);
  gbar(p, smem);
#endif
  if (PHON(7)) phase_resid8<0>(p, smem, (const u16*)(p.ws + OFF_MB), 1024, OFF_WO, 1.0f, OFF_SSP2, vbid);
  gbar(p, smem);
  if (PHON(8)) phase_gateup(p, smem, OFF_SSP2, OFF_WGU2, vbid);
  gbar(p, smem);
  if (PHON(9)) phase_resid8<0>(p, smem, (const u16*)(p.ws + OFF_HID), 2816, OFF_WD2, 0.5f, OFF_SSP3, vbid);
  gbar(p, smem);
  if (PHON(10)) phase_final(p);
}

extern "C" void kernel_launch(void* const* d_in, const int* in_sizes, int n_in, void* d_out, int out_size, void* d_ws,
                              size_t ws_size, hipStream_t stream) {
  Params p{};
  for (int i = 0; i < 27; ++i) p.in[i] = (const float*)d_in[i];
  p.out = (float*)d_out;
  p.ws = (char*)d_ws;
  static int grid_blocks = 0;
  if (!grid_blocks) {
    hipFuncSetAttribute((const void*)mega, hipFuncAttributeMaxDynamicSharedMemorySize, SMEM_BYTES);
    int dev = 0, cus = 0, per_cu = 0;
    hipGetDevice(&dev);
    hipDeviceGetAttribute(&cus, hipDeviceAttributeMultiprocessorCount, dev);
    hipOccupancyMaxActiveBlocksPerMultiprocessor(&per_cu, mega, NTHR, SMEM_BYTES);
    if (per_cu > 1) per_cu = 1;
    if (per_cu < 1) per_cu = 1;
    grid_blocks = cus * per_cu;
  }
  if (ws_size < WS_END) fprintf(stderr, "workspace too small: %zu < %zu\n", ws_size, (size_t)WS_END);
  (void)hipMemsetAsync((char*)d_ws + OFF_CNT, 0, 256 + SZ_XBAR, stream);
  void* args[] = {&p};
  hipError_t e = hipLaunchCooperativeKernel((void*)mega, dim3(grid_blocks), dim3(NTHR), args, SMEM_BYTES, stream);
  if (e != hipSuccess) fprintf(stderr, "cooperative launch failed: %s (grid %d)\n", hipGetErrorString(e), grid_blocks);
}
```

```cpp
#include <hip/hip_runtime.h>
#include <hip/hip_cooperative_groups.h>
#include <stdint.h>
#include <cstdio>
namespace cg = cooperative_groups;

typedef __attribute__((ext_vector_type(8))) short bf16x8;
typedef __attribute__((ext_vector_type(4))) short bf16x4;
typedef __attribute__((ext_vector_type(16))) float f32x16;
typedef unsigned short u16;
typedef unsigned long long u64;
#define MFMA(a, b, c) __builtin_amdgcn_mfma_f32_32x32x16_bf16((a), (b), (c), 0, 0, 0)
#define DI __device__ __forceinline__

constexpr int NTOKP = 8208;
constexpr int TP = 2 * NTOKP;
constexpr int TS = 512;
constexpr int T = TP + TS;
constexpr int TPAD = 17152;
constexpr int NT_M = 67;
constexpr int NTHR = 512;
constexpr int NCACHE = 2064;
constexpr int NKS = 2096;
constexpr int NWP = 129;
constexpr int NWS = 33;
constexpr float EPS = 1e-6f;
constexpr float LOG2E = 1.4426950408889634f;
constexpr float QA_SCALE = 0.125f * LOG2E;
constexpr float QB_SCALE = 0.08838834764831845f * LOG2E;
constexpr float IW_SCALE = 0.125f * 0.35355339059327373f;

constexpr size_t O_YP = 0;
constexpr size_t O_YS = O_YP + 2ull * 8192 * 1024;
constexpr size_t O_AKP = O_YS + 512ull * 1024;
constexpr size_t SZ_NEWP = (size_t)TP * 1024;
constexpr size_t O_AVP = O_AKP + SZ_NEWP;
constexpr size_t O_BKP = O_AVP + SZ_NEWP;
constexpr size_t O_BVP = O_BKP + SZ_NEWP;
constexpr size_t O_IKP = O_BVP + SZ_NEWP;
constexpr size_t O_AKS = O_IKP + (size_t)TP * 64;
constexpr size_t SZ_NEWS = (size_t)TS * 1024;
constexpr size_t O_AVS = O_AKS + SZ_NEWS;
constexpr size_t O_BKS = O_AVS + SZ_NEWS;
constexpr size_t O_BVS = O_BKS + SZ_NEWS;
constexpr size_t O_IKS = O_BVS + SZ_NEWS;

constexpr size_t al256(size_t x) { return (x + 255) & ~size_t(255); }
constexpr size_t SZ_WGU = 5632ull * 1024 * 2, SZ_WD = 1024ull * 2816 * 2, SZ_WIN = 8960ull * 1024 * 2, SZ_WSQ = 1024ull * 1024 * 2;
constexpr int VTPAD = 8256;
constexpr size_t OFF_WA = 0;
constexpr size_t OFF_WB = OFF_WA + SZ_WSQ;
constexpr size_t OFF_WO = OFF_WB + SZ_WSQ;
constexpr size_t OFF_WGU2 = OFF_WO + SZ_WSQ;
constexpr size_t OFF_WD2 = OFF_WGU2 + SZ_WGU;
constexpr size_t OFF_XF = OFF_WD2 + SZ_WD;
constexpr size_t SZ_SSP = (size_t)TPAD * 16 * 4;
constexpr size_t OFF_SSP0 = OFF_XF + (size_t)TPAD * 1024 * 4;
constexpr size_t OFF_SSP1 = OFF_SSP0 + SZ_SSP;
constexpr size_t OFF_SSP2 = OFF_SSP1 + SZ_SSP;
constexpr size_t OFF_SSP3 = OFF_SSP2 + SZ_SSP;
constexpr size_t OFF_TAB = OFF_SSP3 + SZ_SSP;
constexpr size_t OFF_AQ = OFF_TAB + (size_t)NTOKP * 64 * 8;
constexpr size_t OFF_MB = OFF_AQ;
constexpr size_t OFF_BQ = OFF_AQ + (size_t)TPAD * 1024 * 2;
constexpr size_t OFF_IQ = OFF_BQ + (size_t)TPAD * 1024 * 2;
constexpr size_t OFF_IW = OFF_IQ + (size_t)TPAD * 512 * 2;
constexpr size_t OFF_G = OFF_IW + (size_t)TPAD * 8 * 4;
constexpr size_t OFF_OA = OFF_G + (size_t)TPAD * 2048 * 2;
constexpr size_t OFF_MASKP = OFF_OA + (size_t)TPAD * 1024 * 2;
constexpr size_t OFF_MASKS = OFF_MASKP + al256((size_t)TP * NWP * 8);
constexpr size_t OFF_CNT = OFF_MASKS + al256((size_t)TS * NWS * 8);
constexpr size_t OFF_XBAR = OFF_CNT + 256;
constexpr size_t SZ_XBAR = 3456 * 4 + 256;
constexpr size_t OFF_AKB = OFF_XBAR + ((SZ_XBAR + 255) & ~size_t(255));
constexpr size_t OFF_BKB = OFF_AKB + (size_t)TP * 1024 * 2;
constexpr size_t SZ_VT = 2ull * 8 * 128 * VTPAD * 2;
constexpr size_t OFF_AVT = OFF_BKB + (size_t)TP * 1024 * 2;
constexpr size_t OFF_BVT = OFF_AVT + SZ_VT;
constexpr size_t OFF_IKB = OFF_BVT + SZ_VT;
constexpr size_t OFF_DEAD = OFF_IKB + al256((size_t)TP * 64 * 2);
constexpr size_t OFF_WGU1 = OFF_DEAD;
constexpr size_t OFF_WD1 = OFF_WGU1 + SZ_WGU;
constexpr size_t OFF_WIN = OFF_WD1 + SZ_WD;
constexpr size_t OFF_XB = OFF_WIN + SZ_WIN;
constexpr size_t OFF_HID = OFF_XB + (size_t)TPAD * 1024 * 2;
constexpr size_t OFF_OB = OFF_HID + (size_t)TPAD * 2816 * 2;
constexpr size_t OFF_SC = OFF_DEAD;
constexpr size_t SC_BSTRIDE = 4096ull * (128 * 131 / 2);
constexpr size_t SC_META = 2 * SC_BSTRIDE;
constexpr size_t SC_SAMP = SC_META + 2 * 4096;
constexpr size_t SC_FLOATS = SC_SAMP + 16ull * 64 * 2112;
constexpr size_t WS_END = OFF_SC + SC_FLOATS * 4 + 4096;
static_assert(WS_END <= 736544256ull, "workspace budget");
static_assert(OFF_OB + (size_t)TPAD * 1024 * 2 <= WS_END, "dead region fits");

constexpr int SMEM_ITEM = 149504;
constexpr int SMEM_BYTES = SMEM_ITEM + 64;

struct Params {
  const float* in[27];
  float* out;
  char* ws;
};

typedef __attribute__((ext_vector_type(2))) float f32x2_t;
typedef __attribute__((ext_vector_type(2))) __bf16 bf16x2_t;
DI unsigned pack2(float a, float b) {
  f32x2_t v = {a, b};
  return __builtin_bit_cast(unsigned, __builtin_convertvector(v, bf16x2_t));
}
DI u16 f2bf(float x) { return (u16)(pack2(x, x) & 0xffffu); }
DI int tid_opaque() { int t = threadIdx.x; asm volatile("" : "+v"(t)); return t; }
DI int crow(int i, int h) { return (i & 3) + 8 * (i >> 2) + 4 * h; }
DI float fexp2(float x) { return __builtin_amdgcn_exp2f(x); }
DI float shx(float v, int m) { return __shfl_xor(v, m, 64); }

DI const float* xrow_ptr(const Params& p, int row) {
  if (row < TP) {
    int b = row >= NTOKP ? 1 : 0;
    int tok = row - b * NTOKP;
    if (tok < 16) return p.in[7] + (size_t)tok * 1024;
    return p.in[0] + ((size_t)b * 8192 + (tok - 16)) * 1024;
  }
  return p.in[1] + (size_t)(row - TP) * 1024;
}

DI const float* kv_row(const Params& p, int grp, int b, int tk, int which) {
  if (!grp) return p.out + O_AKP + (size_t)which * SZ_NEWP + ((size_t)b * NTOKP + tk) * 1024;
  if (tk < NCACHE) return (which == 0 ? p.in[2] : which == 1 ? p.in[3] : which == 2 ? p.in[4] : p.in[5]) + ((size_t)b * NCACHE + tk) * 1024;
  return p.out + O_AKS + (size_t)which * SZ_NEWS + ((size_t)b * 32 + (tk - NCACHE)) * 1024;
}
DI const float* ik_row(const Params& p, int grp, int b, int tk) {
  if (!grp) return p.out + O_IKP + ((size_t)b * NTOKP + tk) * 64;
  if (tk < NCACHE) return p.in[6] + ((size_t)b * NCACHE + tk) * 64;
  return p.out + O_IKS + ((size_t)b * 32 + (tk - NCACHE)) * 64;
}

#define XB_TMO      128
#define XB_XCNT(j)  (256  + 64 * (j))
#define XB_XSUB(j)  (1280 + 64 * (j))
#define XB_XGEN(j)  (2304 + 64 * (j))
#define XB_TOP      3328
#define XB_TOPGEN   3392
#define XCD_BAR_WORDS 3456
#define XB_SPIN_CAP (1u << 18)
#define LAS __attribute__((address_space(3)))

__device__ __forceinline__ unsigned xb_ld(unsigned* p)              { return __hip_atomic_load(p, __ATOMIC_RELAXED, __HIP_MEMORY_SCOPE_AGENT); }
__device__ __forceinline__ unsigned xb_add(unsigned* p, unsigned v) { return __hip_atomic_fetch_add(p, v, __ATOMIC_RELAXED, __HIP_MEMORY_SCOPE_AGENT); }
__device__ __forceinline__ unsigned xb_xcc_id() { return (unsigned)__builtin_amdgcn_s_getreg((3 << 11) | 20) & 0xFu; }
#define XB_SPIN(cond, bar) do { unsigned _sp = 0; while (cond) { __builtin_amdgcn_s_sleep(1); \
    if ((++_sp & 255u) == 0u) { if (xb_ld(&(bar)[XB_TMO])) break; if (_sp > XB_SPIN_CAP) { atomicAdd(&(bar)[XB_TMO], 1u); break; } } } } while (0)

struct XcdBarrier {
    unsigned* bar; unsigned x;
    volatile LAS unsigned* st;
};

__device__ __forceinline__ XcdBarrier xcd_barrier_post(unsigned* bar, volatile LAS unsigned* st) {
    XcdBarrier b; b.bar = bar; b.x = xb_xcc_id(); b.st = st;
    if (threadIdx.x == 0) (void)xb_add(&bar[XB_XCNT(b.x)], 1u);
    return b;
}
__device__ __forceinline__ void xcd_barrier_complete(unsigned* bar, unsigned x, unsigned& nloc, unsigned& nx) {
    const unsigned G = gridDim.x * gridDim.y * gridDim.z;
    unsigned sum, cnt, mine, sp = 0u;
    for (;;) {
        sum = 0u; cnt = 0u; mine = 0u;
#pragma unroll
        for (unsigned j = 0; j < 16; ++j) { const unsigned c = xb_ld(&bar[XB_XCNT(j)]); sum += c; cnt += (c > 0u) ? 1u : 0u; mine = (j == x) ? c : mine; }
        if (sum == G) break;
        __builtin_amdgcn_s_sleep(1);
        if ((++sp & 255u) == 0u) { if (xb_ld(&bar[XB_TMO])) break; if (sp > XB_SPIN_CAP) { atomicAdd(&bar[XB_TMO], 1u); break; } }
    }
    nloc = mine > 0u ? mine : 1u; nx = cnt > 0u ? cnt : 1u;
}

__device__ __forceinline__ void xcd_barrier(const XcdBarrier& b) {
    asm volatile("s_waitcnt vmcnt(0)" ::: "memory");
    __syncthreads();
    if (threadIdx.x == 0) {
        unsigned* bar = b.bar;
        __builtin_amdgcn_s_waitcnt(0);
        unsigned nloc = b.st[0], nx = b.st[1];
        if (nloc == 0u) { xcd_barrier_complete(bar, b.x, nloc, nx); b.st[0] = nloc; b.st[1] = nx; }
        const unsigned old = xb_add(&bar[XB_XSUB(b.x)], 1u);
        const unsigned gen = old / nloc;
        if (old + 1u == (gen + 1u) * nloc) {
            __builtin_amdgcn_fence(__ATOMIC_RELEASE, "agent");
            asm volatile("s_waitcnt vmcnt(0)" ::: "memory");
            const unsigned og = xb_add(&bar[XB_TOP], 1u);
            const unsigned tg = og / nx;
            if (og + 1u == (tg + 1u) * nx) xb_add(&bar[XB_TOPGEN], 1u);
            else XB_SPIN(xb_ld(&bar[XB_TOPGEN]) == tg, bar);
            __builtin_amdgcn_fence(__ATOMIC_ACQUIRE, "agent");
            xb_add(&bar[XB_XGEN(b.x)], 1u);
            asm volatile("s_waitcnt vmcnt(0)" ::: "memory");
        } else {
            XB_SPIN(xb_ld(&bar[XB_XGEN(b.x)]) == gen, bar);
            __builtin_amdgcn_fence(__ATOMIC_ACQUIRE, "agent");
            asm volatile("s_waitcnt vmcnt(0)" ::: "memory");
        }
    }
    __syncthreads();
}


DI void gbar(const Params& p, char* smem) {
  XcdBarrier b; b.bar = (unsigned*)(p.ws + OFF_XBAR); b.x = xb_xcc_id(); b.st = (volatile LAS unsigned*)(smem + SMEM_ITEM + 48);
  xcd_barrier(b);
}
template <int job>
DI void wt_tile(const Params& p, int seg, int kt, float* ts) {
  const int t = threadIdx.x & 255;
  ts += (threadIdx.x >> 8) * (128 * 33);
  const float* src = nullptr; int ld = 0; const float* gs = nullptr; u16* dst = nullptr; int K = 1024; int nvalid4 = 8;
  switch (job) {
    case 0: case 6: {
      const float* wg = job == 0 ? p.in[9] : p.in[23]; const float* wu = job == 0 ? p.in[10] : p.in[24];
      const int c4g = threadIdx.x & 7;
      src = (c4g < 4 ? wg : wu) + 16 * seg - (c4g < 4 ? 0 : 16); ld = 2816; gs = job == 0 ? p.in[8] : p.in[22];
      dst = (u16*)(p.ws + (job == 0 ? OFF_WGU1 : OFF_WGU2)) + (size_t)seg * 32 * 1024; K = 1024;
    } break;
    case 1: case 7: {
      src = (job == 1 ? p.in[11] : p.in[25]) + 32 * seg; ld = 1024; K = 2816;
      dst = (u16*)(p.ws + (job == 1 ? OFF_WD1 : OFF_WD2)) + (size_t)seg * 32 * 2816;
    } break;
    case 2: {
      const int G = seg; const int c4g = threadIdx.x & 7; const int hf = c4g >> 2;
      int a0 = 0; bool valid = true;
      if (G < 64) { const int base = G < 32 ? 0 : 1024; const int q = G & 31; a0 = base + (q >> 1) * 64 + (q & 1) * 16 + hf * 32; }
      else if (G < 96) a0 = 2048 + (G - 64) * 32 + hf * 16;
      else if (G < 160) { const int base = G < 128 ? 3072 : 4096; const int q = (G - 96) & 31; a0 = base + (q >> 2) * 128 + (q & 3) * 16 + hf * 64; }
      else if (G < 192) a0 = 5120 + (G - 160) * 32 + hf * 16;
      else if (G < 208) { const int q = G - 192; a0 = 6144 + (q >> 1) * 64 + (q & 1) * 16 + hf * 32; }
      else if (G < 210) { a0 = 6656 + (G - 208) * 16 + hf * 32; }
      else if (G == 210) { a0 = 6720; valid = c4g < 2; }
      else if (G < 275) a0 = 6728 + (G - 211) * 32 + hf * 16;
      else valid = false;
      if (!valid) a0 = 0;
      src = p.in[13] + a0 - (valid ? hf * 16 : c4g * 4); ld = 8776; gs = p.in[12]; K = 1024;
      nvalid4 = valid ? 8 : 0;
      dst = (u16*)(p.ws + OFF_WIN) + (size_t)G * 32 * 1024;
    } break;
    default: {
      src = (job == 3 ? p.in[19] : (job == 4 ? p.in[20] : p.in[21])) + 32 * seg; ld = 1024; K = 1024;
      dst = (u16*)(p.ws + (job == 3 ? OFF_WA : (job == 4 ? OFF_WB : OFF_WO))) + (size_t)seg * 32 * 1024;
    } break;
  }
  const int c4 = t & 7, kr = t >> 3;
  {
#pragma unroll
  for (int ps = 0; ps < 4; ++ps) {
    const int kl = ps * 32 + kr; const int k = kt * 128 + kl;
    float4 v = make_float4(0.f, 0.f, 0.f, 0.f);
    if (c4 < nvalid4) v = *(const float4*)(src + (size_t)k * ld + c4 * 4);
    const float s = gs ? gs[k] : 1.0f;
    float* d = ts + kl * 33 + c4 * 4;
    d[0] = v.x * s; d[1] = v.y * s; d[2] = v.z * s; d[3] = v.w * s;
  }
  }
  __syncthreads();
  {
    const int r = t >> 3, kc = t & 7;
    unsigned o[8];
#pragma unroll
    for (int j = 0; j < 8; ++j) o[j] = pack2(ts[(kc * 16 + 2 * j) * 33 + r], ts[(kc * 16 + 2 * j + 1) * 33 + r]);
    uint4* dp = (uint4*)(dst + (size_t)r * K + kt * 128 + kc * 16);
    dp[0] = make_uint4(o[0], o[1], o[2], o[3]);
    dp[1] = make_uint4(o[4], o[5], o[6], o[7]);
  }
  __syncthreads();
}

DI void phase_prep(const Params& p, char* smem) {
  const int t = tid_opaque(), lane = t & 63;
  for (int e = blockIdx.x * NTHR + t; e < NTOKP * 64; e += gridDim.x * NTHR) {
    const int pos = e >> 6, i = e & 63;
    double inv = 1.0;
    for (int j = 0; j < i; ++j) inv *= 0.8659643233600653;
    const float invf = (float)inv;
    const float ang = (float)pos * invf;
    const double a = (double)ang;
    const double qd = rint(a * 0.6366197723675814);
    const double r = (a - qd * 1.5707963267948966) - qd * 6.123233995736766e-17;
    const double r2 = r * r;
    double sn = r2 * (1.0 / 6227020800.0) - 1.0 / 39916800.0;
    sn = sn * r2 + 1.0 / 362880.0; sn = sn * r2 - 1.0 / 5040.0; sn = sn * r2 + 1.0 / 120.0; sn = sn * r2 - 1.0 / 6.0; sn = sn * r2 * r + r;
    double cn = -r2 * (1.0 / 87178291200.0) + 1.0 / 479001600.0;
    cn = cn * r2 - 1.0 / 3628800.0; cn = cn * r2 + 1.0 / 40320.0; cn = cn * r2 - 1.0 / 720.0; cn = cn * r2 + 1.0 / 24.0; cn = cn * r2 - 0.5; cn = cn * r2 + 1.0;
    const int q = ((int)qd) & 3;
    double c, s;
    if (q == 0) { c = cn; s = sn; } else if (q == 1) { c = -sn; s = cn; } else if (q == 2) { c = -cn; s = -sn; } else { c = sn; s = -cn; }
    ((float2*)(p.ws + OFF_TAB))[e] = make_float2((float)c, (float)s);
  }
  for (int e = blockIdx.x * NTHR + t; e < 2 * 2048 * 6; e += gridDim.x * NTHR) {
    const int which = e / (2048 * 6), r = e % (2048 * 6);
    const int row = r / 6, ch = r % 6;
    u16* vt = (u16*)(p.ws + (which ? OFF_BVT : OFF_AVT)) + (size_t)row * VTPAD + NTOKP + ch * 8;
    *(uint4*)vt = make_uint4(0, 0, 0, 0);
  }
  {
    const int wv = blockIdx.x * 8 + (t >> 6), nw = gridDim.x * 8;
    for (int row = wv; row < TPAD; row += nw) {
      u16* xb = (u16*)(p.ws + OFF_XB) + (size_t)row * 1024;
      float* ssp = (float*)(p.ws + OFF_SSP0) + (size_t)row * 16;
      if (row >= T) {
        uint4 z = make_uint4(0, 0, 0, 0);
        ((uint4*)xb)[lane * 2] = z; ((uint4*)xb)[lane * 2 + 1] = z;
        if (lane < 16) ssp[lane] = lane == 0 ? 1024.f : 0.f;
        continue;
      }
      const float4* src = (const float4*)xrow_ptr(p, row);
      float ss = 0.f;
#pragma unroll
      for (int i = 0; i < 4; ++i) {
        const float4 v = src[lane + 64 * i];
        ss += v.x * v.x + v.y * v.y + v.z * v.z + v.w * v.w;
        ((uint2*)xb)[lane + 64 * i] = make_uint2(pack2(v.x, v.y), pack2(v.z, v.w));
      }
#pragma unroll
      for (int m = 32; m >= 1; m >>= 1) ss += shx(ss, m);
      if (lane < 16) ssp[lane] = lane == 0 ? ss : 0.f;
    }
  }
  {
    float* ts = (float*)smem;
    for (int tb = blockIdx.x * 2; tb < 7232; tb += gridDim.x * 2) {
      const int tile = __builtin_amdgcn_readfirstlane(tb + (int)(threadIdx.x >> 8));
      if (tile >= 7232) { __syncthreads(); __syncthreads(); continue; }
      int job, r = tile;
      if (r < 1408) job = 0;
      else if ((r -= 1408) < 704) job = 1;
      else if ((r -= 704) < 2240) job = 2;
      else if ((r -= 2240) < 256) job = 3;
      else if ((r -= 256) < 256) job = 4;
      else if ((r -= 256) < 256) job = 5;
      else if ((r -= 256) < 1408) job = 6;
      else { r -= 1408; job = 7; }
      const int nkt = (job == 1 || job == 7) ? 22 : 8;
      const int sg = r / nkt, kk = r % nkt;
      switch (job) {
        case 0: wt_tile<0>(p, sg, kk, ts); break;
        case 1: wt_tile<1>(p, sg, kk, ts); break;
        case 2: wt_tile<2>(p, sg, kk, ts); break;
        case 3: wt_tile<3>(p, sg, kk, ts); break;
        case 4: wt_tile<4>(p, sg, kk, ts); break;
        case 5: wt_tile<5>(p, sg, kk, ts); break;
        case 6: wt_tile<6>(p, sg, kk, ts); break;
        default: wt_tile<7>(p, sg, kk, ts); break;
      }
    }
  }
}

constexpr int GSTAGE = (256 + 128) * 72;
constexpr int RS_OFF = 2 * GSTAGE * 2;
#define G_DECL uint4 gs0, gs1, gs2, gs3, gs4, gs5, gs6, gs7, gs8, gs9, gs10, gs11, gs12, gs13, gs14, gs15, gs16, gs17; float4 gq0, gq1, gq2, gq3;
#define G_LOAD(S0, S1, S2, S3, S4, S5, kn) { \
    S0 = *(const uint4*)(Ap + (kn)); S1 = *(const uint4*)(Ap + (size_t)64 * lda_ + (kn)); \
    S2 = *(const uint4*)(Ap + (size_t)128 * lda_ + (kn)); S3 = *(const uint4*)(Ap + (size_t)192 * lda_ + (kn)); \
    S4 = *(const uint4*)(Bp + (kn)); S5 = *(const uint4*)(Bp + (size_t)64 * ldb_ + (kn)); }
#define G_STORE(S0, S1, S2, S3, S4, S5, st) { \
    u16* An_ = smem_ + (st) * GSTAGE; u16* Bn_ = An_ + 256 * 72; \
    *(uint4*)(An_ + (lrow) * 72 + lkc * 8) = S0; *(uint4*)(An_ + (lrow + 64) * 72 + lkc * 8) = S1; \
    *(uint4*)(An_ + (lrow + 128) * 72 + lkc * 8) = S2; *(uint4*)(An_ + (lrow + 192) * 72 + lkc * 8) = S3; \
    *(uint4*)(Bn_ + (lrow) * 72 + lkc * 8) = S4; *(uint4*)(Bn_ + (lrow + 64) * 72 + lkc * 8) = S5; }
#define G_LOAD_A(kn) G_LOAD(gs0, gs1, gs2, gs3, gs4, gs5, kn)
#define G_LOAD_B(kn) G_LOAD(gs6, gs7, gs8, gs9, gs10, gs11, kn)
#define G_LOAD_C(kn) G_LOAD(gs12, gs13, gs14, gs15, gs16, gs17, kn)
#define G_STORE_A(st) G_STORE(gs0, gs1, gs2, gs3, gs4, gs5, st)
#define G_STORE_B(st) G_STORE(gs6, gs7, gs8, gs9, gs10, gs11, st)
#define G_STORE_C(st) G_STORE(gs12, gs13, gs14, gs15, gs16, gs17, st)
#define G_COMPUTE(st, SWAPC, ACC) { \
    const u16* As_ = smem_ + (st) * GSTAGE; const u16* Bs_ = As_ + 256 * 72; \
    _Pragma("unroll") for (int kk = 0; kk < 4; ++kk) { \
      bf16x8 a0 = *(const bf16x8*)(As_ + (gwm * 64 + glr) * 72 + kk * 16 + glh * 8); \
      bf16x8 a1 = *(const bf16x8*)(As_ + (gwm * 64 + 32 + glr) * 72 + kk * 16 + glh * 8); \
      bf16x8 b0 = *(const bf16x8*)(Bs_ + (gwn * 64 + glr) * 72 + kk * 16 + glh * 8); \
      bf16x8 b1 = *(const bf16x8*)(Bs_ + (gwn * 64 + 32 + glr) * 72 + kk * 16 + glh * 8); \
      if (SWAPC) { \
        ACC[0][0] = MFMA(b0, a0, ACC[0][0]); ACC[0][1] = MFMA(b1, a0, ACC[0][1]); \
        ACC[1][0] = MFMA(b0, a1, ACC[1][0]); ACC[1][1] = MFMA(b1, a1, ACC[1][1]); \
      } else { \
        ACC[0][0] = MFMA(a0, b0, ACC[0][0]); ACC[0][1] = MFMA(a0, b1, ACC[0][1]); \
        ACC[1][0] = MFMA(a1, b0, ACC[1][0]); ACC[1][1] = MFMA(a1, b1, ACC[1][1]); } } }
#define G_STEP(k, SL, SS, SWAPC, ACC) if ((k) < nk_) { \
    if ((k) + 3 < nk_) G_LOAD_##SL(((k) + 3) << 6) \
    G_COMPUTE((k) & 1, SWAPC, ACC) \
    if ((k) + 1 < nk_) G_STORE_##SS(((k) + 1) & 1) \
    __syncthreads(); }
#define G_ISSUE(A_, LDA, B_, LDB, M0, N0, SSP) { \
    const int t_ = tid_opaque(); const int lrow = t_ >> 3, lkc = t_ & 7; const int lda_ = (LDA), ldb_ = (LDB); \
    const u16* Ap = (A_) + (size_t)((M0) + lrow) * lda_ + lkc * 8; \
    const u16* Bp = (B_) + (size_t)((N0) + lrow) * ldb_ + lkc * 8; \
    G_LOAD_A(0) G_LOAD_B(64) G_LOAD_C(128) \
    const float* ssp_ = (SSP); \
    if (ssp_ && t_ < 256) { const float4* q_ = (const float4*)(ssp_ + (size_t)((M0) + t_) * 16); gq0 = q_[0]; gq1 = q_[1]; gq2 = q_[2]; gq3 = q_[3]; } }
#define G_RSFIN(RS) { const int t_ = tid_opaque(); if (t_ < 256) { \
    const float s_ = ((gq0.x + gq0.y) + (gq0.z + gq0.w)) + ((gq1.x + gq1.y) + (gq1.z + gq1.w)) + ((gq2.x + gq2.y) + (gq2.z + gq2.w)) + ((gq3.x + gq3.y) + (gq3.z + gq3.w)); \
    (RS)[t_] = rsqrtf(s_ * (1.0f / 1024.0f) + EPS); } }
#define G_RUN(A_, LDA, B_, LDB, K_, M0, N0, SMEM, ACC, SWAPC) { \
    const int t_ = tid_opaque(), glane = t_ & 63, gw = t_ >> 6, gwm = gw >> 1, gwn = gw & 1; \
    const int glr = glane & 31, glh = glane >> 5; const int lrow = t_ >> 3, lkc = t_ & 7; const int lda_ = (LDA), ldb_ = (LDB); \
    u16* smem_ = (SMEM); \
    const u16* Ap = (A_) + (size_t)((M0) + lrow) * lda_ + lkc * 8; \
    const u16* Bp = (B_) + (size_t)((N0) + lrow) * ldb_ + lkc * 8; \
    const int nk_ = (K_) >> 6; \
    G_STORE_A(0) \
    __syncthreads(); \
    for (int ks = 0; ks < nk_; ks += 3) { \
      G_STEP(ks, A, B, SWAPC, ACC) \
      G_STEP(ks + 1, B, C, SWAPC, ACC) \
      G_STEP(ks + 2, C, A, SWAPC, ACC) } }

DI bool gemm_tile(int vbid, int it, int nt_n, int& m0, int& n0) {
  if (gridDim.x == 256) {
    const int x = vbid & 7, r = vbid >> 3;
    const int L = (it * 8 + x) * 32 + r;
    if (L >= NT_M * nt_n) return false;
    const int full = (NT_M / 4) * 4 * nt_n;
    int m, n;
    if (L < full) { const int band = L / (4 * nt_n), idx = L - band * 4 * nt_n; n = idx >> 2; m = band * 4 + (idx & 3); }
    else { const int idx = L - full; constexpr int rem = NT_M % 4; n = idx / rem; m = (NT_M / 4) * 4 + idx % rem; }
    m0 = m * 256; n0 = n * 128;
    return true;
  }
  const int tile = blockIdx.x + it * gridDim.x;
  m0 = (tile / nt_n) * 256; n0 = (tile % nt_n) * 128;
  return tile < NT_M * nt_n;
}
DI int gemm_rounds(int nt_n) {
  return (NT_M * nt_n + gridDim.x - 1) / gridDim.x;
}

DI void zero_acc(f32x16 (&acc)[2][2]) {
#pragma unroll
  for (int a = 0; a < 2; ++a)
#pragma unroll
    for (int b = 0; b < 2; ++b)
#pragma unroll
      for (int i = 0; i < 16; ++i) acc[a][b][i] = 0.f;
}

DI void load_rs(const float* ssp, int m0, float* rs_s) {
  __syncthreads();
  const int t = threadIdx.x;
  if (t < 256) {
    const float4* q = (const float4*)(ssp + (size_t)(m0 + t) * 16);
    const float4 a = q[0], b = q[1], c = q[2], d = q[3];
    const float s = ((a.x + a.y) + (a.z + a.w)) + ((b.x + b.y) + (b.z + b.w)) + ((c.x + c.y) + (c.z + c.w)) + ((d.x + d.y) + (d.z + d.w));
    rs_s[t] = rsqrtf(s * (1.0f / 1024.0f) + EPS);
  }
}

typedef __attribute__((ext_vector_type(4))) float f32x4;
constexpr int P8_HT = 128 * 64;
constexpr int RS8_OFF = 8 * P8_HT * 2;
DI int p8_lds_byte(int r, int c) {
  const int st = (r >> 4) * 2 + (c >> 5), rr = r & 15, cc = c & 31, ob = rr * 64 + cc * 2;
  return st * 1024 + (ob ^ (((ob >> 9) & 1) << 5));
}
DI void p8_stage_rc(int b, int& R, int& C) {
  const int st = b / 1024, sb = b % 1024, swz = sb ^ (((sb >> 9) & 1) << 5);
  R = (st >> 1) * 16 + swz / 64; C = (st & 1) * 32 + (swz % 64) / 2;
}
typedef __attribute__((address_space(3))) unsigned lds_u32;
typedef __attribute__((address_space(3))) unsigned char lds_u8;
typedef __attribute__((address_space(3))) bf16x8 lds_bf16x8;
DI void gemm8_tile(const u16* __restrict__ A, const u16* __restrict__ Bt, const int K, const int brow, const int bcol,
                   u16* shm, f32x4 (&acc)[2][2][4][2], const int klen = 0) {
#define P8_SA(b, h) (((b) * 2 + (h)) * 16384)
#define P8_SB(b, h) ((4 + (b) * 2 + (h)) * 16384)
#define P8_STAGE(P, BASE, br, kt) do { const char* _gb = (const char*)(BASE) + ((long)(br) * K + (long)(kt) * 64) * 2; \
    __builtin_amdgcn_global_load_lds((const unsigned*)(_gb + so0), (lds_u32*)(lds + (P) + lo0), 16, 0, 0); \
    __builtin_amdgcn_global_load_lds((const unsigned*)(_gb + (long)K * 128 + so0), (lds_u32*)(lds + (P) + lo0 + 8192), 16, 0, 0); } while (0)
#define P8_LDA(dst, b, h) _Pragma("unroll") for (int m = 0; m < 4; ++m) _Pragma("unroll") for (int k = 0; k < 2; ++k) \
    dst[m][k] = *(const lds_bf16x8*)(lds + P8_SA(b, h) + aoff + m * 2048 + k * 1024)
#define P8_LDB(dst, b, h) _Pragma("unroll") for (int n = 0; n < 2; ++n) _Pragma("unroll") for (int k = 0; k < 2; ++k) \
    dst[n][k] = *(const lds_bf16x8*)(lds + P8_SB(b, h) + boff + n * 2048 + k * 1024)
#define P8_MMA(ai, bj, At_, Bt_) do { __builtin_amdgcn_s_setprio(1); \
    _Pragma("unroll") for (int m = 0; m < 4; ++m) _Pragma("unroll") for (int n = 0; n < 2; ++n) _Pragma("unroll") for (int k = 0; k < 2; ++k) \
      acc[ai][bj][m][n] = __builtin_amdgcn_mfma_f32_16x16x32_bf16(Bt_[n][k], At_[m][k], acc[ai][bj][m][n], 0, 0, 0); \
    __builtin_amdgcn_s_setprio(0); } while (0)
#define P8_WAIT_V(n) asm volatile("s_waitcnt vmcnt(" #n ")" ::: "memory")
#define P8_WAIT_L(n) asm volatile("s_waitcnt lgkmcnt(" #n ")" ::: "memory")
#define P8_BAR __builtin_amdgcn_s_barrier()
#define P8_SCHED __builtin_amdgcn_sched_barrier(0)
  const int HALF = 128;
  const int tid8 = tid_opaque();
  const int wid = __builtin_amdgcn_readfirstlane(tid8 >> 6), lane = tid8 & 63, wr = wid >> 2, wc = wid & 3, fr = lane & 15, fq = lane >> 4;
  lds_u8* lds = (lds_u8*)shm;
  const int lo0 = tid8 * 16;
  const int aoff = p8_lds_byte(wr * 64 + fr, fq * 8), boff = p8_lds_byte(wc * 32 + fr, fq * 8);
  unsigned so0;
  { int r_, c_; p8_stage_rc(lo0, r_, c_); so0 = (unsigned)(r_ * K + c_) * 2u; }
  bf16x8 At[4][2], B0[2][2], B1[2][2];
  const int nt = (klen ? klen : K) / 64;
  P8_STAGE(P8_SB(0, 0), Bt, bcol, 0); P8_STAGE(P8_SA(0, 0), A, brow, 0);
  P8_STAGE(P8_SB(0, 1), Bt, bcol + HALF, 0); P8_STAGE(P8_SA(0, 1), A, brow + HALF, 0);
  if (wr == 1) P8_BAR;
  P8_WAIT_V(4); P8_BAR;
  P8_STAGE(P8_SB(1, 0), Bt, bcol, 1); P8_STAGE(P8_SA(1, 0), A, brow, 1); P8_STAGE(P8_SB(1, 1), Bt, bcol + HALF, 1);
  P8_WAIT_V(6); P8_BAR;
  for (int t = 0; t < nt - 2; t += 2) {
    P8_LDB(B0, 0, 0); P8_SCHED; P8_LDA(At, 0, 0); P8_STAGE(P8_SA(1, 1), A, brow + HALF, t + 1);
    P8_WAIT_L(8); P8_BAR; P8_WAIT_L(0); P8_MMA(0, 0, At, B0); P8_BAR; P8_SCHED;
    P8_LDB(B1, 0, 1); P8_STAGE(P8_SB(0, 0), Bt, bcol, t + 2);
    P8_BAR; P8_WAIT_L(0); P8_MMA(0, 1, At, B1); P8_BAR;
    P8_LDA(At, 0, 1); P8_STAGE(P8_SA(0, 0), A, brow, t + 2);
    P8_BAR; P8_WAIT_L(0); P8_MMA(1, 0, At, B0); P8_BAR; P8_SCHED;
    P8_STAGE(P8_SB(0, 1), Bt, bcol + HALF, t + 2);
    P8_WAIT_V(6); P8_BAR; P8_MMA(1, 1, At, B1); P8_BAR;
    P8_LDB(B0, 1, 0); P8_SCHED; P8_LDA(At, 1, 0); P8_STAGE(P8_SA(0, 1), A, brow + HALF, t + 2);
    P8_WAIT_L(8); P8_BAR; P8_WAIT_L(0); P8_MMA(0, 0, At, B0); P8_BAR; P8_SCHED;
    P8_LDB(B1, 1, 1); P8_STAGE(P8_SB(1, 0), Bt, bcol, t + 3);
    P8_BAR; P8_WAIT_L(0); P8_MMA(0, 1, At, B1); P8_BAR;
    P8_LDA(At, 1, 1); P8_STAGE(P8_SA(1, 0), A, brow, t + 3);
    P8_BAR; P8_WAIT_L(0); P8_MMA(1, 0, At, B0); P8_BAR; P8_SCHED;
    P8_STAGE(P8_SB(1, 1), Bt, bcol + HALF, t + 3);
    P8_WAIT_V(6); P8_BAR; P8_MMA(1, 1, At, B1); P8_BAR;
  }
  { P8_LDB(B0, 0, 0); P8_LDA(At, 0, 0); P8_STAGE(P8_SA(1, 1), A, brow + HALF, nt - 1);
    P8_BAR; P8_WAIT_L(0); P8_MMA(0, 0, At, B0); P8_BAR;
    P8_LDB(B1, 0, 1); P8_BAR; P8_WAIT_L(0); P8_MMA(0, 1, At, B1); P8_BAR;
    P8_LDA(At, 0, 1); P8_WAIT_V(4); P8_BAR; P8_WAIT_L(0); P8_MMA(1, 0, At, B0); P8_MMA(1, 1, At, B1); P8_BAR; }
  { P8_LDB(B0, 1, 0); P8_LDA(At, 1, 0); P8_WAIT_V(2); P8_BAR; P8_WAIT_L(0); P8_MMA(0, 0, At, B0); P8_BAR;
    P8_LDB(B1, 1, 1); P8_WAIT_V(0); P8_BAR; P8_WAIT_L(0); P8_MMA(0, 1, At, B1); P8_BAR;
    P8_LDA(At, 1, 1); P8_BAR; P8_WAIT_L(0); P8_MMA(1, 0, At, B0); P8_MMA(1, 1, At, B1); P8_BAR; }
  if (wr == 0) P8_BAR;
}

DI void phase_gateup(const Params& p, char* smem, size_t off_ssp, size_t off_w, int vbid) {
  const u16* A = (const u16*)(p.ws + OFF_XB);
  const u16* B = (const u16*)(p.ws + off_w);
  const float* ssp = (const float*)(p.ws + off_ssp);
  u16* hid = (u16*)(p.ws + OFF_HID);
  float* rs_s = (float*)(smem + RS8_OFF);
  const int nr = gemm_rounds(22);
  for (int it = 0; it < nr; ++it) {
    int m0, n0;
    if (!gemm_tile(vbid, it, 22, m0, n0)) continue;
    n0 *= 2;
    load_rs(ssp, m0, rs_s);
    __syncthreads();
    f32x4 acc[2][2][4][2];
#pragma unroll
    for (int a_ = 0; a_ < 2; ++a_)
#pragma unroll
      for (int b_ = 0; b_ < 2; ++b_)
#pragma unroll
        for (int m_ = 0; m_ < 4; ++m_)
#pragma unroll
          for (int n_ = 0; n_ < 2; ++n_) acc[a_][b_][m_][n_] = (f32x4){0.f, 0.f, 0.f, 0.f};
    gemm8_tile(A, B, 1024, m0, n0, (u16*)smem, acc);
    const int t = tid_opaque(), lane = t & 63, wid = t >> 6, wr = wid >> 2, wc = wid & 3, fr = lane & 15, fq = lane >> 4;
#pragma unroll
    for (int ai = 0; ai < 2; ++ai)
#pragma unroll
      for (int m = 0; m < 4; ++m) {
        const int rl = ai * 128 + wr * 64 + m * 16 + fr; const int row = m0 + rl;
        if (row < T) {
          const float r = rs_s[rl];
#pragma unroll
          for (int bj = 0; bj < 2; ++bj) {
            float hv[4];
#pragma unroll
            for (int j = 0; j < 4; ++j) {
              const float gg = acc[ai][bj][m][0][j] * r, uu = acc[ai][bj][m][1][j] * r;
              hv[j] = gg / (1.0f + __expf(-gg)) * uu;
            }
            const int hc = ((n0 + bj * 128 + wc * 32) >> 1) + fq * 4;
            *(uint2*)(hid + (size_t)row * 2816 + hc) = make_uint2(pack2(hv[0], hv[1]), pack2(hv[2], hv[3]));
          }
        }
      }
  }
}

DI void phase_merge8(const Params& p, char* smem, int vbid) {
  const u16* OA = (const u16*)(p.ws + OFF_OA); const u16* OB = (const u16*)(p.ws + OFF_OB);
  const u16* WA = (const u16*)(p.ws + OFF_WA); const u16* WB = (const u16*)(p.ws + OFF_WB);
  const u16* G = (const u16*)(p.ws + OFF_G);
  u16* MB = (u16*)(p.ws + OFF_MB);
  float* tmp = (float*)(p.ws + OFF_HID);
  float* part_buf = (float*)(p.ws + OFF_BQ);
  const bool splitmode = gridDim.x == 256;
  const int nr = splitmode ? 1 : gemm_rounds(4);
  const int nitem = splitmode ? 12 * 8 : 0;
  for (int itx = 0; itx < nr + (nitem ? 1 : 0); ++itx) {
    int m0, n0, slice = -1, spass = 0;
    if (itx < nr) {
      if (!gemm_tile(vbid, itx, 4, m0, n0)) continue;
      n0 *= 2;
    } else {
      if (vbid >= nitem) continue;
      const int tl = vbid >> 3; spass = (vbid >> 2) & 1; slice = vbid & 3;
      m0 = (64 + (tl >> 2)) * 256; n0 = (tl & 3) * 256;
    }
#pragma unroll 1
    for (int pass = (slice < 0 ? 0 : spass); pass < (slice < 0 ? 2 : spass + 1); ++pass) {
      __syncthreads();
      f32x4 acc[2][2][4][2];
#pragma unroll
      for (int a_ = 0; a_ < 2; ++a_)
#pragma unroll
        for (int b_ = 0; b_ < 2; ++b_)
#pragma unroll
          for (int m_ = 0; m_ < 4; ++m_)
#pragma unroll
            for (int n_ = 0; n_ < 2; ++n_) acc[a_][b_][m_][n_] = (f32x4){0.f, 0.f, 0.f, 0.f};
      {
        const int koff = slice < 0 ? 0 : slice * 256;
        gemm8_tile((pass ? OB : OA) + koff, (pass ? WB : WA) + koff, 1024, m0, n0, (u16*)smem, acc, slice < 0 ? 1024 : 256);
      }
      const int t = tid_opaque(), lane = t & 63, wid = t >> 6, wr = wid >> 2, wc = wid & 3, fr = lane & 15, fq = lane >> 4;
      float* pb = part_buf + (size_t)(pass * 4 + (slice < 0 ? 0 : slice)) * 768 * 1024;
#pragma unroll
      for (int ai = 0; ai < 2; ++ai)
#pragma unroll
        for (int m = 0; m < 4; ++m) {
          const int row = m0 + ai * 128 + wr * 64 + m * 16 + fr;
          if (row >= T) continue;
#pragma unroll
          for (int bj = 0; bj < 2; ++bj)
#pragma unroll
            for (int n = 0; n < 2; ++n) {
              const int col = n0 + bj * 128 + wc * 32 + n * 16 + fq * 4;
              if (slice >= 0) {
                *(float4*)(pb + (size_t)(row - 16384) * 1024 + col) = make_float4(acc[ai][bj][m][n][0], acc[ai][bj][m][n][1], acc[ai][bj][m][n][2], acc[ai][bj][m][n][3]);
                continue;
              }
              const uint2 gg = *(const uint2*)(G + (size_t)row * 2048 + pass * 1024 + col);
              const float g0 = __uint_as_float(gg.x << 16), g1 = __uint_as_float(gg.x & 0xffff0000u);
              const float g2 = __uint_as_float(gg.y << 16), g3 = __uint_as_float(gg.y & 0xffff0000u);
              float4 v = make_float4(g0 * acc[ai][bj][m][n][0], g1 * acc[ai][bj][m][n][1], g2 * acc[ai][bj][m][n][2], g3 * acc[ai][bj][m][n][3]);
              float* tp = tmp + (size_t)row * 1024 + col;
              if (pass == 0) *(float4*)tp = v;
              else {
                const float4 u = *(const float4*)tp;
                *(uint2*)(MB + (size_t)row * 1024 + col) = make_uint2(pack2(u.x + v.x, u.y + v.y), pack2(u.z + v.z, u.w + v.w));
              }
            }
        }
    }
  }
  if (splitmode) {
    gbar(p, smem);
    const int t = tid_opaque(), lane = t & 63;
    const int wv = vbid * 8 + (t >> 6);
    for (int rr = wv; rr < T - 16384; rr += 256 * 8) {
      const int row = 16384 + rr;
#pragma unroll
      for (int i = 0; i < 4; ++i) {
        const int col = (lane + 64 * i) * 4;
        float4 sa = make_float4(0.f, 0.f, 0.f, 0.f), sb = sa;
        for (int sl = 0; sl < 4; ++sl) {
          const float4 qa = *(const float4*)(part_buf + ((size_t)sl * 768 + rr) * 1024 + col);
          const float4 qb = *(const float4*)(part_buf + ((size_t)(4 + sl) * 768 + rr) * 1024 + col);
          sa.x += qa.x; sa.y += qa.y; sa.z += qa.z; sa.w += qa.w;
          sb.x += qb.x; sb.y += qb.y; sb.z += qb.z; sb.w += qb.w;
        }
        const uint2 ga = *(const uint2*)(G + (size_t)row * 2048 + col);
        const uint2 gb = *(const uint2*)(G + (size_t)row * 2048 + 1024 + col);
        const float m0v = __uint_as_float(ga.x << 16) * sa.x + __uint_as_float(gb.x << 16) * sb.x;
        const float m1v = __uint_as_float(ga.x & 0xffff0000u) * sa.y + __uint_as_float(gb.x & 0xffff0000u) * sb.y;
        const float m2v = __uint_as_float(ga.y << 16) * sa.z + __uint_as_float(gb.y << 16) * sb.z;
        const float m3v = __uint_as_float(ga.y & 0xffff0000u) * sa.w + __uint_as_float(gb.y & 0xffff0000u) * sb.w;
        *(uint2*)(MB + (size_t)row * 1024 + col) = make_uint2(pack2(m0v, m1v), pack2(m2v, m3v));
      }
    }
  }
}

template <int RESID_ORIG>
DI void phase_resid8(const Params& p, char* smem, const u16* A, int K, size_t off_w, float factor, size_t off_ssp_out, int vbid) {
  const u16* B = (const u16*)(p.ws + off_w);
  float* xf = (float*)(p.ws + OFF_XF);
  u16* xb = (u16*)(p.ws + OFF_XB);
  float* sspo = (float*)(p.ws + off_ssp_out);
  float* part_buf = (float*)(p.ws + OFF_G);
  const bool splitmode = gridDim.x == 256;
  const int nslice = K >> 8;
  const int nr = splitmode ? 1 : gemm_rounds(4);
  const int nitem = splitmode ? 12 * nslice : 0;
  for (int itx = 0; itx < nr + (nitem + 255) / 256; ++itx) {
    int m0, n0, slice = -1;
    if (itx < nr) {
      if (!gemm_tile(vbid, itx, 4, m0, n0)) continue;
      n0 *= 2;
    } else {
      const int id = (itx - nr) * 256 + vbid;
      if (id >= nitem) continue;
      const int tl = id / nslice; slice = id - tl * nslice;
      m0 = (64 + (tl >> 2)) * 256; n0 = (tl & 3) * 256;
    }
    __syncthreads();
    f32x4 acc[2][2][4][2];
#pragma unroll
    for (int a_ = 0; a_ < 2; ++a_)
#pragma unroll
      for (int b_ = 0; b_ < 2; ++b_)
#pragma unroll
        for (int m_ = 0; m_ < 4; ++m_)
#pragma unroll
          for (int n_ = 0; n_ < 2; ++n_) acc[a_][b_][m_][n_] = (f32x4){0.f, 0.f, 0.f, 0.f};
    {
      const int koff = slice < 0 ? 0 : slice * 256;
      gemm8_tile(A + koff, B + koff, K, m0, n0, (u16*)smem, acc, slice < 0 ? K : 256);
    }
    const int t = tid_opaque(), lane = t & 63, wid = t >> 6, wr = wid >> 2, wc = wid & 3, fr = lane & 15, fq = lane >> 4;
    const int pn = n0 >> 8;
    if (slice >= 0) {
      float* pb = part_buf + (size_t)slice * 768 * 1024;
#pragma unroll
      for (int ai = 0; ai < 2; ++ai)
#pragma unroll
        for (int m = 0; m < 4; ++m) {
          const int row = m0 + ai * 128 + wr * 64 + m * 16 + fr;
          if (row >= T) continue;
#pragma unroll
          for (int bj = 0; bj < 2; ++bj)
#pragma unroll
            for (int n = 0; n < 2; ++n) {
              const int col = n0 + bj * 128 + wc * 32 + n * 16 + fq * 4;
              *(float4*)(pb + (size_t)(row - 16384) * 1024 + col) = make_float4(acc[ai][bj][m][n][0], acc[ai][bj][m][n][1], acc[ai][bj][m][n][2], acc[ai][bj][m][n][3]);
            }
        }
      continue;
    }
#pragma unroll
    for (int ai = 0; ai < 2; ++ai)
#pragma unroll
      for (int m = 0; m < 4; ++m) {
        const int row = m0 + ai * 128 + wr * 64 + m * 16 + fr;
        const bool ok = row < T;
        float part = 0.f;
        if (ok) {
          const float* rsrc = RESID_ORIG ? xrow_ptr(p, row) : (xf + (size_t)row * 1024);
#pragma unroll
          for (int bj = 0; bj < 2; ++bj)
#pragma unroll
            for (int n = 0; n < 2; ++n) {
              const int col = n0 + bj * 128 + wc * 32 + n * 16 + fq * 4;
              const float4 xr = *(const float4*)(rsrc + col);
              float4 v;
              v.x = xr.x + factor * acc[ai][bj][m][n][0]; v.y = xr.y + factor * acc[ai][bj][m][n][1];
              v.z = xr.z + factor * acc[ai][bj][m][n][2]; v.w = xr.w + factor * acc[ai][bj][m][n][3];
              *(float4*)(xf + (size_t)row * 1024 + col) = v;
              *(uint2*)(xb + (size_t)row * 1024 + col) = make_uint2(pack2(v.x, v.y), pack2(v.z, v.w));
              part += v.x * v.x + v.y * v.y + v.z * v.z + v.w * v.w;
            }
        }
        part += shx(part, 16); part += shx(part, 32);
        if (ok && fq == 0) sspo[(size_t)row * 16 + pn * 4 + wc] = part;
      }
  }
  if (splitmode) {
    gbar(p, smem);
    const int t = tid_opaque(), lane = t & 63;
    const int wv = vbid * 8 + (t >> 6);
    const float* px_ = p.in[0]; const float* ps_ = p.in[1];
    for (int rr = wv; rr < T - 16384; rr += 256 * 8) {
      const int row = 16384 + rr;
      const float* rsrc = RESID_ORIG ? (row < TP ? px_ + (size_t)(8192 + row - NTOKP - 16) * 1024 : ps_ + (size_t)(row - TP) * 1024) : (xf + (size_t)row * 1024);
      float ss = 0.f;
#pragma unroll
      for (int i = 0; i < 4; ++i) {
        const int col = (lane + 64 * i) * 4;
        float4 sum = make_float4(0.f, 0.f, 0.f, 0.f);
        for (int sl = 0; sl < nslice; ++sl) {
          const float4 q = *(const float4*)(part_buf + ((size_t)sl * 768 + rr) * 1024 + col);
          sum.x += q.x; sum.y += q.y; sum.z += q.z; sum.w += q.w;
        }
        const float4 xr = *(const float4*)(rsrc + col);
        float4 v;
        v.x = xr.x + factor * sum.x; v.y = xr.y + factor * sum.y; v.z = xr.z + factor * sum.z; v.w = xr.w + factor * sum.w;
        *(float4*)(xf + (size_t)row * 1024 + col) = v;
        *(uint2*)(xb + (size_t)row * 1024 + col) = make_uint2(pack2(v.x, v.y), pack2(v.z, v.w));
        ss += v.x * v.x + v.y * v.y + v.z * v.z + v.w * v.w;
      }
#pragma unroll
      for (int mm = 32; mm >= 1; mm >>= 1) ss += shx(ss, mm);
      if (lane < 16) sspo[(size_t)row * 16 + lane] = lane == 0 ? ss : 0.f;
    }
  }
}

template <int RESID_ORIG>
DI void phase_resid(const Params& p, char* smem, const u16* A, int lda, int K, size_t off_w, float factor, size_t off_ssp_out, int vbid) {
  const u16* B = (const u16*)(p.ws + off_w);
  float* xf = (float*)(p.ws + OFF_XF);
  u16* xb = (u16*)(p.ws + OFF_XB);
  float* sspo = (float*)(p.ws + off_ssp_out);
  G_DECL
  const int nr = gemm_rounds(8);
  int it = 0, m0 = 0, n0 = 0;
  while (it < nr && !gemm_tile(vbid, it, 8, m0, n0)) ++it;
  if (it < nr) G_ISSUE(A, lda, B, K, m0, n0, (const float*)nullptr)
  while (it < nr) {
    f32x16 acc[2][2]; zero_acc(acc);
    G_RUN(A, lda, B, K, K, m0, n0, (u16*)smem, acc, true)
    const int cm0 = m0, cn0 = n0; const int nt = cn0 >> 7;
    ++it;
    while (it < nr && !gemm_tile(vbid, it, 8, m0, n0)) ++it;
    if (it < nr) G_ISSUE(A, lda, B, K, m0, n0, (const float*)nullptr)
    const int t = tid_opaque(), lane = t & 63, w = t >> 6, wm = w >> 1, wn = w & 1, lr = lane & 31, lh = lane >> 5;
#pragma unroll
    for (int mi = 0; mi < 2; ++mi) {
      const int row = cm0 + wm * 64 + mi * 32 + lr;
      const bool ok = row < T;
      float part = 0.f;
      if (ok) {
        const float* rsrc = RESID_ORIG ? xrow_ptr(p, row) : (xf + (size_t)row * 1024);
#pragma unroll
        for (int ni = 0; ni < 2; ++ni)
#pragma unroll
          for (int g = 0; g < 4; ++g) {
            const int col = cn0 + wn * 64 + ni * 32 + 8 * g + 4 * lh;
            const float4 xr = *(const float4*)(rsrc + col);
            float4 v;
            v.x = xr.x + factor * acc[mi][ni][4 * g]; v.y = xr.y + factor * acc[mi][ni][4 * g + 1];
            v.z = xr.z + factor * acc[mi][ni][4 * g + 2]; v.w = xr.w + factor * acc[mi][ni][4 * g + 3];
            *(float4*)(xf + (size_t)row * 1024 + col) = v;
            *(uint2*)(xb + (size_t)row * 1024 + col) = make_uint2(pack2(v.x, v.y), pack2(v.z, v.w));
            part += v.x * v.x + v.y * v.y + v.z * v.z + v.w * v.w;
          }
      }
      part += shx(part, 32);
      if (ok && lh == 0) sspo[(size_t)row * 16 + nt * 2 + wn] = part;
    }
  }
}

DI void phase_win(const Params& p, char* smem, int vbid) {
  const u16* A = (const u16*)(p.ws + OFF_XB);
  const u16* B = (const u16*)(p.ws + OFF_WIN);
  const float* ssp = (const float*)(p.ws + OFF_SSP1);
  const float2* tab = (const float2*)(p.ws + OFF_TAB);
  u16* AQ = (u16*)(p.ws + OFF_AQ); u16* BQ = (u16*)(p.ws + OFF_BQ); u16* IQ = (u16*)(p.ws + OFF_IQ);
  float* IW = (float*)(p.ws + OFF_IW); u16* G = (u16*)(p.ws + OFF_G);
  float* out = p.out;
  float* rs_all = (float*)(smem + RS_OFF);
  G_DECL
  const int nr = gemm_rounds(69);
  int it = 0, m0n = 0, n0n = 0, par = 0;
  while (it < nr && !gemm_tile(vbid, it, 69, m0n, n0n)) ++it;
  while (it < nr) {
    float* rs_s = rs_all + par * 256; par ^= 1;
    load_rs(ssp, m0n, rs_s);
    G_ISSUE(A, 1024, B, 1024, m0n, n0n, (const float*)nullptr)
    f32x16 acc[2][2]; zero_acc(acc);
    const int vgw = __builtin_amdgcn_readfirstlane((n0n >> 6) + ((tid_opaque() >> 6) & 1));
    const bool swapw = !((vgw >= 32 && vgw < 48) || (vgw >= 80 && vgw < 96));
    if (swapw) G_RUN(A, 1024, B, 1024, 1024, m0n, n0n, (u16*)smem, acc, true)
    else G_RUN(A, 1024, B, 1024, 1024, m0n, n0n, (u16*)smem, acc, false)
    const int m0 = m0n, n0 = n0n;
    const int t = tid_opaque(), lane = t & 63, w = t >> 6, wm = w >> 1, wn = w & 1, lr = lane & 31, lh = lane >> 5;
    const int vg = vgw;
    if (!swapw) {
      const int q = vg < 48 ? vg - 32 : vg - 80;
      u16* vtb = (u16*)(p.ws + (vg < 48 ? OFF_AVT : OFF_BVT));
#pragma unroll
      for (int mi = 0; mi < 2; ++mi)
#pragma unroll
        for (int g = 0; g < 4; ++g) {
          const int rl = wm * 64 + mi * 32 + 8 * g + 4 * lh; const int row = m0 + rl;
          if (row < TP) {
            const int bb = row >= NTOKP ? 1 : 0; const int tok = row - bb * NTOKP;
            const float r0 = rs_s[rl], r1 = rs_s[rl + 1], r2 = rs_s[rl + 2], r3 = rs_s[rl + 3];
#pragma unroll
            for (int ni = 0; ni < 2; ++ni) {
              const int d = (q & 1) * 64 + ni * 32 + lr;
              u16* dst = vtb + ((size_t)(bb * 8 + (q >> 1)) * 128 + d) * VTPAD + tok;
              *(uint2*)dst = make_uint2(pack2(acc[mi][ni][4 * g] * r0, acc[mi][ni][4 * g + 1] * r1),
                                        pack2(acc[mi][ni][4 * g + 2] * r2, acc[mi][ni][4 * g + 3] * r3));
            }
          }
        }
#pragma unroll
      for (int mi = 0; mi < 2; ++mi)
#pragma unroll
        for (int i = 0; i < 16; ++i) {
          const int rl = wm * 64 + mi * 32 + crow(i, lh); const int row = m0 + rl;
          if (row >= T) continue;
          const float r = rs_s[rl];
          const float v0 = acc[mi][0][i] * r, v1 = acc[mi][1][i] * r;
          const bool smp = row >= TP;
          const int orow = smp ? row - TP : row;
          float* d = out + (vg < 48 ? (smp ? O_AVS : O_AVP) : (smp ? O_BVS : O_BVP)) + (size_t)orow * 1024 + q * 64 + lr;
          d[0] = v0; d[32] = v1;
        }
    } else {
#pragma unroll
      for (int mi = 0; mi < 2; ++mi) {
        int rl = wm * 64 + mi * 32 + lr;
        asm volatile("" : "+v"(rl));
        const int row = m0 + rl;
        if (row >= T) continue;
        const float r = rs_s[rl];
        const bool smp = row >= TP;
        const int orow = smp ? row - TP : row;
        const int bb = (!smp && row >= NTOKP) ? 1 : 0;
        const int tok = row - bb * NTOKP;
        const int pos = smp ? (NCACHE + (orow & 31)) : tok;
#pragma unroll
        for (int g = 0; g < 4; ++g) {
          const int c0 = 8 * g + 4 * lh;
          float v0[4], v1[4];
#pragma unroll
          for (int j = 0; j < 4; ++j) { v0[j] = acc[mi][0][4 * g + j] * r; v1[j] = acc[mi][1][4 * g + j] * r; }
          if (vg < 32 || (vg >= 96 && vg < 105)) {
            float o0[4], o1[4];
#pragma unroll
            for (int j = 0; j < 4; ++j) {
              const float2 cs = tab[pos * 64 + 2 * (c0 + j)];
              o0[j] = v0[j] * cs.x - v1[j] * cs.y; o1[j] = v1[j] * cs.x + v0[j] * cs.y;
            }
            if (vg < 16) {
              u16* d = AQ + (size_t)row * 1024 + vg * 64 + c0;
              *(uint2*)d = make_uint2(pack2(o0[0] * QA_SCALE, o0[1] * QA_SCALE), pack2(o0[2] * QA_SCALE, o0[3] * QA_SCALE));
              *(uint2*)(d + 32) = make_uint2(pack2(o1[0] * QA_SCALE, o1[1] * QA_SCALE), pack2(o1[2] * QA_SCALE, o1[3] * QA_SCALE));
            } else if (vg < 32) {
              float* d = out + (smp ? O_AKS : O_AKP) + (size_t)orow * 1024 + (vg - 16) * 64 + c0;
              *(float4*)d = make_float4(o0[0], o0[1], o0[2], o0[3]);
              *(float4*)(d + 32) = make_float4(o1[0], o1[1], o1[2], o1[3]);
              if (!smp) {
                const int q = vg - 16;
                u16* db = (u16*)(p.ws + OFF_AKB) + ((size_t)(bb * 8 + (q >> 1)) * NTOKP + tok) * 128 + (q & 1) * 64 + c0;
                *(uint2*)db = make_uint2(pack2(o0[0], o0[1]), pack2(o0[2], o0[3]));
                *(uint2*)(db + 32) = make_uint2(pack2(o1[0], o1[1]), pack2(o1[2], o1[3]));
              }
            } else if (vg < 104) {
              u16* d = IQ + (size_t)row * 512 + (vg - 96) * 64 + c0;
              *(uint2*)d = make_uint2(pack2(o0[0], o0[1]), pack2(o0[2], o0[3]));
              *(uint2*)(d + 32) = make_uint2(pack2(o1[0], o1[1]), pack2(o1[2], o1[3]));
            } else {
              float* d = out + (smp ? O_IKS : O_IKP) + (size_t)orow * 64 + c0;
              *(float4*)d = make_float4(o0[0], o0[1], o0[2], o0[3]);
              *(float4*)(d + 32) = make_float4(o1[0], o1[1], o1[2], o1[3]);
              if (!smp) {
                u16* db = (u16*)(p.ws + OFF_IKB) + (size_t)row * 64 + c0;
                *(uint2*)db = make_uint2(pack2(o0[0], o0[1]), pack2(o0[2], o0[3]));
                *(uint2*)(db + 32) = make_uint2(pack2(o1[0], o1[1]), pack2(o1[2], o1[3]));
              }
            }
          } else if (vg < 80) {
            const int q = vg < 64 ? vg - 48 : vg - 64; const int hh = q >> 1, gi = q & 1;
            float o0[4], o1[4];
            const float4* tp = (const float4*)(tab + pos * 64 + gi * 32 + c0);
            const float4 t01 = tp[0], t23 = tp[1];
            o0[0] = v0[0] * t01.x - v1[0] * t01.y; o1[0] = v1[0] * t01.x + v0[0] * t01.y;
            o0[1] = v0[1] * t01.z - v1[1] * t01.w; o1[1] = v1[1] * t01.z + v0[1] * t01.w;
            o0[2] = v0[2] * t23.x - v1[2] * t23.y; o1[2] = v1[2] * t23.x + v0[2] * t23.y;
            o0[3] = v0[3] * t23.z - v1[3] * t23.w; o1[3] = v1[3] * t23.z + v0[3] * t23.w;
            if (vg < 64) {
              u16* d = BQ + (size_t)row * 1024 + hh * 128 + gi * 32 + c0;
              *(uint2*)d = make_uint2(pack2(o0[0] * QB_SCALE, o0[1] * QB_SCALE), pack2(o0[2] * QB_SCALE, o0[3] * QB_SCALE));
              *(uint2*)(d + 64) = make_uint2(pack2(o1[0] * QB_SCALE, o1[1] * QB_SCALE), pack2(o1[2] * QB_SCALE, o1[3] * QB_SCALE));
            } else {
              float* d = out + (smp ? O_BKS : O_BKP) + (size_t)orow * 1024 + hh * 128 + gi * 32 + c0;
              *(float4*)d = make_float4(o0[0], o0[1], o0[2], o0[3]);
              *(float4*)(d + 64) = make_float4(o1[0], o1[1], o1[2], o1[3]);
              if (!smp) {
                u16* db = (u16*)(p.ws + OFF_BKB) + ((size_t)(bb * 8 + hh) * NTOKP + tok) * 128 + gi * 32 + c0;
                *(uint2*)db = make_uint2(pack2(o0[0], o0[1]), pack2(o0[2], o0[3]));
                *(uint2*)(db + 64) = make_uint2(pack2(o1[0], o1[1]), pack2(o1[2], o1[3]));
              }
            }
          } else if (vg == 105) {
            if (g == 0) *(float4*)(IW + (size_t)row * 8 + c0) = make_float4(v0[0] * IW_SCALE, v0[1] * IW_SCALE, v0[2] * IW_SCALE, v0[3] * IW_SCALE);
          } else {
            u16* d = G + (size_t)row * 2048 + (vg - 106) * 64 + c0;
            float s0[4], s1[4];
#pragma unroll
            for (int j = 0; j < 4; ++j) { s0[j] = 1.0f / (1.0f + __expf(-v0[j])); s1[j] = 1.0f / (1.0f + __expf(-v1[j])); }
            *(uint2*)d = make_uint2(pack2(s0[0], s0[1]), pack2(s0[2], s0[3]));
            *(uint2*)(d + 32) = make_uint2(pack2(s1[0], s1[1]), pack2(s1[2], s1[3]));
          }
          __builtin_amdgcn_sched_barrier(0);
        }
      }
    }
    ++it;
    while (it < nr && !gemm_tile(vbid, it, 69, m0n, n0n)) ++it;
  }
}

DI void phase_win8(const Params& p, char* smem, int vbid) {
  const u16* A = (const u16*)(p.ws + OFF_XB);
  const u16* B = (const u16*)(p.ws + OFF_WIN);
  const float* ssp = (const float*)(p.ws + OFF_SSP1);
  const float2* tab = (const float2*)(p.ws + OFF_TAB);
  u16* AQ = (u16*)(p.ws + OFF_AQ); u16* BQ = (u16*)(p.ws + OFF_BQ); u16* IQ = (u16*)(p.ws + OFF_IQ);
  float* IW = (float*)(p.ws + OFF_IW); u16* Gt = (u16*)(p.ws + OFF_G);
  float* out = p.out;
  float* rs_s = (float*)(smem + RS8_OFF);
  const int nr = gemm_rounds(35);
  for (int it = 0; it < nr; ++it) {
    int m0, n0;
    if (!gemm_tile(vbid, it, 35, m0, n0)) continue;
    n0 *= 2;
    load_rs(ssp, m0, rs_s);
    __syncthreads();
    f32x4 acc[2][2][4][2];
#pragma unroll
    for (int a_ = 0; a_ < 2; ++a_)
#pragma unroll
      for (int b_ = 0; b_ < 2; ++b_)
#pragma unroll
        for (int m_ = 0; m_ < 4; ++m_)
#pragma unroll
          for (int n_ = 0; n_ < 2; ++n_) acc[a_][b_][m_][n_] = (f32x4){0.f, 0.f, 0.f, 0.f};
    gemm8_tile(A, B, 1024, m0, n0, (u16*)smem, acc);
    const int t = tid_opaque(), lane = t & 63, wid = __builtin_amdgcn_readfirstlane(t >> 6), wr = wid >> 2, wc = wid & 3, fr = lane & 15, fq = lane >> 4;
    const int o = fq * 4;
#pragma unroll
    for (int bj = 0; bj < 2; ++bj) {
      const int G = (n0 >> 5) + bj * 4 + wc;
      if (G >= 275) continue;
#pragma unroll
      for (int ai = 0; ai < 2; ++ai)
#pragma unroll
        for (int m = 0; m < 4; ++m) {
          int rl = ai * 128 + wr * 64 + m * 16 + fr;
          asm volatile("" : "+v"(rl));
          const int row = m0 + rl;
          if (row >= T) continue;
          const float r = rs_s[rl];
          const bool smp = row >= TP;
          const int orow = smp ? row - TP : row;
          const int bb = (!smp && row >= NTOKP) ? 1 : 0;
          const int tok = row - bb * NTOKP;
          const int pos = smp ? (NCACHE + (orow & 31)) : tok;
          float v0[4], v1[4];
#pragma unroll
          for (int j = 0; j < 4; ++j) { v0[j] = acc[ai][bj][m][0][j] * r; v1[j] = acc[ai][bj][m][1][j] * r; }
          if (G < 64 || (G >= 192 && G < 210)) {
            const int q = G < 64 ? (G & 31) : (G < 208 ? G - 192 : G - 208);
            const int g = G < 208 ? (q & 1) : q;
            const int hd = G < 208 ? (q >> 1) : 0;
            const int d0 = 16 * g + o;
            float o0[4], o1[4];
#pragma unroll
            for (int j = 0; j < 4; ++j) {
              const float2 cs = tab[pos * 64 + 2 * (d0 + j)];
              o0[j] = v0[j] * cs.x - v1[j] * cs.y; o1[j] = v1[j] * cs.x + v0[j] * cs.y;
            }
            if (G < 32) {
              u16* d = AQ + (size_t)row * 1024 + hd * 64 + d0;
              *(uint2*)d = make_uint2(pack2(o0[0] * QA_SCALE, o0[1] * QA_SCALE), pack2(o0[2] * QA_SCALE, o0[3] * QA_SCALE));
              *(uint2*)(d + 32) = make_uint2(pack2(o1[0] * QA_SCALE, o1[1] * QA_SCALE), pack2(o1[2] * QA_SCALE, o1[3] * QA_SCALE));
            } else if (G < 64) {
              float* d = out + (smp ? O_AKS : O_AKP) + (size_t)orow * 1024 + hd * 64 + d0;
              *(float4*)d = make_float4(o0[0], o0[1], o0[2], o0[3]);
              *(float4*)(d + 32) = make_float4(o1[0], o1[1], o1[2], o1[3]);
              if (!smp) {
                u16* db = (u16*)(p.ws + OFF_AKB) + ((size_t)(bb * 8 + (hd >> 1)) * NTOKP + tok) * 128 + (hd & 1) * 64 + d0;
                *(uint2*)db = make_uint2(pack2(o0[0], o0[1]), pack2(o0[2], o0[3]));
                *(uint2*)(db + 32) = make_uint2(pack2(o1[0], o1[1]), pack2(o1[2], o1[3]));
              }
            } else if (G < 208) {
              u16* d = IQ + (size_t)row * 512 + hd * 64 + d0;
              *(uint2*)d = make_uint2(pack2(o0[0], o0[1]), pack2(o0[2], o0[3]));
              *(uint2*)(d + 32) = make_uint2(pack2(o1[0], o1[1]), pack2(o1[2], o1[3]));
            } else {
              float* d = out + (smp ? O_IKS : O_IKP) + (size_t)orow * 64 + d0;
              *(float4*)d = make_float4(o0[0], o0[1], o0[2], o0[3]);
              *(float4*)(d + 32) = make_float4(o1[0], o1[1], o1[2], o1[3]);
              if (!smp) {
                u16* db = (u16*)(p.ws + OFF_IKB) + (size_t)row * 64 + d0;
                *(uint2*)db = make_uint2(pack2(o0[0], o0[1]), pack2(o0[2], o0[3]));
                *(uint2*)(db + 32) = make_uint2(pack2(o1[0], o1[1]), pack2(o1[2], o1[3]));
              }
            }
          } else if (G >= 96 && G < 160) {
            const int q = (G - 96) & 31; const int hh = q >> 2, g = q & 3;
            const int d0 = 16 * g + o;
            const float4* tp = (const float4*)(tab + pos * 64 + d0);
            const float4 t01 = tp[0], t23 = tp[1];
            float o0[4], o1[4];
            o0[0] = v0[0] * t01.x - v1[0] * t01.y; o1[0] = v1[0] * t01.x + v0[0] * t01.y;
            o0[1] = v0[1] * t01.z - v1[1] * t01.w; o1[1] = v1[1] * t01.z + v0[1] * t01.w;
            o0[2] = v0[2] * t23.x - v1[2] * t23.y; o1[2] = v1[2] * t23.x + v0[2] * t23.y;
            o0[3] = v0[3] * t23.z - v1[3] * t23.w; o1[3] = v1[3] * t23.z + v0[3] * t23.w;
            if (G < 128) {
              u16* d = BQ + (size_t)row * 1024 + hh * 128 + d0;
              *(uint2*)d = make_uint2(pack2(o0[0] * QB_SCALE, o0[1] * QB_SCALE), pack2(o0[2] * QB_SCALE, o0[3] * QB_SCALE));
              *(uint2*)(d + 64) = make_uint2(pack2(o1[0] * QB_SCALE, o1[1] * QB_SCALE), pack2(o1[2] * QB_SCALE, o1[3] * QB_SCALE));
            } else {
              float* d = out + (smp ? O_BKS : O_BKP) + (size_t)orow * 1024 + hh * 128 + d0;
              *(float4*)d = make_float4(o0[0], o0[1], o0[2], o0[3]);
              *(float4*)(d + 64) = make_float4(o1[0], o1[1], o1[2], o1[3]);
              if (!smp) {
                u16* db = (u16*)(p.ws + OFF_BKB) + ((size_t)(bb * 8 + hh) * NTOKP + tok) * 128 + d0;
                *(uint2*)db = make_uint2(pack2(o0[0], o0[1]), pack2(o0[2], o0[3]));
                *(uint2*)(db + 64) = make_uint2(pack2(o1[0], o1[1]), pack2(o1[2], o1[3]));
              }
            }
          } else if (G < 192) {
            const bool isa = G < 96;
            const int c = (isa ? (G - 64) : (G - 160)) * 32 + o;
            float* d = out + (isa ? (smp ? O_AVS : O_AVP) : (smp ? O_BVS : O_BVP)) + (size_t)orow * 1024 + c;
            *(float4*)d = make_float4(v0[0], v0[1], v0[2], v0[3]);
            *(float4*)(d + 16) = make_float4(v1[0], v1[1], v1[2], v1[3]);
            if (!smp) {
              u16* vt = (u16*)(p.ws + (isa ? OFF_AVT : OFF_BVT)) + ((size_t)(bb * 8 + (c >> 7)) * 128 + (c & 127)) * VTPAD + tok;
#pragma unroll
              for (int j = 0; j < 4; ++j) { vt[(size_t)j * VTPAD] = f2bf(v0[j]); vt[(size_t)(16 + j) * VTPAD] = f2bf(v1[j]); }
            }
          } else if (G == 210) {
            if (fq < 2) *(float4*)(IW + (size_t)row * 8 + o) = make_float4(v0[0] * IW_SCALE, v0[1] * IW_SCALE, v0[2] * IW_SCALE, v0[3] * IW_SCALE);
          } else {
            u16* d = Gt + (size_t)row * 2048 + (G - 211) * 32 + o;
            float s0[4], s1[4];
#pragma unroll
            for (int j = 0; j < 4; ++j) { s0[j] = 1.0f / (1.0f + __expf(-v0[j])); s1[j] = 1.0f / (1.0f + __expf(-v1[j])); }
            *(uint2*)d = make_uint2(pack2(s0[0], s0[1]), pack2(s0[2], s0[3]));
            *(uint2*)(d + 16) = make_uint2(pack2(s1[0], s1[1]), pack2(s1[2], s1[3]));
          }
        }
    }
  }
}

DI void phase_merge(const Params& p, char* smem, int vbid) {
  const u16* OA = (const u16*)(p.ws + OFF_OA); const u16* OB = (const u16*)(p.ws + OFF_OB);
  const u16* WA = (const u16*)(p.ws + OFF_WA); const u16* WB = (const u16*)(p.ws + OFF_WB);
  const u16* G = (const u16*)(p.ws + OFF_G);
  u16* MB = (u16*)(p.ws + OFF_MB);
  G_DECL
  const int nr = gemm_rounds(8);
  int it = 0, m0n = 0, n0n = 0;
  while (it < nr && !gemm_tile(vbid, it, 8, m0n, n0n)) ++it;
  if (it < nr) G_ISSUE(OA, 1024, WA, 1024, m0n, n0n, (const float*)nullptr)
  while (it < nr) {
    const int m0 = m0n, n0 = n0n;
    f32x16 acc[2][2], acc2[2][2]; zero_acc(acc); zero_acc(acc2);
    G_RUN(OA, 1024, WA, 1024, 1024, m0, n0, (u16*)smem, acc, true)
    G_ISSUE(OB, 1024, WB, 1024, m0, n0, (const float*)nullptr)
    G_RUN(OB, 1024, WB, 1024, 1024, m0, n0, (u16*)smem, acc2, true)
    ++it;
    while (it < nr && !gemm_tile(vbid, it, 8, m0n, n0n)) ++it;
    if (it < nr) G_ISSUE(OA, 1024, WA, 1024, m0n, n0n, (const float*)nullptr)
    const int t = tid_opaque(), lane = t & 63, w = t >> 6, wm = w >> 1, wn = w & 1, lr = lane & 31, lh = lane >> 5;
#pragma unroll
    for (int mi = 0; mi < 2; ++mi) {
      const int row = m0 + wm * 64 + mi * 32 + lr;
      if (row >= T) continue;
#pragma unroll
      for (int ni = 0; ni < 2; ++ni)
#pragma unroll
        for (int g = 0; g < 4; ++g) {
          const int col = n0 + wn * 64 + ni * 32 + 8 * g + 4 * lh;
          const uint2 ga = *(const uint2*)(G + (size_t)row * 2048 + col);
          const uint2 gb = *(const uint2*)(G + (size_t)row * 2048 + 1024 + col);
          const float m0v = __uint_as_float(ga.x << 16) * acc[mi][ni][4 * g] + __uint_as_float(gb.x << 16) * acc2[mi][ni][4 * g];
          const float m1v = __uint_as_float(ga.x & 0xffff0000u) * acc[mi][ni][4 * g + 1] + __uint_as_float(gb.x & 0xffff0000u) * acc2[mi][ni][4 * g + 1];
          const float m2v = __uint_as_float(ga.y << 16) * acc[mi][ni][4 * g + 2] + __uint_as_float(gb.y << 16) * acc2[mi][ni][4 * g + 2];
          const float m3v = __uint_as_float(ga.y & 0xffff0000u) * acc[mi][ni][4 * g + 3] + __uint_as_float(gb.y & 0xffff0000u) * acc2[mi][ni][4 * g + 3];
          *(uint2*)(MB + (size_t)row * 1024 + col) = make_uint2(pack2(m0v, m1v), pack2(m2v, m3v));
        }
    }
  }
}

template <int MODE>
DI void attn_item(const Params& p, char* smem, int grp, int b, int h, int q0, int nqv, float lam) {
  int t_ = threadIdx.x;
  asm volatile("" : "+v"(t_));
  const int t = t_, lane = t & 63, w = __builtin_amdgcn_readfirstlane(t >> 6), lr = lane & 31, lh = lane >> 5;
  u16* Ks = (u16*)smem;
  u16* Vt = Ks + 64 * 136;
  u16* Qs = Vt + 128 * 72;
  constexpr int NQB = MODE == 0 ? 128 : 256;
  constexpr int KS = MODE == 0 ? 4 : 8;
  const int NK = grp ? NKS : NTOKP;
  const int qsub = MODE == 0 ? (w >> 1) : w;
  const int map = MODE == 0 ? (w & 1) : 0;
  const int qw0 = q0 + qsub * 32;
  const bool wact = (qsub * 32) < nqv;
  int Lw = 0;
  if (wact) Lw = grp ? NKS : (qw0 < 16 ? 16 : 16 + 64 * (((qw0 - 16) >> 6) + 1));
  const int tql = q0 + nqv - 1;
  const int Lblk = grp ? NKS : (tql < 16 ? 16 : 16 + 64 * (((tql - 16) >> 6) + 1));
  const int nkt = (Lblk + 63) >> 6;
  const int ql = qsub * 32 + lr;
  const int tq = q0 + (ql < nqv ? ql : nqv - 1);
  const size_t gr = grp ? (size_t)TP + b * 32 + tq : (size_t)b * NTOKP + tq;
  __syncthreads();
  bf16x8 qf[KS];
  {
    const u16* Qg = (const u16*)(p.ws + (MODE == 0 ? OFF_AQ : OFF_BQ)) + gr * 1024 + h * 128 + map * 64 + lh * 8;
#pragma unroll
    for (int ks = 0; ks < KS; ++ks) qf[ks] = *(const bf16x8*)(Qg + ks * 16);
  }
  const u64* mrow = nullptr;
  if (MODE == 1) mrow = grp ? (const u64*)(p.ws + OFF_MASKS) + ((size_t)b * 32 + tq) * NWS : (const u64*)(p.ws + OFF_MASKP) + gr * NWP;
  f32x16 O[4];
  float mrun = -1e30f, lrun = 0.f;
#pragma unroll
  for (int db = 0; db < 4; ++db)
#pragma unroll
    for (int i = 0; i < 16; ++i) O[db][i] = 0.f;
  const int kwhich = MODE == 0 ? 0 : 2;
  const u16* Kg = (const u16*)(p.ws + (MODE == 0 ? OFF_AKB : OFF_BKB)) + (size_t)(b * 8 + h) * NTOKP * 128 + (t & 15) * 8;
  const u16* Vg = (const u16*)(p.ws + (MODE == 0 ? OFF_AVT : OFF_BVT)) + ((size_t)(b * 8 + h) * 128 + (t >> 3)) * VTPAD + (t & 7) * 8;
  const int kkey = t >> 4;
  uint4 sa0, sa1, sa2, sa3, sb0, sb1, sb2, sb3, sc0, sc1, sc2, sc3;
  u64 ma = 0, mb = 0, mc = 0;
  sa0 = sa1 = sa2 = sa3 = sb0 = sb1 = sb2 = sb3 = sc0 = sc1 = sc2 = sc3 = make_uint4(0, 0, 0, 0);
  auto issue = [&](int kt, uint4& r0, uint4& r1, uint4& r2, uint4& r3, u64& mwr) {
    if (!grp && kt < nkt) {
      int k0 = kt * 64 + kkey, k1 = k0 + 32;
      k0 = k0 < NTOKP ? k0 : NTOKP - 1; k1 = k1 < NTOKP ? k1 : NTOKP - 1;
      r0 = *(const uint4*)(Kg + (size_t)k0 * 128); r1 = *(const uint4*)(Kg + (size_t)k1 * 128);
      const u16* vp = Vg + kt * 64;
      r2 = *(const uint4*)(vp); r3 = *(const uint4*)(vp + (size_t)64 * VTPAD);
    }
    if (MODE == 1 && kt < nkt) mwr = mrow[kt];
  };
  constexpr int ATT_BUF = 64 * 136 + 128 * 72;
  auto fill = [&](int kt, uint4& r0, uint4& r1, uint4& r2, uint4& r3) {
    u16* Ks = (u16*)smem + (kt & 1) * ATT_BUF; u16* Vt = Ks + 64 * 136;
    if (!grp) {
      *(uint4*)(Ks + kkey * 136 + (t & 15) * 8) = r0; *(uint4*)(Ks + (kkey + 32) * 136 + (t & 15) * 8) = r1;
      *(uint4*)(Vt + (t >> 3) * 72 + (t & 7) * 8) = r2; *(uint4*)(Vt + ((t >> 3) + 64) * 72 + (t & 7) * 8) = r3;
    } else {
#pragma unroll
      for (int i = 0; i < 4; ++i) {
        const int c = t + NTHR * i; const int key = c >> 5, d4 = c & 31;
        int tk = kt * 64 + key; tk = tk < NK ? tk : NK - 1;
        const float4 v = *(const float4*)(kv_row(p, grp, b, tk, kwhich) + h * 128 + d4 * 4);
        *(uint2*)(Ks + key * 136 + d4 * 4) = make_uint2(pack2(v.x, v.y), pack2(v.z, v.w));
      }
      {
        const int kq = t >> 5, d4 = t & 31;
        float4 x[4];
#pragma unroll
        for (int j = 0; j < 4; ++j) {
          int tk = kt * 64 + kq * 4 + j; tk = tk < NK ? tk : NK - 1;
          x[j] = *(const float4*)(kv_row(p, grp, b, tk, kwhich + 1) + h * 128 + d4 * 4);
        }
        u16* vd = Vt + (d4 * 4) * 72 + kq * 4;
        *(uint2*)(vd) = make_uint2(pack2(x[0].x, x[1].x), pack2(x[2].x, x[3].x));
        *(uint2*)(vd + 72) = make_uint2(pack2(x[0].y, x[1].y), pack2(x[2].y, x[3].y));
        *(uint2*)(vd + 144) = make_uint2(pack2(x[0].z, x[1].z), pack2(x[2].z, x[3].z));
        *(uint2*)(vd + 216) = make_uint2(pack2(x[0].w, x[1].w), pack2(x[2].w, x[3].w));
      }
    }
  };
  auto step = [&](int kt, uint4& r0, uint4& r1, uint4& r2, uint4& r3, u64& mwr, uint4& n0, uint4& n1, uint4& n2, uint4& n3) {
    const u64 mw = mwr;
    u16* Ks = (u16*)smem + (kt & 1) * ATT_BUF; u16* Vt = Ks + 64 * 136;
    if (kt + 1 < nkt) fill(kt + 1, n0, n1, n2, n3);
    issue(kt + 3, r0, r1, r2, r3, mwr);
    if (wact && kt * 64 < Lw) {
      f32x16 st0, st1;
#pragma unroll
      for (int i = 0; i < 16; ++i) { st0[i] = 0.f; st1[i] = 0.f; }
#pragma unroll
      for (int ks = 0; ks < KS; ++ks) {
        const bf16x8 k0 = *(const bf16x8*)(Ks + lr * 136 + map * 64 + ks * 16 + lh * 8);
        const bf16x8 k1 = *(const bf16x8*)(Ks + (32 + lr) * 136 + map * 64 + ks * 16 + lh * 8);
        st0 = MFMA(k0, qf[ks], st0);
        st1 = MFMA(k1, qf[ks], st1);
      }
      if (MODE == 0) {
        if (kt * 64 + 64 > Lw) {
#pragma unroll
          for (int i = 0; i < 16; ++i) {
            const int key = kt * 64 + crow(i, lh);
            if (key >= Lw) st0[i] = -INFINITY;
            if (key + 32 >= Lw) st1[i] = -INFINITY;
          }
        }
      } else {
        const unsigned lo = (unsigned)mw >> (4 * lh), hi = (unsigned)(mw >> 32) >> (4 * lh);
#pragma unroll
        for (int i = 0; i < 16; ++i) {
          const int bit = (i & 3) + 8 * (i >> 2);
          if (!((lo >> bit) & 1u)) st0[i] = -INFINITY;
          if (!((hi >> bit) & 1u)) st1[i] = -INFINITY;
        }
      }
      float tm0 = __builtin_fmaxf(__builtin_fmaxf(st0[0], st0[1]), st0[2]), tm1 = __builtin_fmaxf(__builtin_fmaxf(st0[8], st0[9]), st0[10]);
      float tm2 = __builtin_fmaxf(__builtin_fmaxf(st1[0], st1[1]), st1[2]), tm3 = __builtin_fmaxf(__builtin_fmaxf(st1[8], st1[9]), st1[10]);
      tm0 = __builtin_fmaxf(__builtin_fmaxf(tm0, st0[3]), st0[4]); tm1 = __builtin_fmaxf(__builtin_fmaxf(tm1, st0[11]), st0[12]);
      tm2 = __builtin_fmaxf(__builtin_fmaxf(tm2, st1[3]), st1[4]); tm3 = __builtin_fmaxf(__builtin_fmaxf(tm3, st1[11]), st1[12]);
      tm0 = __builtin_fmaxf(__builtin_fmaxf(tm0, st0[5]), st0[6]); tm1 = __builtin_fmaxf(__builtin_fmaxf(tm1, st0[13]), st0[14]);
      tm2 = __builtin_fmaxf(__builtin_fmaxf(tm2, st1[5]), st1[6]); tm3 = __builtin_fmaxf(__builtin_fmaxf(tm3, st1[13]), st1[14]);
      tm0 = __builtin_fmaxf(__builtin_fmaxf(tm0, st0[7]), st0[15]); tm2 = __builtin_fmaxf(__builtin_fmaxf(tm2, st1[7]), st1[15]);
      float tmax = __builtin_fmaxf(__builtin_fmaxf(tm0, tm1), __builtin_fmaxf(tm2, tm3));
      tmax = fmaxf(tmax, shx(tmax, 32));
      const float mnew = fmaxf(mrun, tmax);
      const float alpha = fexp2(mrun - mnew);
      mrun = mnew;
      float ps = 0.f;
#pragma unroll
      for (int i = 0; i < 16; ++i) {
        st0[i] = fexp2(st0[i] - mnew); st1[i] = fexp2(st1[i] - mnew);
        ps += st0[i] + st1[i];
      }
      lrun = lrun * alpha + ps;
      if (__any(alpha != 1.0f)) {
#pragma unroll
        for (int db = 0; db < 4; ++db)
#pragma unroll
          for (int i = 0; i < 16; ++i) O[db][i] *= alpha;
      }
      bf16x8 pf[4];
#pragma unroll
      for (int c = 0; c < 4; ++c) {
        const unsigned u0 = (c < 2) ? pack2(st0[(c & 1) * 8 + 0], st0[(c & 1) * 8 + 1]) : pack2(st1[(c & 1) * 8 + 0], st1[(c & 1) * 8 + 1]);
        const unsigned u1 = (c < 2) ? pack2(st0[(c & 1) * 8 + 2], st0[(c & 1) * 8 + 3]) : pack2(st1[(c & 1) * 8 + 2], st1[(c & 1) * 8 + 3]);
        const unsigned u2 = (c < 2) ? pack2(st0[(c & 1) * 8 + 4], st0[(c & 1) * 8 + 5]) : pack2(st1[(c & 1) * 8 + 4], st1[(c & 1) * 8 + 5]);
        const unsigned u3 = (c < 2) ? pack2(st0[(c & 1) * 8 + 6], st0[(c & 1) * 8 + 7]) : pack2(st1[(c & 1) * 8 + 6], st1[(c & 1) * 8 + 7]);
        pf[c] = __builtin_bit_cast(bf16x8, make_uint4(u0, u1, u2, u3));
      }
#pragma unroll
      for (int db = 0; db < 4; ++db)
#pragma unroll
        for (int c = 0; c < 4; ++c) {
          const int kk = (c >> 1) * 32 + (c & 1) * 16 + 4 * lh;
          const bf16x4 v0 = *(const bf16x4*)(Vt + (db * 32 + lr) * 72 + kk);
          const bf16x4 v1 = *(const bf16x4*)(Vt + (db * 32 + lr) * 72 + kk + 8);
          const bf16x8 vf = __builtin_shufflevector(v0, v1, 0, 1, 2, 3, 4, 5, 6, 7);
          O[db] = MFMA(vf, pf[c], O[db]);
        }
    }
    __syncthreads();
  };
  issue(0, sa0, sa1, sa2, sa3, ma);
  issue(1, sb0, sb1, sb2, sb3, mb);
  issue(2, sc0, sc1, sc2, sc3, mc);
  fill(0, sa0, sa1, sa2, sa3);
  __syncthreads();
  for (int kt = 0; kt < nkt; kt += 3) {
    step(kt, sa0, sa1, sa2, sa3, ma, sb0, sb1, sb2, sb3);
    if (kt + 1 < nkt) step(kt + 1, sb0, sb1, sb2, sb3, mb, sc0, sc1, sc2, sc3);
    if (kt + 2 < nkt) step(kt + 2, sc0, sc1, sc2, sc3, mc, sa0, sa1, sa2, sa3);
  }
  const float ltot = lrun + shx(lrun, 32);
  const float inv = 1.0f / ltot;
  const bool qok = ql < nqv;
  if (MODE == 0) {
    float* Ex = (float*)smem;
    __syncthreads();
    if (map == 1) {
      const float sc = inv * lam;
#pragma unroll
      for (int db = 0; db < 4; ++db)
#pragma unroll
        for (int i = 0; i < 16; ++i) Ex[(qsub * 128 + db * 32 + crow(i, lh)) * 33 + lr] = O[db][i] * sc;
    }
    __syncthreads();
    if (map == 0) {
      float ss = 0.f;
#pragma unroll
      for (int db = 0; db < 4; ++db)
#pragma unroll
        for (int i = 0; i < 16; ++i) {
          const float v = O[db][i] * inv - Ex[(qsub * 128 + db * 32 + crow(i, lh)) * 33 + lr];
          O[db][i] = v; ss += v * v;
        }
      ss += shx(ss, 32);
      const float rn = rsqrtf(ss * (1.0f / 128.0f) + EPS) * 0.8f;
      const float* sub = p.in[18];
      u16* dst = (u16*)(p.ws + OFF_OA) + gr * 1024 + h * 128;
      if (wact && qok) {
#pragma unroll
        for (int db = 0; db < 4; ++db)
#pragma unroll
          for (int g = 0; g < 4; ++g) {
            const int d = db * 32 + 8 * g + 4 * lh;
            const float4 sg = *(const float4*)(sub + d);
            *(uint2*)(dst + d) = make_uint2(pack2(O[db][4 * g] * rn * sg.x, O[db][4 * g + 1] * rn * sg.y),
                                            pack2(O[db][4 * g + 2] * rn * sg.z, O[db][4 * g + 3] * rn * sg.w));
          }
      }
    }
  } else {
    u16* dst = (u16*)(p.ws + OFF_OB) + gr * 1024 + h * 128;
    if (wact && qok) {
#pragma unroll
      for (int db = 0; db < 4; ++db)
#pragma unroll
        for (int g = 0; g < 4; ++g) {
          const int d = db * 32 + 8 * g + 4 * lh;
          *(uint2*)(dst + d) = make_uint2(pack2(O[db][4 * g] * inv, O[db][4 * g + 1] * inv),
                                          pack2(O[db][4 * g + 2] * inv, O[db][4 * g + 3] * inv));
        }
    }
  }
}

DI unsigned ford(float f) { unsigned u = __float_as_uint(f); return u ^ ((u >> 31) ? 0xFFFFFFFFu : 0x80000000u); }

DI void idx_item(const Params& p, char* smem, int grp, int b, int pidx) {
  int t_ = threadIdx.x;
  asm volatile("" : "+v"(t_));
  const int t = t_, lane = t & 63, w = __builtin_amdgcn_readfirstlane(t >> 6), lr = lane & 31, lh = lane >> 5;
  u16* IQs = (u16*)smem;
  u16* IKs = IQs + 128 * 520;
  float* IWs = (float*)(smem + 133120 + 9216);
  float* SCb = (float*)(p.ws + OFF_SC);
  const int half = w >> 2;
  int q0h[2], nqh[2], Lh[2];
  if (!grp) {
    if (pidx == 0) { q0h[0] = 0; nqh[0] = 16; Lh[0] = 16; q0h[1] = 0; nqh[1] = 0; Lh[1] = 0; }
    else {
      const int c0 = 2 * (pidx - 1);
      q0h[0] = 16 + 64 * c0; nqh[0] = 64; Lh[0] = 80 + 64 * c0;
      q0h[1] = 80 + 64 * c0; nqh[1] = 64; Lh[1] = 144 + 64 * c0;
    }
  } else { q0h[0] = 0; nqh[0] = 32; Lh[0] = NKS; q0h[1] = 0; nqh[1] = 0; Lh[1] = 0; }
  const int NK = grp ? NKS : NTOKP;
  const int q0 = half ? q0h[1] : q0h[0], nqv = half ? nqh[1] : nqh[0], L = half ? Lh[1] : Lh[0];
  int Lpad; float* SC;
  if (!grp) {
    if (pidx == 0) { Lpad = 64; SC = SCb + SC_META + (size_t)b * 4096; }
    else { const int c = 2 * (pidx - 1) + half; Lpad = 64 * (c + 2); SC = SCb + (size_t)b * SC_BSTRIDE + 4096ull * (size_t)(c * (c + 3) / 2); }
  } else { Lpad = 2112; SC = SCb + SC_SAMP + (size_t)b * 64 * 2112; }
  const int nkt = (L + 63) >> 6;
  const int Lmax = Lh[1] > Lh[0] ? Lh[1] : Lh[0];
  const int nkt_blk = (Lmax + 63) >> 6;
  const u16* IQg = (const u16*)(p.ws + OFF_IQ);
  const float* IWg = (const float*)(p.ws + OFF_IW);
  __syncthreads();
#pragma unroll 4
  for (int i = 0; i < 16; ++i) {
    const int c = t + NTHR * i; const int q = c >> 6, ch = c & 63;
    const int hh = q >> 6, qq = q & 63;
    const int hq0 = hh ? q0h[1] : q0h[0], hn = hh ? nqh[1] : nqh[0];
    const int tq = hn > 0 ? hq0 + (qq < hn ? qq : hn - 1) : q0h[0];
    const size_t gr = grp ? (size_t)TP + b * 32 + tq : (size_t)b * NTOKP + tq;
    *(uint4*)(IQs + q * 520 + ch * 8) = *(const uint4*)(IQg + gr * 512 + ch * 8);
  }
#pragma unroll
  for (int i = 0; i < 2; ++i) {
    const int e = t + NTHR * i; const int q = e >> 3, hd = e & 7;
    const int hh = q >> 6, qq = q & 63;
    const int hq0 = hh ? q0h[1] : q0h[0], hn = hh ? nqh[1] : nqh[0];
    const int tq = hn > 0 ? hq0 + (qq < hn ? qq : hn - 1) : q0h[0];
    const size_t gr = grp ? (size_t)TP + b * 32 + tq : (size_t)b * NTOKP + tq;
    IWs[e] = IWg[gr * 8 + hd];
  }
  const int wq = w >> 1, wk = w & 1;
  const u16* IKg = (const u16*)(p.ws + OFF_IKB) + (size_t)b * NTOKP * 64 + (t & 7) * 8;
  const int ikey = t >> 3;
  uint4 ri0 = make_uint4(0, 0, 0, 0);
  if (!grp) {
    int k0 = ikey; k0 = k0 < NTOKP ? k0 : NTOKP - 1;
    ri0 = *(const uint4*)(IKg + (size_t)k0 * 64);
  }
  for (int kt = 0; kt < nkt_blk; ++kt) {
    __syncthreads();
    if (!grp) {
      *(uint4*)(IKs + ikey * 72 + (t & 7) * 8) = ri0;
    } else {
#pragma unroll
      for (int i = 0; i < 2; ++i) {
        const int c = t + NTHR * i; const int key = c >> 4, d4 = c & 15;
        int tk = kt * 64 + key; tk = tk < NK ? tk : NK - 1;
        const float4 v = *(const float4*)(ik_row(p, grp, b, tk) + d4 * 4);
        *(uint2*)(IKs + key * 72 + d4 * 4) = make_uint2(pack2(v.x, v.y), pack2(v.z, v.w));
      }
    }
    __syncthreads();
    if (!grp && kt + 1 < nkt_blk) {
      int k0 = (kt + 1) * 64 + ikey; k0 = k0 < NTOKP ? k0 : NTOKP - 1;
      ri0 = *(const uint4*)(IKg + (size_t)k0 * 64);
    }
    if (kt < nkt) {
      bf16x8 kf[4];
#pragma unroll
      for (int ks = 0; ks < 4; ++ks) kf[ks] = *(const bf16x8*)(IKs + (wk * 32 + lr) * 72 + ks * 16 + lh * 8);
      float sc[16];
#pragma unroll
      for (int i = 0; i < 16; ++i) sc[i] = 0.f;
#pragma unroll
      for (int hd = 0; hd < 8; ++hd) {
        f32x16 st;
#pragma unroll
        for (int i = 0; i < 16; ++i) st[i] = 0.f;
#pragma unroll
        for (int ks = 0; ks < 4; ++ks) {
          const bf16x8 qfr = *(const bf16x8*)(IQs + (wq * 32 + lr) * 520 + hd * 64 + ks * 16 + lh * 8);
          st = MFMA(kf[ks], qfr, st);
        }
        const float wv = IWs[(wq * 32 + lr) * 8 + hd];
#pragma unroll
        for (int i = 0; i < 16; ++i) sc[i] += wv * fmaxf(st[i], 0.f);
      }
      float* srow = SC + (size_t)((wq & 1) * 32 + lr) * Lpad + kt * 64 + wk * 32 + 4 * lh;
#pragma unroll
      for (int g = 0; g < 4; ++g) *(float4*)(srow + 8 * g) = make_float4(sc[4 * g], sc[4 * g + 1], sc[4 * g + 2], sc[4 * g + 3]);
    }
  }
  __threadfence();
  __syncthreads();
  for (int j = 0; j < 16; ++j) {
    const int q = (w & 3) * 16 + j;
    if (q >= nqv) break;
    const int tq = q0 + q;
    u64* mrow = grp ? (u64*)(p.ws + OFF_MASKS) + ((size_t)b * 32 + tq) * NWS : (u64*)(p.ws + OFF_MASKP) + ((size_t)b * NTOKP + tq) * NWP;
    if (L <= 256) {
      for (int i = 0; i < nkt; ++i) {
        const u64 wd = __ballot(i * 64 + lane < L);
        if (lane == 0) mrow[i] = wd;
      }
      continue;
    }
    const unsigned* srow = (const unsigned*)(SC + (size_t)q * Lpad);
    int Lr = L;
    asm volatile("" : "+v"(Lr));
    int nkr = __builtin_amdgcn_readfirstlane(nkt);
    asm volatile("" : "+s"(nkr));
    int lanev = lane;
    asm volatile("" : "+v"(lanev));
    unsigned v[129];
#pragma unroll
    for (int g = 0; g < 17; ++g) {
      if (g * 8 < nkt) {
#pragma unroll
        for (int jj = 0; jj < 8; ++jj) {
          const int i = g * 8 + jj; if (i >= 129) continue;
          v[i] = __hip_atomic_load(srow + i * 64 + lanev, __ATOMIC_RELAXED, __HIP_MEMORY_SCOPE_AGENT);
        }
      } else {
#pragma unroll
        for (int jj = 0; jj < 8; ++jj) if (g * 8 + jj < 129) v[g * 8 + jj] = 0u;
      }
    }
#pragma unroll
    for (int g = 0; g < 17; ++g) {
      if (g * 8 < nkt) {
#pragma unroll
        for (int jj = 0; jj < 8; ++jj) {
          const int i = g * 8 + jj; if (i >= 129) continue; const int key = i * 64 + lanev;
          const unsigned u = ford(__uint_as_float(v[i]));
          v[i] = key < Lr ? u : 0u;
        }
        __builtin_amdgcn_sched_barrier(0);
      }
    }
    unsigned Tt = 0u;
    for (int bit = 31; bit >= 0; --bit) {
      const unsigned cand = Tt | (1u << bit);
      int cnt = 0;
#pragma unroll
      for (int g = 0; g < 17; ++g) {
        if (g * 8 < nkt) {
#pragma unroll
          for (int jj = 0; jj < 8; ++jj) if (g * 8 + jj < 129) cnt += (v[g * 8 + jj] >= cand) ? 1 : 0;
          __builtin_amdgcn_sched_barrier(0);
        }
      }
#pragma unroll
      for (int m = 32; m >= 1; m >>= 1) cnt += __shfl_xor(cnt, m, 64);
      if (cnt >= 256) Tt = cand;
    }
    int cgt = 0;
#pragma unroll
    for (int g = 0; g < 17; ++g) {
      if (g * 8 < nkt) {
#pragma unroll
        for (int jj = 0; jj < 8; ++jj) if (g * 8 + jj < 129) cgt += (v[g * 8 + jj] > Tt) ? 1 : 0;
        __builtin_amdgcn_sched_barrier(0);
      }
    }
#pragma unroll
    for (int m = 32; m >= 1; m >>= 1) cgt += __shfl_xor(cgt, m, 64);
    const int need = 256 - cgt;
    int run = 0;
    const u64 lmask = (1ull << lane) - 1ull;
#pragma unroll
    for (int g = 0; g < 17; ++g) {
      if (g * 8 < nkt) {
#pragma unroll
        for (int jj = 0; jj < 8; ++jj) {
          const int i = g * 8 + jj; if (i >= 129) continue;
          const bool eq = v[i] == Tt;
          const u64 em = __ballot(eq);
          const int pre = run + __popcll(em & lmask);
          const bool sel = (v[i] > Tt) || (eq && pre < need);
          run += __popcll(em);
          const u64 wd = __ballot(sel);
          if (i < nkr) { if (lane == 0) mrow[i] = wd; }
          __builtin_amdgcn_sched_barrier(0);
        }
      }
    }
  }
}

DI unsigned xcc_id() { return (unsigned)__builtin_amdgcn_s_getreg((3 << 11) | 20) & 7u; }

DI int next_item(unsigned* cnt, int* s_item, int qlen, int& q, int& tries) {
  __syncthreads();
  if (threadIdx.x == 0) {
    int r = -1;
    while (tries < 8) {
      const int j = (int)atomicAdd(cnt + q, 1u);
      if (j < qlen) { r = (q << 16) | j; break; }
      q = (q + 1) & 7; ++tries;
    }
    s_item[0] = r; s_item[1] = q; s_item[2] = tries;
  }
  __syncthreads();
  q = __builtin_amdgcn_readfirstlane(s_item[1]);
  tries = __builtin_amdgcn_readfirstlane(s_item[2]);
  return __builtin_amdgcn_readfirstlane(s_item[0]);
}

DI void phase_attn_a(const Params& p, char* smem, int cbase = 0) {
  unsigned* cnt = (unsigned*)(p.ws + OFF_CNT) + cbase;
  int* s_item = (int*)(smem + SMEM_ITEM);
  float lam;
  {
    const int lane = threadIdx.x & 63;
    float a = p.in[14][lane] * p.in[15][lane], c = p.in[16][lane] * p.in[17][lane];
#pragma unroll
    for (int m = 32; m >= 1; m >>= 1) { a += shx(a, m); c += shx(c, m); }
    lam = expf(a) - expf(c) + 0.2f;
  }
  int q = (int)xcc_id(), tries = 0;
  while (true) {
    const int it = next_item(cnt, s_item, 165, q, tries);
    if (it < 0) break;
    const int x = it >> 16, j = it & 0xffff;
#ifndef NO_IDX
    if (j < 17) {
      const int k = j * 8 + x;
      if (k < 130) idx_item(p, smem, 0, k & 1, 64 - (k >> 1));
    } else if (j < 19) {
      idx_item(p, smem, 1, 2 * x + (j - 17), 0);
    } else
#else
    if (j < 19) {} else
#endif
    if (j < 35) {
      const int jj = j - 19;
      attn_item<0>(p, smem, 1, 2 * x + (jj >> 3), jj & 7, 0, 32, lam);
    } else {
      const int jj = j - 35; const int bh = 2 * x + jj / 65, qt = 64 - jj % 65;
      attn_item<0>(p, smem, 0, bh >> 3, bh & 7, qt == 0 ? 0 : 16 + (qt - 1) * 128, qt == 0 ? 16 : 128, lam);
    }
  }
}

DI void phase_attn_b(const Params& p, char* smem, int cbase = 8) {
  unsigned* cnt = (unsigned*)(p.ws + OFF_CNT) + cbase;
  int* s_item = (int*)(smem + SMEM_ITEM);
  int q = (int)xcc_id(), tries = 0;
  while (true) {
    const int it = next_item(cnt, s_item, 82, q, tries);
    if (it < 0) break;
    const int x = it >> 16, j = it & 0xffff;
    if (j < 16) {
      attn_item<1>(p, smem, 1, 2 * x + (j >> 3), j & 7, 0, 32, 0.f);
    } else {
      const int jj = j - 16; const int bh = 2 * x + jj / 33, qt = 32 - jj % 33;
      attn_item<1>(p, smem, 0, bh >> 3, bh & 7, qt == 0 ? 0 : 16 + (qt - 1) * 256, qt == 0 ? 16 : 256, 0.f);
    }
  }
}

DI void phase_final(const Params& p) {
  const int t = tid_opaque(), lane = t & 63;
  const int wv = blockIdx.x * 8 + (t >> 6), nw = gridDim.x * 8;
  const float* xf = (const float*)(p.ws + OFF_XF);
  const float* ssp = (const float*)(p.ws + OFF_SSP3);
  const float4* gf = (const float4*)p.in[26];
  for (int row = wv; row < T; row += nw) {
    float* dst;
    if (row < TP) {
      const int b = row >= NTOKP ? 1 : 0; const int tok = row - b * NTOKP;
      if (tok < 16) continue;
      dst = p.out + O_YP + ((size_t)b * 8192 + (tok - 16)) * 1024;
    } else dst = p.out + O_YS + (size_t)(row - TP) * 1024;
    float s = 0.f;
#pragma unroll
    for (int i = 0; i < 16; ++i) s += ssp[(size_t)row * 16 + i];
    const float r = rsqrtf(s * (1.0f / 1024.0f) + EPS);
#pragma unroll
    for (int i = 0; i < 4; ++i) {
      const float4 v = ((const float4*)(xf + (size_t)row * 1024))[lane + 64 * i];
      const float4 g = gf[lane + 64 * i];
      ((float4*)dst)[lane + 64 * i] = make_float4(v.x * r * g.x, v.y * r * g.y, v.z * r * g.z, v.w * r * g.w);
    }
  }
}

#ifndef PHM
#define PHM 0x7ff
#endif
#define PHON(n) ((PHM >> n) & 1)
__global__ void __launch_bounds__(512, 2) mega(Params p) {
  extern __shared__ __attribute__((aligned(16))) char smem[];
  cg::grid_group grid = cg::this_grid();
  volatile LAS unsigned* xst = (volatile LAS unsigned*)(smem + SMEM_ITEM + 48);
  if (threadIdx.x == 0) { xst[0] = 0u; xst[1] = 0u; }
  __syncthreads();
  (void)xcd_barrier_post((unsigned*)(p.ws + OFF_XBAR), xst);
  int* sv = (int*)(smem + SMEM_ITEM) + 8;
  if (threadIdx.x == 0) {
    const unsigned x = xcc_id();
    sv[0] = (int)x;
    sv[1] = (int)atomicAdd((unsigned*)(p.ws + OFF_CNT) + 48 + x, 1u);
  }
  if (PHON(0)) phase_prep(p, smem);
  grid.sync();
  int vbid;
  {
    if (threadIdx.x == 0) {
      const int x = sv[0], r = sv[1];
      int v = -1;
      if (gridDim.x == 256) {
        unsigned cntx[8];
#pragma unroll
        for (int i = 0; i < 8; ++i) cntx[i] = __hip_atomic_load((unsigned*)(p.ws + OFF_CNT) + 48 + i, __ATOMIC_RELAXED, __HIP_MEMORY_SCOPE_AGENT);
        if (r < 32) v = r * 8 + x;
        else {
          int k = r - 32;
#pragma unroll
          for (int i = 0; i < 8; ++i) if (i < x && cntx[i] > 32u) k += (int)cntx[i] - 32;
#pragma unroll
          for (int i = 0; i < 8; ++i) {
            const int freei = cntx[i] < 32u ? 32 - (int)cntx[i] : 0;
            if (v < 0) { if (k < freei) v = ((int)cntx[i] + k) * 8 + i; else k -= freei; }
          }
        }
      }
      sv[2] = v;
    }
    __syncthreads();
    vbid = __builtin_amdgcn_readfirstlane(sv[2]);
    if (vbid < 0) vbid = blockIdx.x;
  }
  if (PHON(1)) phase_gateup(p, smem, OFF_SSP0, OFF_WGU1, vbid);
  gbar(p, smem);
#ifdef DUP_GEMM
  phase_gateup(p, smem, OFF_SSP0, OFF_WGU1, vbid);
  gbar(p, smem);
#endif
  if (PHON(2)) phase_resid8<1>(p, smem, (const u16*)(p.ws + OFF_HID), 2816, OFF_WD1, 0.5f, OFF_SSP1, vbid);
  gbar(p, smem);
#ifdef DUP_G2
  phase_resid<1>(p, smem, (const u16*)(p.ws + OFF_HID), 2816, 2816, OFF_WD1, 0.5f, OFF_SSP1, vbid);
  gbar(p, smem);
#endif
  if (PHON(3)) phase_win8(p, smem, vbid);
  gbar(p, smem);
#ifdef DUP_GEMM
  phase_win8(p, smem, vbid);
  gbar(p, smem);
#endif
  if (PHON(4)) phase_attn_a(p, smem);
  gbar(p, smem);
#ifdef DUP_P4
  phase_attn_a(p, smem, 16);
  gbar(p, smem);
#endif
  if (PHON(5)) phase_attn_b(p, smem);
  gbar(p, smem);
#ifdef DUP_P5
  phase_attn_b(p, smem, 24);
  gbar(p, smem);
#endif
  if (PHON(6)) phase_merge8(p, smem, vbid);
  gbar(p, smem);
#ifdef DUP_G2
  phase_merge(p, smem, vbid);
  gbar(p, smem);
#endif
  if (PHON(7)) phase_resid8<0>(p, smem, (const u16*)(p.ws + OFF_MB), 1024, OFF_WO, 1.0f, OFF_SSP2, vbid);
  gbar(p, smem);
  if (PHON(8)) phase_gateup(p, smem, OFF_SSP2, OFF_WGU2, vbid);
  gbar(p, smem);
  if (PHON(9)) phase_resid8<0>(p, smem, (const u16*)(p.ws + OFF_HID), 2816, OFF_WD2, 0.5f, OFF_SSP3, vbid);
  gbar(p, smem);
  if (PHON(10)) phase_final(p);
}

extern "C" void kernel_launch(void* const* d_in, const int* in_sizes, int n_in, void* d_out, int out_size, void* d_ws,
                              size_t ws_size, hipStream_t stream) {
  Params p{};
  for (int i = 0; i < 27; ++i) p.in[i] = (const float*)d_in[i];
  p.out = (float*)d_out;
  p.ws = (char*)d_ws;
  static int grid_blocks = 0;
  if (!grid_blocks) {
    hipFuncSetAttribute((const void*)mega, hipFuncAttributeMaxDynamicSharedMemorySize, SMEM_BYTES);
    int dev = 0, cus = 0, per_cu = 0;
    hipGetDevice(&dev);
    hipDeviceGetAttribute(&cus, hipDeviceAttributeMultiprocessorCount, dev);
    hipOccupancyMaxActiveBlocksPerMultiprocessor(&per_cu, mega, NTHR, SMEM_BYTES);
    if (per_cu > 1) per_cu = 1;
    if (per_cu < 1) per_cu = 1;
    grid_blocks = cus * per_cu;
  }
  if (ws_size < WS_END) fprintf(stderr, "workspace too small: %zu < %zu\n", ws_size, (size_t)WS_END);
  (void)hipMemsetAsync((char*)d_ws + OFF_CNT, 0, 256 + SZ_XBAR, stream);
  void* args[] = {&p};
  hipError_t e = hipLaunchCooperativeKernel((void*)mega, dim3(grid_blocks), dim3(NTHR), args, SMEM_BYTES, stream);
  if (e != hipSuccess) fprintf(stderr, "cooperative launch failed: %s (grid %d)\n", hipGetErrorString(e), grid_blocks);
}
```

```cpp
#include <hip/hip_runtime.h>
#include <hip/hip_cooperative_groups.h>
#include <stdint.h>
#include <cstdio>
namespace cg = cooperative_groups;

typedef __attribute__((ext_vector_type(8))) short bf16x8;
typedef __attribute__((ext_vector_type(4))) short bf16x4;
typedef __attribute__((ext_vector_type(16))) float f32x16;
typedef unsigned short u16;
typedef unsigned long long u64;
#define MFMA(a, b, c) __builtin_amdgcn_mfma_f32_32x32x16_bf16((a), (b), (c), 0, 0, 0)
#define DI __device__ __forceinline__

constexpr int NTOKP = 8208;
constexpr int TP = 2 * NTOKP;
constexpr int TS = 512;
constexpr int T = TP + TS;
constexpr int TPAD = 17152;
constexpr int NT_M = 67;
constexpr int NTHR = 512;
constexpr int NCACHE = 2064;
constexpr int NKS = 2096;
constexpr int NWP = 129;
constexpr int NWS = 33;
constexpr float EPS = 1e-6f;
constexpr float LOG2E = 1.4426950408889634f;
constexpr float QA_SCALE = 0.125f * LOG2E;
constexpr float QB_SCALE = 0.08838834764831845f * LOG2E;
constexpr float IW_SCALE = 0.125f * 0.35355339059327373f;

constexpr size_t O_YP = 0;
constexpr size_t O_YS = O_YP + 2ull * 8192 * 1024;
constexpr size_t O_AKP = O_YS + 512ull * 1024;
constexpr size_t SZ_NEWP = (size_t)TP * 1024;
constexpr size_t O_AVP = O_AKP + SZ_NEWP;
constexpr size_t O_BKP = O_AVP + SZ_NEWP;
constexpr size_t O_BVP = O_BKP + SZ_NEWP;
constexpr size_t O_IKP = O_BVP + SZ_NEWP;
constexpr size_t O_AKS = O_IKP + (size_t)TP * 64;
constexpr size_t SZ_NEWS = (size_t)TS * 1024;
constexpr size_t O_AVS = O_AKS + SZ_NEWS;
constexpr size_t O_BKS = O_AVS + SZ_NEWS;
constexpr size_t O_BVS = O_BKS + SZ_NEWS;
constexpr size_t O_IKS = O_BVS + SZ_NEWS;

constexpr size_t al256(size_t x) { return (x + 255) & ~size_t(255); }
constexpr size_t SZ_WGU = 5632ull * 1024 * 2, SZ_WD = 1024ull * 2816 * 2, SZ_WIN = 8960ull * 1024 * 2, SZ_WSQ = 1024ull * 1024 * 2;
constexpr int VTPAD = 8256;
constexpr size_t OFF_WA = 0;
constexpr size_t OFF_WB = OFF_WA + SZ_WSQ;
constexpr size_t OFF_WO = OFF_WB + SZ_WSQ;
constexpr size_t OFF_WGU2 = OFF_WO + SZ_WSQ;
constexpr size_t OFF_WD2 = OFF_WGU2 + SZ_WGU;
constexpr size_t OFF_XF = OFF_WD2 + SZ_WD;
constexpr size_t SZ_SSP = (size_t)TPAD * 16 * 4;
constexpr size_t OFF_SSP0 = OFF_XF + (size_t)TPAD * 1024 * 4;
constexpr size_t OFF_SSP1 = OFF_SSP0 + SZ_SSP;
constexpr size_t OFF_SSP2 = OFF_SSP1 + SZ_SSP;
constexpr size_t OFF_SSP3 = OFF_SSP2 + SZ_SSP;
constexpr size_t OFF_TAB = OFF_SSP3 + SZ_SSP;
constexpr size_t OFF_AQ = OFF_TAB + (size_t)NTOKP * 64 * 8;
constexpr size_t OFF_MB = OFF_AQ;
constexpr size_t OFF_BQ = OFF_AQ + (size_t)TPAD * 1024 * 2;
constexpr size_t OFF_IQ = OFF_BQ + (size_t)TPAD * 1024 * 2;
constexpr size_t OFF_IW = OFF_IQ + (size_t)TPAD * 512 * 2;
constexpr size_t OFF_G = OFF_IW + (size_t)TPAD * 8 * 4;
constexpr size_t OFF_OA = OFF_G + (size_t)TPAD * 2048 * 2;
constexpr size_t OFF_MASKP = OFF_OA + (size_t)TPAD * 1024 * 2;
constexpr size_t OFF_MASKS = OFF_MASKP + al256((size_t)TP * NWP * 8);
constexpr size_t OFF_CNT = OFF_MASKS + al256((size_t)TS * NWS * 8);
constexpr size_t OFF_XBAR = OFF_CNT + 256;
constexpr size_t SZ_XBAR = 3456 * 4 + 256;
constexpr size_t OFF_AKB = OFF_XBAR + ((SZ_XBAR + 255) & ~size_t(255));
constexpr size_t OFF_BKB = OFF_AKB + (size_t)TP * 1024 * 2;
constexpr size_t SZ_VT = 2ull * 8 * 128 * VTPAD * 2;
constexpr size_t OFF_AVT = OFF_BKB + (size_t)TP * 1024 * 2;
constexpr size_t OFF_BVT = OFF_AVT + SZ_VT;
constexpr size_t OFF_IKB = OFF_BVT + SZ_VT;
constexpr size_t OFF_DEAD = OFF_IKB + al256((size_t)TP * 64 * 2);
constexpr size_t OFF_WGU1 = OFF_DEAD;
constexpr size_t OFF_WD1 = OFF_WGU1 + SZ_WGU;
constexpr size_t OFF_WIN = OFF_WD1 + SZ_WD;
constexpr size_t OFF_XB = OFF_WIN + SZ_WIN;
constexpr size_t OFF_HID = OFF_XB + (size_t)TPAD * 1024 * 2;
constexpr size_t OFF_OB = OFF_HID + (size_t)TPAD * 2816 * 2;
constexpr size_t OFF_SC = OFF_DEAD;
constexpr size_t SC_BSTRIDE = 4096ull * (128 * 131 / 2);
constexpr size_t SC_META = 2 * SC_BSTRIDE;
constexpr size_t SC_SAMP = SC_META + 2 * 4096;
constexpr size_t SC_FLOATS = SC_SAMP + 16ull * 64 * 2112;
constexpr size_t WS_END = OFF_SC + SC_FLOATS * 4 + 4096;
static_assert(WS_END <= 736544256ull, "workspace budget");
static_assert(OFF_OB + (size_t)TPAD * 1024 * 2 <= WS_END, "dead region fits");

constexpr int SMEM_ITEM = 149504;
constexpr int SMEM_BYTES = SMEM_ITEM + 64;

struct Params {
  const float* in[27];
  float* out;
  char* ws;
};

typedef __attribute__((ext_vector_type(2))) float f32x2_t;
typedef __attribute__((ext_vector_type(2))) __bf16 bf16x2_t;
DI unsigned pack2(float a, float b) {
  f32x2_t v = {a, b};
  return __builtin_bit_cast(unsigned, __builtin_convertvector(v, bf16x2_t));
}
DI u16 f2bf(float x) { return (u16)(pack2(x, x) & 0xffffu); }
DI int tid_opaque() { int t = threadIdx.x; asm volatile("" : "+v"(t)); return t; }
DI int crow(int i, int h) { return (i & 3) + 8 * (i >> 2) + 4 * h; }
DI float fexp2(float x) { return __builtin_amdgcn_exp2f(x); }
DI float shx(float v, int m) { return __shfl_xor(v, m, 64); }

DI const float* xrow_ptr(const Params& p, int row) {
  if (row < TP) {
    int b = row >= NTOKP ? 1 : 0;
    int tok = row - b * NTOKP;
    if (tok < 16) return p.in[7] + (size_t)tok * 1024;
    return p.in[0] + ((size_t)b * 8192 + (tok - 16)) * 1024;
  }
  return p.in[1] + (size_t)(row - TP) * 1024;
}

DI const float* kv_row(const Params& p, int grp, int b, int tk, int which) {
  if (!grp) return p.out + O_AKP + (size_t)which * SZ_NEWP + ((size_t)b * NTOKP + tk) * 1024;
  if (tk < NCACHE) return (which == 0 ? p.in[2] : which == 1 ? p.in[3] : which == 2 ? p.in[4] : p.in[5]) + ((size_t)b * NCACHE + tk) * 1024;
  return p.out + O_AKS + (size_t)which * SZ_NEWS + ((size_t)b * 32 + (tk - NCACHE)) * 1024;
}
DI const float* ik_row(const Params& p, int grp, int b, int tk) {
  if (!grp) return p.out + O_IKP + ((size_t)b * NTOKP + tk) * 64;
  if (tk < NCACHE) return p.in[6] + ((size_t)b * NCACHE + tk) * 64;
  return p.out + O_IKS + ((size_t)b * 32 + (tk - NCACHE)) * 64;
}

#define XB_TMO      128
#define XB_XCNT(j)  (256  + 64 * (j))
#define XB_XSUB(j)  (1280 + 64 * (j))
#define XB_XGEN(j)  (2304 + 64 * (j))
#define XB_TOP      3328
#define XB_TOPGEN   3392
#define XCD_BAR_WORDS 3456
#define XB_SPIN_CAP (1u << 18)
#define LAS __attribute__((address_space(3)))

__device__ __forceinline__ unsigned xb_ld(unsigned* p)              { return __hip_atomic_load(p, __ATOMIC_RELAXED, __HIP_MEMORY_SCOPE_AGENT); }
__device__ __forceinline__ unsigned xb_add(unsigned* p, unsigned v) { return __hip_atomic_fetch_add(p, v, __ATOMIC_RELAXED, __HIP_MEMORY_SCOPE_AGENT); }
__device__ __forceinline__ unsigned xb_xcc_id() { return (unsigned)__builtin_amdgcn_s_getreg((3 << 11) | 20) & 0xFu; }
#define XB_SPIN(cond, bar) do { unsigned _sp = 0; while (cond) { __builtin_amdgcn_s_sleep(1); \
    if ((++_sp & 255u) == 0u) { if (xb_ld(&(bar)[XB_TMO])) break; if (_sp > XB_SPIN_CAP) { atomicAdd(&(bar)[XB_TMO], 1u); break; } } } } while (0)

struct XcdBarrier {
    unsigned* bar; unsigned x;
    volatile LAS unsigned* st;
};

__device__ __forceinline__ XcdBarrier xcd_barrier_post(unsigned* bar, volatile LAS unsigned* st) {
    XcdBarrier b; b.bar = bar; b.x = xb_xcc_id(); b.st = st;
    if (threadIdx.x == 0) (void)xb_add(&bar[XB_XCNT(b.x)], 1u);
    return b;
}
__device__ __forceinline__ void xcd_barrier_complete(unsigned* bar, unsigned x, unsigned& nloc, unsigned& nx) {
    const unsigned G = gridDim.x * gridDim.y * gridDim.z;
    unsigned sum, cnt, mine, sp = 0u;
    for (;;) {
        sum = 0u; cnt = 0u; mine = 0u;
#pragma unroll
        for (unsigned j = 0; j < 16; ++j) { const unsigned c = xb_ld(&bar[XB_XCNT(j)]); sum += c; cnt += (c > 0u) ? 1u : 0u; mine = (j == x) ? c : mine; }
        if (sum == G) break;
        __builtin_amdgcn_s_sleep(1);
        if ((++sp & 255u) == 0u) { if (xb_ld(&bar[XB_TMO])) break; if (sp > XB_SPIN_CAP) { atomicAdd(&bar[XB_TMO], 1u); break; } }
    }
    nloc = mine > 0u ? mine : 1u; nx = cnt > 0u ? cnt : 1u;
}

__device__ __forceinline__ void xcd_barrier(const XcdBarrier& b) {
    asm volatile("s_waitcnt vmcnt(0)" ::: "memory");
    __syncthreads();
    if (threadIdx.x == 0) {
        unsigned* bar = b.bar;
        __builtin_amdgcn_s_waitcnt(0);
        unsigned nloc = b.st[0], nx = b.st[1];
        if (nloc == 0u) { xcd_barrier_complete(bar, b.x, nloc, nx); b.st[0] = nloc; b.st[1] = nx; }
        const unsigned old = xb_add(&bar[XB_XSUB(b.x)], 1u);
        const unsigned gen = old / nloc;
        if (old + 1u == (gen + 1u) * nloc) {
            __builtin_amdgcn_fence(__ATOMIC_RELEASE, "agent");
            asm volatile("s_waitcnt vmcnt(0)" ::: "memory");
            const unsigned og = xb_add(&bar[XB_TOP], 1u);
            const unsigned tg = og / nx;
            if (og + 1u == (tg + 1u) * nx) xb_add(&bar[XB_TOPGEN], 1u);
            else XB_SPIN(xb_ld(&bar[XB_TOPGEN]) == tg, bar);
            __builtin_amdgcn_fence(__ATOMIC_ACQUIRE, "agent");
            xb_add(&bar[XB_XGEN(b.x)], 1u);
            asm volatile("s_waitcnt vmcnt(0)" ::: "memory");
        } else {
            XB_SPIN(xb_ld(&bar[XB_XGEN(b.x)]) == gen, bar);
            __builtin_amdgcn_fence(__ATOMIC_ACQUIRE, "agent");
            asm volatile("s_waitcnt vmcnt(0)" ::: "memory");
        }
    }
    __syncthreads();
}


DI void gbar(const Params& p, char* smem) {
  XcdBarrier b; b.bar = (unsigned*)(p.ws + OFF_XBAR); b.x = xb_xcc_id(); b.st = (volatile LAS unsigned*)(smem + SMEM_ITEM + 48);
  xcd_barrier(b);
}
template <int job>
DI void wt_tile(const Params& p, int seg, int kt, float* ts) {
  const int t = threadIdx.x & 255;
  ts += (threadIdx.x >> 8) * (128 * 33);
  const float* src = nullptr; int ld = 0; const float* gs = nullptr; u16* dst = nullptr; int K = 1024; int nvalid4 = 8;
  switch (job) {
    case 0: case 6: {
      const float* wg = job == 0 ? p.in[9] : p.in[23]; const float* wu = job == 0 ? p.in[10] : p.in[24];
      const int c4g = threadIdx.x & 7;
      src = (c4g < 4 ? wg : wu) + 16 * seg - (c4g < 4 ? 0 : 16); ld = 2816; gs = job == 0 ? p.in[8] : p.in[22];
      dst = (u16*)(p.ws + (job == 0 ? OFF_WGU1 : OFF_WGU2)) + (size_t)seg * 32 * 1024; K = 1024;
    } break;
    case 1: case 7: {
      src = (job == 1 ? p.in[11] : p.in[25]) + 32 * seg; ld = 1024; K = 2816;
      dst = (u16*)(p.ws + (job == 1 ? OFF_WD1 : OFF_WD2)) + (size_t)seg * 32 * 2816;
    } break;
    case 2: {
      const int G = seg; const int c4g = threadIdx.x & 7; const int hf = c4g >> 2;
      int a0 = 0; bool valid = true;
      if (G < 64) { const int base = G < 32 ? 0 : 1024; const int q = G & 31; a0 = base + (q >> 1) * 64 + (q & 1) * 16 + hf * 32; }
      else if (G < 96) a0 = 2048 + (G - 64) * 32 + hf * 16;
      else if (G < 160) { const int base = G < 128 ? 3072 : 4096; const int q = (G - 96) & 31; a0 = base + (q >> 2) * 128 + (q & 3) * 16 + hf * 64; }
      else if (G < 192) a0 = 5120 + (G - 160) * 32 + hf * 16;
      else if (G < 208) { const int q = G - 192; a0 = 6144 + (q >> 1) * 64 + (q & 1) * 16 + hf * 32; }
      else if (G < 210) { a0 = 6656 + (G - 208) * 16 + hf * 32; }
      else if (G == 210) { a0 = 6720; valid = c4g < 2; }
      else if (G < 275) a0 = 6728 + (G - 211) * 32 + hf * 16;
      else valid = false;
      if (!valid) a0 = 0;
      src = p.in[13] + a0 - (valid ? hf * 16 : c4g * 4); ld = 8776; gs = p.in[12]; K = 1024;
      nvalid4 = valid ? 8 : 0;
      dst = (u16*)(p.ws + OFF_WIN) + (size_t)G * 32 * 1024;
    } break;
    default: {
      src = (job == 3 ? p.in[19] : (job == 4 ? p.in[20] : p.in[21])) + 32 * seg; ld = 1024; K = 1024;
      dst = (u16*)(p.ws + (job == 3 ? OFF_WA : (job == 4 ? OFF_WB : OFF_WO))) + (size_t)seg * 32 * 1024;
    } break;
  }
  const int c4 = t & 7, kr = t >> 3;
  {
#pragma unroll
  for (int ps = 0; ps < 4; ++ps) {
    const int kl = ps * 32 + kr; const int k = kt * 128 + kl;
    float4 v = make_float4(0.f, 0.f, 0.f, 0.f);
    if (c4 < nvalid4) v = *(const float4*)(src + (size_t)k * ld + c4 * 4);
    const float s = gs ? gs[k] : 1.0f;
    float* d = ts + kl * 33 + c4 * 4;
    d[0] = v.x * s; d[1] = v.y * s; d[2] = v.z * s; d[3] = v.w * s;
  }
  }
  __syncthreads();
  {
    const int r = t >> 3, kc = t & 7;
    unsigned o[8];
#pragma unroll
    for (int j = 0; j < 8; ++j) o[j] = pack2(ts[(kc * 16 + 2 * j) * 33 + r], ts[(kc * 16 + 2 * j + 1) * 33 + r]);
    uint4* dp = (uint4*)(dst + (size_t)r * K + kt * 128 + kc * 16);
    dp[0] = make_uint4(o[0], o[1], o[2], o[3]);
    dp[1] = make_uint4(o[4], o[5], o[6], o[7]);
  }
  __syncthreads();
}

DI void phase_prep(const Params& p, char* smem) {
  const int t = tid_opaque(), lane = t & 63;
  for (int e = blockIdx.x * NTHR + t; e < NTOKP * 64; e += gridDim.x * NTHR) {
    const int pos = e >> 6, i = e & 63;
    double inv = 1.0;
    for (int j = 0; j < i; ++j) inv *= 0.8659643233600653;
    const float invf = (float)inv;
    const float ang = (float)pos * invf;
    const double a = (double)ang;
    const double qd = rint(a * 0.6366197723675814);
    const double r = (a - qd * 1.5707963267948966) - qd * 6.123233995736766e-17;
    const double r2 = r * r;
    double sn = r2 * (1.0 / 6227020800.0) - 1.0 / 39916800.0;
    sn = sn * r2 + 1.0 / 362880.0; sn = sn * r2 - 1.0 / 5040.0; sn = sn * r2 + 1.0 / 120.0; sn = sn * r2 - 1.0 / 6.0; sn = sn * r2 * r + r;
    double cn = -r2 * (1.0 / 87178291200.0) + 1.0 / 479001600.0;
    cn = cn * r2 - 1.0 / 3628800.0; cn = cn * r2 + 1.0 / 40320.0; cn = cn * r2 - 1.0 / 720.0; cn = cn * r2 + 1.0 / 24.0; cn = cn * r2 - 0.5; cn = cn * r2 + 1.0;
    const int q = ((int)qd) & 3;
    double c, s;
    if (q == 0) { c = cn; s = sn; } else if (q == 1) { c = -sn; s = cn; } else if (q == 2) { c = -cn; s = -sn; } else { c = sn; s = -cn; }
    ((float2*)(p.ws + OFF_TAB))[e] = make_float2((float)c, (float)s);
  }
  for (int e = blockIdx.x * NTHR + t; e < 2 * 2048 * 6; e += gridDim.x * NTHR) {
    const int which = e / (2048 * 6), r = e % (2048 * 6);
    const int row = r / 6, ch = r % 6;
    u16* vt = (u16*)(p.ws + (which ? OFF_BVT : OFF_AVT)) + (size_t)row * VTPAD + NTOKP + ch * 8;
    *(uint4*)vt = make_uint4(0, 0, 0, 0);
  }
  {
    const int wv = blockIdx.x * 8 + (t >> 6), nw = gridDim.x * 8;
    for (int row = wv; row < TPAD; row += nw) {
      u16* xb = (u16*)(p.ws + OFF_XB) + (size_t)row * 1024;
      float* ssp = (float*)(p.ws + OFF_SSP0) + (size_t)row * 16;
      if (row >= T) {
        uint4 z = make_uint4(0, 0, 0, 0);
        ((uint4*)xb)[lane * 2] = z; ((uint4*)xb)[lane * 2 + 1] = z;
        if (lane < 16) ssp[lane] = lane == 0 ? 1024.f : 0.f;
        continue;
      }
      const float4* src = (const float4*)xrow_ptr(p, row);
      float ss = 0.f;
#pragma unroll
      for (int i = 0; i < 4; ++i) {
        const float4 v = src[lane + 64 * i];
        ss += v.x * v.x + v.y * v.y + v.z * v.z + v.w * v.w;
        ((uint2*)xb)[lane + 64 * i] = make_uint2(pack2(v.x, v.y), pack2(v.z, v.w));
      }
#pragma unroll
      for (int m = 32; m >= 1; m >>= 1) ss += shx(ss, m);
      if (lane < 16) ssp[lane] = lane == 0 ? ss : 0.f;
    }
  }
  {
    float* ts = (float*)smem;
    for (int tb = blockIdx.x * 2; tb < 7232; tb += gridDim.x * 2) {
      const int tile = __builtin_amdgcn_readfirstlane(tb + (int)(threadIdx.x >> 8));
      if (tile >= 7232) { __syncthreads(); __syncthreads(); continue; }
      int job, r = tile;
      if (r < 1408) job = 0;
      else if ((r -= 1408) < 704) job = 1;
      else if ((r -= 704) < 2240) job = 2;
      else if ((r -= 2240) < 256) job = 3;
      else if ((r -= 256) < 256) job = 4;
      else if ((r -= 256) < 256) job = 5;
      else if ((r -= 256) < 1408) job = 6;
      else { r -= 1408; job = 7; }
      const int nkt = (job == 1 || job == 7) ? 22 : 8;
      const int sg = r / nkt, kk = r % nkt;
      switch (job) {
        case 0: wt_tile<0>(p, sg, kk, ts); break;
        case 1: wt_tile<1>(p, sg, kk, ts); break;
        case 2: wt_tile<2>(p, sg, kk, ts); break;
        case 3: wt_tile<3>(p, sg, kk, ts); break;
        case 4: wt_tile<4>(p, sg, kk, ts); break;
        case 5: wt_tile<5>(p, sg, kk, ts); break;
        case 6: wt_tile<6>(p, sg, kk, ts); break;
        default: wt_tile<7>(p, sg, kk, ts); break;
      }
    }
  }
}

constexpr int GSTAGE = (256 + 128) * 72;
constexpr int RS_OFF = 2 * GSTAGE * 2;
#define G_DECL uint4 gs0, gs1, gs2, gs3, gs4, gs5, gs6, gs7, gs8, gs9, gs10, gs11, gs12, gs13, gs14, gs15, gs16, gs17; float4 gq0, gq1, gq2, gq3;
#define G_LOAD(S0, S1, S2, S3, S4, S5, kn) { \
    S0 = *(const uint4*)(Ap + (kn)); S1 = *(const uint4*)(Ap + (size_t)64 * lda_ + (kn)); \
    S2 = *(const uint4*)(Ap + (size_t)128 * lda_ + (kn)); S3 = *(const uint4*)(Ap + (size_t)192 * lda_ + (kn)); \
    S4 = *(const uint4*)(Bp + (kn)); S5 = *(const uint4*)(Bp + (size_t)64 * ldb_ + (kn)); }
#define G_STORE(S0, S1, S2, S3, S4, S5, st) { \
    u16* An_ = smem_ + (st) * GSTAGE; u16* Bn_ = An_ + 256 * 72; \
    *(uint4*)(An_ + (lrow) * 72 + lkc * 8) = S0; *(uint4*)(An_ + (lrow + 64) * 72 + lkc * 8) = S1; \
    *(uint4*)(An_ + (lrow + 128) * 72 + lkc * 8) = S2; *(uint4*)(An_ + (lrow + 192) * 72 + lkc * 8) = S3; \
    *(uint4*)(Bn_ + (lrow) * 72 + lkc * 8) = S4; *(uint4*)(Bn_ + (lrow + 64) * 72 + lkc * 8) = S5; }
#define G_LOAD_A(kn) G_LOAD(gs0, gs1, gs2, gs3, gs4, gs5, kn)
#define G_LOAD_B(kn) G_LOAD(gs6, gs7, gs8, gs9, gs10, gs11, kn)
#define G_LOAD_C(kn) G_LOAD(gs12, gs13, gs14, gs15, gs16, gs17, kn)
#define G_STORE_A(st) G_STORE(gs0, gs1, gs2, gs3, gs4, gs5, st)
#define G_STORE_B(st) G_STORE(gs6, gs7, gs8, gs9, gs10, gs11, st)
#define G_STORE_C(st) G_STORE(gs12, gs13, gs14, gs15, gs16, gs17, st)
#define G_COMPUTE(st, SWAPC, ACC) { \
    const u16* As_ = smem_ + (st) * GSTAGE; const u16* Bs_ = As_ + 256 * 72; \
    _Pragma("unroll") for (int kk = 0; kk < 4; ++kk) { \
      bf16x8 a0 = *(const bf16x8*)(As_ + (gwm * 64 + glr) * 72 + kk * 16 + glh * 8); \
      bf16x8 a1 = *(const bf16x8*)(As_ + (gwm * 64 + 32 + glr) * 72 + kk * 16 + glh * 8); \
      bf16x8 b0 = *(const bf16x8*)(Bs_ + (gwn * 64 + glr) * 72 + kk * 16 + glh * 8); \
      bf16x8 b1 = *(const bf16x8*)(Bs_ + (gwn * 64 + 32 + glr) * 72 + kk * 16 + glh * 8); \
      if (SWAPC) { \
        ACC[0][0] = MFMA(b0, a0, ACC[0][0]); ACC[0][1] = MFMA(b1, a0, ACC[0][1]); \
        ACC[1][0] = MFMA(b0, a1, ACC[1][0]); ACC[1][1] = MFMA(b1, a1, ACC[1][1]); \
      } else { \
        ACC[0][0] = MFMA(a0, b0, ACC[0][0]); ACC[0][1] = MFMA(a0, b1, ACC[0][1]); \
        ACC[1][0] = MFMA(a1, b0, ACC[1][0]); ACC[1][1] = MFMA(a1, b1, ACC[1][1]); } } }
#define G_STEP(k, SL, SS, SWAPC, ACC) if ((k) < nk_) { \
    if ((k) + 3 < nk_) G_LOAD_##SL(((k) + 3) << 6) \
    G_COMPUTE((k) & 1, SWAPC, ACC) \
    if ((k) + 1 < nk_) G_STORE_##SS(((k) + 1) & 1) \
    __syncthreads(); }
#define G_ISSUE(A_, LDA, B_, LDB, M0, N0, SSP) { \
    const int t_ = tid_opaque(); const int lrow = t_ >> 3, lkc = t_ & 7; const int lda_ = (LDA), ldb_ = (LDB); \
    const u16* Ap = (A_) + (size_t)((M0) + lrow) * lda_ + lkc * 8; \
    const u16* Bp = (B_) + (size_t)((N0) + lrow) * ldb_ + lkc * 8; \
    G_LOAD_A(0) G_LOAD_B(64) G_LOAD_C(128) \
    const float* ssp_ = (SSP); \
    if (ssp_ && t_ < 256) { const float4* q_ = (const float4*)(ssp_ + (size_t)((M0) + t_) * 16); gq0 = q_[0]; gq1 = q_[1]; gq2 = q_[2]; gq3 = q_[3]; } }
#define G_RSFIN(RS) { const int t_ = tid_opaque(); if (t_ < 256) { \
    const float s_ = ((gq0.x + gq0.y) + (gq0.z + gq0.w)) + ((gq1.x + gq1.y) + (gq1.z + gq1.w)) + ((gq2.x + gq2.y) + (gq2.z + gq2.w)) + ((gq3.x + gq3.y) + (gq3.z + gq3.w)); \
    (RS)[t_] = rsqrtf(s_ * (1.0f / 1024.0f) + EPS); } }
#define G_RUN(A_, LDA, B_, LDB, K_, M0, N0, SMEM, ACC, SWAPC) { \
    const int t_ = tid_opaque(), glane = t_ & 63, gw = t_ >> 6, gwm = gw >> 1, gwn = gw & 1; \
    const int glr = glane & 31, glh = glane >> 5; const int lrow = t_ >> 3, lkc = t_ & 7; const int lda_ = (LDA), ldb_ = (LDB); \
    u16* smem_ = (SMEM); \
    const u16* Ap = (A_) + (size_t)((M0) + lrow) * lda_ + lkc * 8; \
    const u16* Bp = (B_) + (size_t)((N0) + lrow) * ldb_ + lkc * 8; \
    const int nk_ = (K_) >> 6; \
    G_STORE_A(0) \
    __syncthreads(); \
    for (int ks = 0; ks < nk_; ks += 3) { \
      G_STEP(ks, A, B, SWAPC, ACC) \
      G_STEP(ks + 1, B, C, SWAPC, ACC) \
      G_STEP(ks + 2, C, A, SWAPC, ACC) } }

DI bool gemm_tile(int vbid, int it, int nt_n, int& m0, int& n0) {
  if (gridDim.x == 256) {
    const int x = vbid & 7, r = vbid >> 3;
    const int L = (it * 8 + x) * 32 + r;
    if (L >= NT_M * nt_n) return false;
    const int full = (NT_M / 4) * 4 * nt_n;
    int m, n;
    if (L < full) { const int band = L / (4 * nt_n), idx = L - band * 4 * nt_n; n = idx >> 2; m = band * 4 + (idx & 3); }
    else { const int idx = L - full; constexpr int rem = NT_M % 4; n = idx / rem; m = (NT_M / 4) * 4 + idx % rem; }
    m0 = m * 256; n0 = n * 128;
    return true;
  }
  const int tile = blockIdx.x + it * gridDim.x;
  m0 = (tile / nt_n) * 256; n0 = (tile % nt_n) * 128;
  return tile < NT_M * nt_n;
}
DI int gemm_rounds(int nt_n) {
  return (NT_M * nt_n + gridDim.x - 1) / gridDim.x;
}

DI void zero_acc(f32x16 (&acc)[2][2]) {
#pragma unroll
  for (int a = 0; a < 2; ++a)
#pragma unroll
    for (int b = 0; b < 2; ++b)
#pragma unroll
      for (int i = 0; i < 16; ++i) acc[a][b][i] = 0.f;
}

DI void load_rs(const float* ssp, int m0, float* rs_s) {
  __syncthreads();
  const int t = threadIdx.x;
  if (t < 256) {
    const float4* q = (const float4*)(ssp + (size_t)(m0 + t) * 16);
    const float4 a = q[0], b = q[1], c = q[2], d = q[3];
    const float s = ((a.x + a.y) + (a.z + a.w)) + ((b.x + b.y) + (b.z + b.w)) + ((c.x + c.y) + (c.z + c.w)) + ((d.x + d.y) + (d.z + d.w));
    rs_s[t] = rsqrtf(s * (1.0f / 1024.0f) + EPS);
  }
}

typedef __attribute__((ext_vector_type(4))) float f32x4;
constexpr int P8_HT = 128 * 64;
constexpr int RS8_OFF = 8 * P8_HT * 2;
DI int p8_lds_byte(int r, int c) {
  const int st = (r >> 4) * 2 + (c >> 5), rr = r & 15, cc = c & 31, ob = rr * 64 + cc * 2;
  return st * 1024 + (ob ^ (((ob >> 9) & 1) << 5));
}
DI void p8_stage_rc(int b, int& R, int& C) {
  const int st = b / 1024, sb = b % 1024, swz = sb ^ (((sb >> 9) & 1) << 5);
  R = (st >> 1) * 16 + swz / 64; C = (st & 1) * 32 + (swz % 64) / 2;
}
typedef __attribute__((address_space(3))) unsigned lds_u32;
typedef __attribute__((address_space(3))) unsigned char lds_u8;
typedef __attribute__((address_space(3))) bf16x8 lds_bf16x8;
DI void gemm8_tile(const u16* __restrict__ A, const u16* __restrict__ Bt, const int K, const int brow, const int bcol,
                   u16* shm, f32x4 (&acc)[2][2][4][2], const int klen = 0) {
#define P8_SA(b, h) (((b) * 2 + (h)) * 16384)
#define P8_SB(b, h) ((4 + (b) * 2 + (h)) * 16384)
#define P8_STAGE(P, BASE, br, kt) do { const char* _gb = (const char*)(BASE) + ((long)(br) * K + (long)(kt) * 64) * 2; \
    __builtin_amdgcn_global_load_lds((const unsigned*)(_gb + so0), (lds_u32*)(lds + (P) + lo0), 16, 0, 0); \
    __builtin_amdgcn_global_load_lds((const unsigned*)(_gb + (long)K * 128 + so0), (lds_u32*)(lds + (P) + lo0 + 8192), 16, 0, 0); } while (0)
#define P8_LDA(dst, b, h) _Pragma("unroll") for (int m = 0; m < 4; ++m) _Pragma("unroll") for (int k = 0; k < 2; ++k) \
    dst[m][k] = *(const lds_bf16x8*)(lds + P8_SA(b, h) + aoff + m * 2048 + k * 1024)
#define P8_LDB(dst, b, h) _Pragma("unroll") for (int n = 0; n < 2; ++n) _Pragma("unroll") for (int k = 0; k < 2; ++k) \
    dst[n][k] = *(const lds_bf16x8*)(lds + P8_SB(b, h) + boff + n * 2048 + k * 1024)
#define P8_MMA(ai, bj, At_, Bt_) do { __builtin_amdgcn_s_setprio(1); \
    _Pragma("unroll") for (int m = 0; m < 4; ++m) _Pragma("unroll") for (int n = 0; n < 2; ++n) _Pragma("unroll") for (int k = 0; k < 2; ++k) \
      acc[ai][bj][m][n] = __builtin_amdgcn_mfma_f32_16x16x32_bf16(Bt_[n][k], At_[m][k], acc[ai][bj][m][n], 0, 0, 0); \
    __builtin_amdgcn_s_setprio(0); } while (0)
#define P8_WAIT_V(n) asm volatile("s_waitcnt vmcnt(" #n ")" ::: "memory")
#define P8_WAIT_L(n) asm volatile("s_waitcnt lgkmcnt(" #n ")" ::: "memory")
#define P8_BAR __builtin_amdgcn_s_barrier()
#define P8_SCHED __builtin_amdgcn_sched_barrier(0)
  const int HALF = 128;
  const int tid8 = tid_opaque();
  const int wid = __builtin_amdgcn_readfirstlane(tid8 >> 6), lane = tid8 & 63, wr = wid >> 2, wc = wid & 3, fr = lane & 15, fq = lane >> 4;
  lds_u8* lds = (lds_u8*)shm;
  const int lo0 = tid8 * 16;
  const int aoff = p8_lds_byte(wr * 64 + fr, fq * 8), boff = p8_lds_byte(wc * 32 + fr, fq * 8);
  unsigned so0;
  { int r_, c_; p8_stage_rc(lo0, r_, c_); so0 = (unsigned)(r_ * K + c_) * 2u; }
  bf16x8 At[4][2], B0[2][2], B1[2][2];
  const int nt = (klen ? klen : K) / 64;
  P8_STAGE(P8_SB(0, 0), Bt, bcol, 0); P8_STAGE(P8_SA(0, 0), A, brow, 0);
  P8_STAGE(P8_SB(0, 1), Bt, bcol + HALF, 0); P8_STAGE(P8_SA(0, 1), A, brow + HALF, 0);
  if (wr == 1) P8_BAR;
  P8_WAIT_V(4); P8_BAR;
  P8_STAGE(P8_SB(1, 0), Bt, bcol, 1); P8_STAGE(P8_SA(1, 0), A, brow, 1); P8_STAGE(P8_SB(1, 1), Bt, bcol + HALF, 1);
  P8_WAIT_V(6); P8_BAR;
  for (int t = 0; t < nt - 2; t += 2) {
    P8_LDB(B0, 0, 0); P8_SCHED; P8_LDA(At, 0, 0); P8_STAGE(P8_SA(1, 1), A, brow + HALF, t + 1);
    P8_WAIT_L(8); P8_BAR; P8_WAIT_L(0); P8_MMA(0, 0, At, B0); P8_BAR; P8_SCHED;
    P8_LDB(B1, 0, 1); P8_STAGE(P8_SB(0, 0), Bt, bcol, t + 2);
    P8_BAR; P8_WAIT_L(0); P8_MMA(0, 1, At, B1); P8_BAR;
    P8_LDA(At, 0, 1); P8_STAGE(P8_SA(0, 0), A, brow, t + 2);
    P8_BAR; P8_WAIT_L(0); P8_MMA(1, 0, At, B0); P8_BAR; P8_SCHED;
    P8_STAGE(P8_SB(0, 1), Bt, bcol + HALF, t + 2);
    P8_WAIT_V(6); P8_BAR; P8_MMA(1, 1, At, B1); P8_BAR;
    P8_LDB(B0, 1, 0); P8_SCHED; P8_LDA(At, 1, 0); P8_STAGE(P8_SA(0, 1), A, brow + HALF, t + 2);
    P8_WAIT_L(8); P8_BAR; P8_WAIT_L(0); P8_MMA(0, 0, At, B0); P8_BAR; P8_SCHED;
    P8_LDB(B1, 1, 1); P8_STAGE(P8_SB(1, 0), Bt, bcol, t + 3);
    P8_BAR; P8_WAIT_L(0); P8_MMA(0, 1, At, B1); P8_BAR;
    P8_LDA(At, 1, 1); P8_STAGE(P8_SA(1, 0), A, brow, t + 3);
    P8_BAR; P8_WAIT_L(0); P8_MMA(1, 0, At, B0); P8_BAR; P8_SCHED;
    P8_STAGE(P8_SB(1, 1), Bt, bcol + HALF, t + 3);
    P8_WAIT_V(6); P8_BAR; P8_MMA(1, 1, At, B1); P8_BAR;
  }
  { P8_LDB(B0, 0, 0); P8_LDA(At, 0, 0); P8_STAGE(P8_SA(1, 1), A, brow + HALF, nt - 1);
    P8_BAR; P8_WAIT_L(0); P8_MMA(0, 0, At, B0); P8_BAR;
    P8_LDB(B1, 0, 1); P8_BAR; P8_WAIT_L(0); P8_MMA(0, 1, At, B1); P8_BAR;
    P8_LDA(At, 0, 1); P8_WAIT_V(4); P8_BAR; P8_WAIT_L(0); P8_MMA(1, 0, At, B0); P8_MMA(1, 1, At, B1); P8_BAR; }
  { P8_LDB(B0, 1, 0); P8_LDA(At, 1, 0); P8_WAIT_V(2); P8_BAR; P8_WAIT_L(0); P8_MMA(0, 0, At, B0); P8_BAR;
    P8_LDB(B1, 1, 1); P8_WAIT_V(0); P8_BAR; P8_WAIT_L(0); P8_MMA(0, 1, At, B1); P8_BAR;
    P8_LDA(At, 1, 1); P8_BAR; P8_WAIT_L(0); P8_MMA(1, 0, At, B0); P8_MMA(1, 1, At, B1); P8_BAR; }
  if (wr == 0) P8_BAR;
}

DI void phase_gateup(const Params& p, char* smem, size_t off_ssp, size_t off_w, int vbid) {
  const u16* A = (const u16*)(p.ws + OFF_XB);
  const u16* B = (const u16*)(p.ws + off_w);
  const float* ssp = (const float*)(p.ws + off_ssp);
  u16* hid = (u16*)(p.ws + OFF_HID);
  float* rs_s = (float*)(smem + RS8_OFF);
  const int nr = gemm_rounds(22);
  for (int it = 0; it < nr; ++it) {
    int m0, n0;
    if (!gemm_tile(vbid, it, 22, m0, n0)) continue;
    n0 *= 2;
    load_rs(ssp, m0, rs_s);
    __syncthreads();
    f32x4 acc[2][2][4][2];
#pragma unroll
    for (int a_ = 0; a_ < 2; ++a_)
#pragma unroll
      for (int b_ = 0; b_ < 2; ++b_)
#pragma unroll
        for (int m_ = 0; m_ < 4; ++m_)
#pragma unroll
          for (int n_ = 0; n_ < 2; ++n_) acc[a_][b_][m_][n_] = (f32x4){0.f, 0.f, 0.f, 0.f};
    gemm8_tile(A, B, 1024, m0, n0, (u16*)smem, acc);
    const int t = tid_opaque(), lane = t & 63, wid = t >> 6, wr = wid >> 2, wc = wid & 3, fr = lane & 15, fq = lane >> 4;
#pragma unroll
    for (int ai = 0; ai < 2; ++ai)
#pragma unroll
      for (int m = 0; m < 4; ++m) {
        const int rl = ai * 128 + wr * 64 + m * 16 + fr; const int row = m0 + rl;
        if (row < T) {
          const float r = rs_s[rl];
#pragma unroll
          for (int bj = 0; bj < 2; ++bj) {
            float hv[4];
#pragma unroll
            for (int j = 0; j < 4; ++j) {
              const float gg = acc[ai][bj][m][0][j] * r, uu = acc[ai][bj][m][1][j] * r;
              hv[j] = gg / (1.0f + __expf(-gg)) * uu;
            }
            const int hc = ((n0 + bj * 128 + wc * 32) >> 1) + fq * 4;
            *(uint2*)(hid + (size_t)row * 2816 + hc) = make_uint2(pack2(hv[0], hv[1]), pack2(hv[2], hv[3]));
          }
        }
      }
  }
}

DI void phase_merge8(const Params& p, char* smem, int vbid) {
  const u16* OA = (const u16*)(p.ws + OFF_OA); const u16* OB = (const u16*)(p.ws + OFF_OB);
  const u16* WA = (const u16*)(p.ws + OFF_WA); const u16* WB = (const u16*)(p.ws + OFF_WB);
  const u16* G = (const u16*)(p.ws + OFF_G);
  u16* MB = (u16*)(p.ws + OFF_MB);
  float* tmp = (float*)(p.ws + OFF_HID);
  float* part_buf = (float*)(p.ws + OFF_BQ);
  const bool splitmode = gridDim.x == 256;
  const int nr = splitmode ? 1 : gemm_rounds(4);
  const int nitem = splitmode ? 12 * 8 : 0;
  for (int itx = 0; itx < nr + (nitem ? 1 : 0); ++itx) {
    int m0, n0, slice = -1, spass = 0;
    if (itx < nr) {
      if (!gemm_tile(vbid, itx, 4, m0, n0)) continue;
      n0 *= 2;
    } else {
      if (vbid >= nitem) continue;
      const int tl = vbid >> 3; spass = (vbid >> 2) & 1; slice = vbid & 3;
      m0 = (64 + (tl >> 2)) * 256; n0 = (tl & 3) * 256;
    }
#pragma unroll 1
    for (int pass = (slice < 0 ? 0 : spass); pass < (slice < 0 ? 2 : spass + 1); ++pass) {
      __syncthreads();
      f32x4 acc[2][2][4][2];
#pragma unroll
      for (int a_ = 0; a_ < 2; ++a_)
#pragma unroll
        for (int b_ = 0; b_ < 2; ++b_)
#pragma unroll
          for (int m_ = 0; m_ < 4; ++m_)
#pragma unroll
            for (int n_ = 0; n_ < 2; ++n_) acc[a_][b_][m_][n_] = (f32x4){0.f, 0.f, 0.f, 0.f};
      {
        const int koff = slice < 0 ? 0 : slice * 256;
        gemm8_tile((pass ? OB : OA) + koff, (pass ? WB : WA) + koff, 1024, m0, n0, (u16*)smem, acc, slice < 0 ? 1024 : 256);
      }
      const int t = tid_opaque(), lane = t & 63, wid = t >> 6, wr = wid >> 2, wc = wid & 3, fr = lane & 15, fq = lane >> 4;
      float* pb = part_buf + (size_t)(pass * 4 + (slice < 0 ? 0 : slice)) * 768 * 1024;
#pragma unroll
      for (int ai = 0; ai < 2; ++ai)
#pragma unroll
        for (int m = 0; m < 4; ++m) {
          const int row = m0 + ai * 128 + wr * 64 + m * 16 + fr;
          if (row >= T) continue;
#pragma unroll
          for (int bj = 0; bj < 2; ++bj)
#pragma unroll
            for (int n = 0; n < 2; ++n) {
              const int col = n0 + bj * 128 + wc * 32 + n * 16 + fq * 4;
              if (slice >= 0) {
                *(float4*)(pb + (size_t)(row - 16384) * 1024 + col) = make_float4(acc[ai][bj][m][n][0], acc[ai][bj][m][n][1], acc[ai][bj][m][n][2], acc[ai][bj][m][n][3]);
                continue;
              }
              const uint2 gg = *(const uint2*)(G + (size_t)row * 2048 + pass * 1024 + col);
              const float g0 = __uint_as_float(gg.x << 16), g1 = __uint_as_float(gg.x & 0xffff0000u);
              const float g2 = __uint_as_float(gg.y << 16), g3 = __uint_as_float(gg.y & 0xffff0000u);
              float4 v = make_float4(g0 * acc[ai][bj][m][n][0], g1 * acc[ai][bj][m][n][1], g2 * acc[ai][bj][m][n][2], g3 * acc[ai][bj][m][n][3]);
              float* tp = tmp + (size_t)row * 1024 + col;
              if (pass == 0) *(float4*)tp = v;
              else {
                const float4 u = *(const float4*)tp;
                *(uint2*)(MB + (size_t)row * 1024 + col) = make_uint2(pack2(u.x + v.x, u.y + v.y), pack2(u.z + v.z, u.w + v.w));
              }
            }
        }
    }
  }
  if (splitmode) {
    gbar(p, smem);
    const int t = tid_opaque(), lane = t & 63;
    const int wv = vbid * 8 + (t >> 6);
    for (int rr = wv; rr < T - 16384; rr += 256 * 8) {
      const int row = 16384 + rr;
#pragma unroll
      for (int i = 0; i < 4; ++i) {
        const int col = (lane + 64 * i) * 4;
        float4 sa = make_float4(0.f, 0.f, 0.f, 0.f), sb = sa;
        for (int sl = 0; sl < 4; ++sl) {
          const float4 qa = *(const float4*)(part_buf + ((size_t)sl * 768 + rr) * 1024 + col);
          const float4 qb = *(const float4*)(part_buf + ((size_t)(4 + sl) * 768 + rr) * 1024 + col);
          sa.x += qa.x; sa.y += qa.y; sa.z += qa.z; sa.w += qa.w;
          sb.x += qb.x; sb.y += qb.y; sb.z += qb.z; sb.w += qb.w;
        }
        const uint2 ga = *(const uint2*)(G + (size_t)row * 2048 + col);
        const uint2 gb = *(const uint2*)(G + (size_t)row * 2048 + 1024 + col);
        const float m0v = __uint_as_float(ga.x << 16) * sa.x + __uint_as_float(gb.x << 16) * sb.x;
        const float m1v = __uint_as_float(ga.x & 0xffff0000u) * sa.y + __uint_as_float(gb.x & 0xffff0000u) * sb.y;
        const float m2v = __uint_as_float(ga.y << 16) * sa.z + __uint_as_float(gb.y << 16) * sb.z;
        const float m3v = __uint_as_float(ga.y & 0xffff0000u) * sa.w + __uint_as_float(gb.y & 0xffff0000u) * sb.w;
        *(uint2*)(MB + (size_t)row * 1024 + col) = make_uint2(pack2(m0v, m1v), pack2(m2v, m3v));
      }
    }
  }
}

template <int RESID_ORIG>
DI void phase_resid8(const Params& p, char* smem, const u16* A, int K, size_t off_w, float factor, size_t off_ssp_out, int vbid) {
  const u16* B = (const u16*)(p.ws + off_w);
  float* xf = (float*)(p.ws + OFF_XF);
  u16* xb = (u16*)(p.ws + OFF_XB);
  float* sspo = (float*)(p.ws + off_ssp_out);
  float* part_buf = (float*)(p.ws + OFF_G);
  const bool splitmode = gridDim.x == 256;
  const int nslice = K >> 8;
  const int nr = splitmode ? 1 : gemm_rounds(4);
  const int nitem = splitmode ? 12 * nslice : 0;
  for (int itx = 0; itx < nr + (nitem + 255) / 256; ++itx) {
    int m0, n0, slice = -1;
    if (itx < nr) {
      if (!gemm_tile(vbid, itx, 4, m0, n0)) continue;
      n0 *= 2;
    } else {
      const int id = (itx - nr) * 256 + vbid;
      if (id >= nitem) continue;
      const int tl = id / nslice; slice = id - tl * nslice;
      m0 = (64 + (tl >> 2)) * 256; n0 = (tl & 3) * 256;
    }
    __syncthreads();
    f32x4 acc[2][2][4][2];
#pragma unroll
    for (int a_ = 0; a_ < 2; ++a_)
#pragma unroll
      for (int b_ = 0; b_ < 2; ++b_)
#pragma unroll
        for (int m_ = 0; m_ < 4; ++m_)
#pragma unroll
          for (int n_ = 0; n_ < 2; ++n_) acc[a_][b_][m_][n_] = (f32x4){0.f, 0.f, 0.f, 0.f};
    {
      const int koff = slice < 0 ? 0 : slice * 256;
      gemm8_tile(A + koff, B + koff, K, m0, n0, (u16*)smem, acc, slice < 0 ? K : 256);
    }
    const int t = tid_opaque(), lane = t & 63, wid = t >> 6, wr = wid >> 2, wc = wid & 3, fr = lane & 15, fq = lane >> 4;
    const int pn = n0 >> 8;
    if (slice >= 0) {
      float* pb = part_buf + (size_t)slice * 768 * 1024;
#pragma unroll
      for (int ai = 0; ai < 2; ++ai)
#pragma unroll
        for (int m = 0; m < 4; ++m) {
          const int row = m0 + ai * 128 + wr * 64 + m * 16 + fr;
          if (row >= T) continue;
#pragma unroll
          for (int bj = 0; bj < 2; ++bj)
#pragma unroll
            for (int n = 0; n < 2; ++n) {
              const int col = n0 + bj * 128 + wc * 32 + n * 16 + fq * 4;
              *(float4*)(pb + (size_t)(row - 16384) * 1024 + col) = make_float4(acc[ai][bj][m][n][0], acc[ai][bj][m][n][1], acc[ai][bj][m][n][2], acc[ai][bj][m][n][3]);
            }
        }
      continue;
    }
#pragma unroll
    for (int ai = 0; ai < 2; ++ai)
#pragma unroll
      for (int m = 0; m < 4; ++m) {
        const int row = m0 + ai * 128 + wr * 64 + m * 16 + fr;
        const bool ok = row < T;
        float part = 0.f;
        if (ok) {
          const float* rsrc = RESID_ORIG ? xrow_ptr(p, row) : (xf + (size_t)row * 1024);
#pragma unroll
          for (int bj = 0; bj < 2; ++bj)
#pragma unroll
            for (int n = 0; n < 2; ++n) {
              const int col = n0 + bj * 128 + wc * 32 + n * 16 + fq * 4;
              const float4 xr = *(const float4*)(rsrc + col);
              float4 v;
              v.x = xr.x + factor * acc[ai][bj][m][n][0]; v.y = xr.y + factor * acc[ai][bj][m][n][1];
              v.z = xr.z + factor * acc[ai][bj][m][n][2]; v.w = xr.w + factor * acc[ai][bj][m][n][3];
              *(float4*)(xf + (size_t)row * 1024 + col) = v;
              *(uint2*)(xb + (size_t)row * 1024 + col) = make_uint2(pack2(v.x, v.y), pack2(v.z, v.w));
              part += v.x * v.x + v.y * v.y + v.z * v.z + v.w * v.w;
            }
        }
        part += shx(part, 16); part += shx(part, 32);
        if (ok && fq == 0) sspo[(size_t)row * 16 + pn * 4 + wc] = part;
      }
  }
  if (splitmode) {
    gbar(p, smem);
    const int t = tid_opaque(), lane = t & 63;
    const int wv = vbid * 8 + (t >> 6);
    const float* px_ = p.in[0]; const float* ps_ = p.in[1];
    for (int rr = wv; rr < T - 16384; rr += 256 * 8) {
      const int row = 16384 + rr;
      const float* rsrc = RESID_ORIG ? (row < TP ? px_ + (size_t)(8192 + row - NTOKP - 16) * 1024 : ps_ + (size_t)(row - TP) * 1024) : (xf + (size_t)row * 1024);
      float ss = 0.f;
#pragma unroll
      for (int i = 0; i < 4; ++i) {
        const int col = (lane + 64 * i) * 4;
        float4 sum = make_float4(0.f, 0.f, 0.f, 0.f);
        for (int sl = 0; sl < nslice; ++sl) {
          const float4 q = *(const float4*)(part_buf + ((size_t)sl * 768 + rr) * 1024 + col);
          sum.x += q.x; sum.y += q.y; sum.z += q.z; sum.w += q.w;
        }
        const float4 xr = *(const float4*)(rsrc + col);
        float4 v;
        v.x = xr.x + factor * sum.x; v.y = xr.y + factor * sum.y; v.z = xr.z + factor * sum.z; v.w = xr.w + factor * sum.w;
        *(float4*)(xf + (size_t)row * 1024 + col) = v;
        *(uint2*)(xb + (size_t)row * 1024 + col) = make_uint2(pack2(v.x, v.y), pack2(v.z, v.w));
        ss += v.x * v.x + v.y * v.y + v.z * v.z + v.w * v.w;
      }
#pragma unroll
      for (int mm = 32; mm >= 1; mm >>= 1) ss += shx(ss, mm);
      if (lane < 16) sspo[(size_t)row * 16 + lane] = lane == 0 ? ss : 0.f;
    }
  }
}

template <int RESID_ORIG>
DI void phase_resid(const Params& p, char* smem, const u16* A, int lda, int K, size_t off_w, float factor, size_t off_ssp_out, int vbid) {
  const u16* B = (const u16*)(p.ws + off_w);
  float* xf = (float*)(p.ws + OFF_XF);
  u16* xb = (u16*)(p.ws + OFF_XB);
  float* sspo = (float*)(p.ws + off_ssp_out);
  G_DECL
  const int nr = gemm_rounds(8);
  int it = 0, m0 = 0, n0 = 0;
  while (it < nr && !gemm_tile(vbid, it, 8, m0, n0)) ++it;
  if (it < nr) G_ISSUE(A, lda, B, K, m0, n0, (const float*)nullptr)
  while (it < nr) {
    f32x16 acc[2][2]; zero_acc(acc);
    G_RUN(A, lda, B, K, K, m0, n0, (u16*)smem, acc, true)
    const int cm0 = m0, cn0 = n0; const int nt = cn0 >> 7;
    ++it;
    while (it < nr && !gemm_tile(vbid, it, 8, m0, n0)) ++it;
    if (it < nr) G_ISSUE(A, lda, B, K, m0, n0, (const float*)nullptr)
    const int t = tid_opaque(), lane = t & 63, w = t >> 6, wm = w >> 1, wn = w & 1, lr = lane & 31, lh = lane >> 5;
#pragma unroll
    for (int mi = 0; mi < 2; ++mi) {
      const int row = cm0 + wm * 64 + mi * 32 + lr;
      const bool ok = row < T;
      float part = 0.f;
      if (ok) {
        const float* rsrc = RESID_ORIG ? xrow_ptr(p, row) : (xf + (size_t)row * 1024);
#pragma unroll
        for (int ni = 0; ni < 2; ++ni)
#pragma unroll
          for (int g = 0; g < 4; ++g) {
            const int col = cn0 + wn * 64 + ni * 32 + 8 * g + 4 * lh;
            const float4 xr = *(const float4*)(rsrc + col);
            float4 v;
            v.x = xr.x + factor * acc[mi][ni][4 * g]; v.y = xr.y + factor * acc[mi][ni][4 * g + 1];
            v.z = xr.z + factor * acc[mi][ni][4 * g + 2]; v.w = xr.w + factor * acc[mi][ni][4 * g + 3];
            *(float4*)(xf + (size_t)row * 1024 + col) = v;
            *(uint2*)(xb + (size_t)row * 1024 + col) = make_uint2(pack2(v.x, v.y), pack2(v.z, v.w));
            part += v.x * v.x + v.y * v.y + v.z * v.z + v.w * v.w;
          }
      }
      part += shx(part, 32);
      if (ok && lh == 0) sspo[(size_t)row * 16 + nt * 2 + wn] = part;
    }
  }
}

DI void phase_win(const Params& p, char* smem, int vbid) {
  const u16* A = (const u16*)(p.ws + OFF_XB);
  const u16* B = (const u16*)(p.ws + OFF_WIN);
  const float* ssp = (const float*)(p.ws + OFF_SSP1);
  const float2* tab = (const float2*)(p.ws + OFF_TAB);
  u16* AQ = (u16*)(p.ws + OFF_AQ); u16* BQ = (u16*)(p.ws + OFF_BQ); u16* IQ = (u16*)(p.ws + OFF_IQ);
  float* IW = (float*)(p.ws + OFF_IW); u16* G = (u16*)(p.ws + OFF_G);
  float* out = p.out;
  float* rs_all = (float*)(smem + RS_OFF);
  G_DECL
  const int nr = gemm_rounds(69);
  int it = 0, m0n = 0, n0n = 0, par = 0;
  while (it < nr && !gemm_tile(vbid, it, 69, m0n, n0n)) ++it;
  while (it < nr) {
    float* rs_s = rs_all + par * 256; par ^= 1;
    load_rs(ssp, m0n, rs_s);
    G_ISSUE(A, 1024, B, 1024, m0n, n0n, (const float*)nullptr)
    f32x16 acc[2][2]; zero_acc(acc);
    const int vgw = __builtin_amdgcn_readfirstlane((n0n >> 6) + ((tid_opaque() >> 6) & 1));
    const bool swapw = !((vgw >= 32 && vgw < 48) || (vgw >= 80 && vgw < 96));
    if (swapw) G_RUN(A, 1024, B, 1024, 1024, m0n, n0n, (u16*)smem, acc, true)
    else G_RUN(A, 1024, B, 1024, 1024, m0n, n0n, (u16*)smem, acc, false)
    const int m0 = m0n, n0 = n0n;
    const int t = tid_opaque(), lane = t & 63, w = t >> 6, wm = w >> 1, wn = w & 1, lr = lane & 31, lh = lane >> 5;
    const int vg = vgw;
    if (!swapw) {
      const int q = vg < 48 ? vg - 32 : vg - 80;
      u16* vtb = (u16*)(p.ws + (vg < 48 ? OFF_AVT : OFF_BVT));
#pragma unroll
      for (int mi = 0; mi < 2; ++mi)
#pragma unroll
        for (int g = 0; g < 4; ++g) {
          const int rl = wm * 64 + mi * 32 + 8 * g + 4 * lh; const int row = m0 + rl;
          if (row < TP) {
            const int bb = row >= NTOKP ? 1 : 0; const int tok = row - bb * NTOKP;
            const float r0 = rs_s[rl], r1 = rs_s[rl + 1], r2 = rs_s[rl + 2], r3 = rs_s[rl + 3];
#pragma unroll
            for (int ni = 0; ni < 2; ++ni) {
              const int d = (q & 1) * 64 + ni * 32 + lr;
              u16* dst = vtb + ((size_t)(bb * 8 + (q >> 1)) * 128 + d) * VTPAD + tok;
              *(uint2*)dst = make_uint2(pack2(acc[mi][ni][4 * g] * r0, acc[mi][ni][4 * g + 1] * r1),
                                        pack2(acc[mi][ni][4 * g + 2] * r2, acc[mi][ni][4 * g + 3] * r3));
            }
          }
        }
#pragma unroll
      for (int mi = 0; mi < 2; ++mi)
#pragma unroll
        for (int i = 0; i < 16; ++i) {
          const int rl = wm * 64 + mi * 32 + crow(i, lh); const int row = m0 + rl;
          if (row >= T) continue;
          const float r = rs_s[rl];
          const float v0 = acc[mi][0][i] * r, v1 = acc[mi][1][i] * r;
          const bool smp = row >= TP;
          const int orow = smp ? row - TP : row;
          float* d = out + (vg < 48 ? (smp ? O_AVS : O_AVP) : (smp ? O_BVS : O_BVP)) + (size_t)orow * 1024 + q * 64 + lr;
          d[0] = v0; d[32] = v1;
        }
    } else {
#pragma unroll
      for (int mi = 0; mi < 2; ++mi) {
        int rl = wm * 64 + mi * 32 + lr;
        asm volatile("" : "+v"(rl));
        const int row = m0 + rl;
        if (row >= T) continue;
        const float r = rs_s[rl];
        const bool smp = row >= TP;
        const int orow = smp ? row - TP : row;
        const int bb = (!smp && row >= NTOKP) ? 1 : 0;
        const int tok = row - bb * NTOKP;
        const int pos = smp ? (NCACHE + (orow & 31)) : tok;
#pragma unroll
        for (int g = 0; g < 4; ++g) {
          const int c0 = 8 * g + 4 * lh;
          float v0[4], v1[4];
#pragma unroll
          for (int j = 0; j < 4; ++j) { v0[j] = acc[mi][0][4 * g + j] * r; v1[j] = acc[mi][1][4 * g + j] * r; }
          if (vg < 32 || (vg >= 96 && vg < 105)) {
            float o0[4], o1[4];
#pragma unroll
            for (int j = 0; j < 4; ++j) {
              const float2 cs = tab[pos * 64 + 2 * (c0 + j)];
              o0[j] = v0[j] * cs.x - v1[j] * cs.y; o1[j] = v1[j] * cs.x + v0[j] * cs.y;
            }
            if (vg < 16) {
              u16* d = AQ + (size_t)row * 1024 + vg * 64 + c0;
              *(uint2*)d = make_uint2(pack2(o0[0] * QA_SCALE, o0[1] * QA_SCALE), pack2(o0[2] * QA_SCALE, o0[3] * QA_SCALE));
              *(uint2*)(d + 32) = make_uint2(pack2(o1[0] * QA_SCALE, o1[1] * QA_SCALE), pack2(o1[2] * QA_SCALE, o1[3] * QA_SCALE));
            } else if (vg < 32) {
              float* d = out + (smp ? O_AKS : O_AKP) + (size_t)orow * 1024 + (vg - 16) * 64 + c0;
              *(float4*)d = make_float4(o0[0], o0[1], o0[2], o0[3]);
              *(float4*)(d + 32) = make_float4(o1[0], o1[1], o1[2], o1[3]);
              if (!smp) {
                const int q = vg - 16;
                u16* db = (u16*)(p.ws + OFF_AKB) + ((size_t)(bb * 8 + (q >> 1)) * NTOKP + tok) * 128 + (q & 1) * 64 + c0;
                *(uint2*)db = make_uint2(pack2(o0[0], o0[1]), pack2(o0[2], o0[3]));
                *(uint2*)(db + 32) = make_uint2(pack2(o1[0], o1[1]), pack2(o1[2], o1[3]));
              }
            } else if (vg < 104) {
              u16* d = IQ + (size_t)row * 512 + (vg - 96) * 64 + c0;
              *(uint2*)d = make_uint2(pack2(o0[0], o0[1]), pack2(o0[2], o0[3]));
              *(uint2*)(d + 32) = make_uint2(pack2(o1[0], o1[1]), pack2(o1[2], o1[3]));
            } else {
              float* d = out + (smp ? O_IKS : O_IKP) + (size_t)orow * 64 + c0;
              *(float4*)d = make_float4(o0[0], o0[1], o0[2], o0[3]);
              *(float4*)(d + 32) = make_float4(o1[0], o1[1], o1[2], o1[3]);
              if (!smp) {
                u16* db = (u16*)(p.ws + OFF_IKB) + (size_t)row * 64 + c0;
                *(uint2*)db = make_uint2(pack2(o0[0], o0[1]), pack2(o0[2], o0[3]));
                *(uint2*)(db + 32) = make_uint2(pack2(o1[0], o1[1]), pack2(o1[2], o1[3]));
              }
            }
          } else if (vg < 80) {
            const int q = vg < 64 ? vg - 48 : vg - 64; const int hh = q >> 1, gi = q & 1;
            float o0[4], o1[4];
            const float4* tp = (const float4*)(tab + pos * 64 + gi * 32 + c0);
            const float4 t01 = tp[0], t23 = tp[1];
            o0[0] = v0[0] * t01.x - v1[0] * t01.y; o1[0] = v1[0] * t01.x + v0[0] * t01.y;
            o0[1] = v0[1] * t01.z - v1[1] * t01.w; o1[1] = v1[1] * t01.z + v0[1] * t01.w;
            o0[2] = v0[2] * t23.x - v1[2] * t23.y; o1[2] = v1[2] * t23.x + v0[2] * t23.y;
            o0[3] = v0[3] * t23.z - v1[3] * t23.w; o1[3] = v1[3] * t23.z + v0[3] * t23.w;
            if (vg < 64) {
              u16* d = BQ + (size_t)row * 1024 + hh * 128 + gi * 32 + c0;
              *(uint2*)d = make_uint2(pack2(o0[0] * QB_SCALE, o0[1] * QB_SCALE), pack2(o0[2] * QB_SCALE, o0[3] * QB_SCALE));
              *(uint2*)(d + 64) = make_uint2(pack2(o1[0] * QB_SCALE, o1[1] * QB_SCALE), pack2(o1[2] * QB_SCALE, o1[3] * QB_SCALE));
            } else {
              float* d = out + (smp ? O_BKS : O_BKP) + (size_t)orow * 1024 + hh * 128 + gi * 32 + c0;
              *(float4*)d = make_float4(o0[0], o0[1], o0[2], o0[3]);
              *(float4*)(d + 64) = make_float4(o1[0], o1[1], o1[2], o1[3]);
              if (!smp) {
                u16* db = (u16*)(p.ws + OFF_BKB) + ((size_t)(bb * 8 + hh) * NTOKP + tok) * 128 + gi * 32 + c0;
                *(uint2*)db = make_uint2(pack2(o0[0], o0[1]), pack2(o0[2], o0[3]));
                *(uint2*)(db + 64) = make_uint2(pack2(o1[0], o1[1]), pack2(o1[2], o1[3]));
              }
            }
          } else if (vg == 105) {
            if (g == 0) *(float4*)(IW + (size_t)row * 8 + c0) = make_float4(v0[0] * IW_SCALE, v0[1] * IW_SCALE, v0[2] * IW_SCALE, v0[3] * IW_SCALE);
          } else {
            u16* d = G + (size_t)row * 2048 + (vg - 106) * 64 + c0;
            float s0[4], s1[4];
#pragma unroll
            for (int j = 0; j < 4; ++j) { s0[j] = 1.0f / (1.0f + __expf(-v0[j])); s1[j] = 1.0f / (1.0f + __expf(-v1[j])); }
            *(uint2*)d = make_uint2(pack2(s0[0], s0[1]), pack2(s0[2], s0[3]));
            *(uint2*)(d + 32) = make_uint2(pack2(s1[0], s1[1]), pack2(s1[2], s1[3]));
          }
          __builtin_amdgcn_sched_barrier(0);
        }
      }
    }
    ++it;
    while (it < nr && !gemm_tile(vbid, it, 69, m0n, n0n)) ++it;
  }
}

DI void phase_win8(const Params& p, char* smem, int vbid) {
  const u16* A = (const u16*)(p.ws + OFF_XB);
  const u16* B = (const u16*)(p.ws + OFF_WIN);
  const float* ssp = (const float*)(p.ws + OFF_SSP1);
  const float2* tab = (const float2*)(p.ws + OFF_TAB);
  u16* AQ = (u16*)(p.ws + OFF_AQ); u16* BQ = (u16*)(p.ws + OFF_BQ); u16* IQ = (u16*)(p.ws + OFF_IQ);
  float* IW = (float*)(p.ws + OFF_IW); u16* Gt = (u16*)(p.ws + OFF_G);
  float* out = p.out;
  float* rs_s = (float*)(smem + RS8_OFF);
  const int nr = gemm_rounds(35);
  for (int it = 0; it < nr; ++it) {
    int m0, n0;
    if (!gemm_tile(vbid, it, 35, m0, n0)) continue;
    n0 *= 2;
    load_rs(ssp, m0, rs_s);
    __syncthreads();
    f32x4 acc[2][2][4][2];
#pragma unroll
    for (int a_ = 0; a_ < 2; ++a_)
#pragma unroll
      for (int b_ = 0; b_ < 2; ++b_)
#pragma unroll
        for (int m_ = 0; m_ < 4; ++m_)
#pragma unroll
          for (int n_ = 0; n_ < 2; ++n_) acc[a_][b_][m_][n_] = (f32x4){0.f, 0.f, 0.f, 0.f};
    gemm8_tile(A, B, 1024, m0, n0, (u16*)smem, acc);
    const int t = tid_opaque(), lane = t & 63, wid = __builtin_amdgcn_readfirstlane(t >> 6), wr = wid >> 2, wc = wid & 3, fr = lane & 15, fq = lane >> 4;
    const int o = fq * 4;
#pragma unroll
    for (int bj = 0; bj < 2; ++bj) {
      const int G = (n0 >> 5) + bj * 4 + wc;
      if (G >= 275) continue;
#pragma unroll
      for (int ai = 0; ai < 2; ++ai)
#pragma unroll
        for (int m = 0; m < 4; ++m) {
          int rl = ai * 128 + wr * 64 + m * 16 + fr;
          asm volatile("" : "+v"(rl));
          const int row = m0 + rl;
          if (row >= T) continue;
          const float r = rs_s[rl];
          const bool smp = row >= TP;
          const int orow = smp ? row - TP : row;
          const int bb = (!smp && row >= NTOKP) ? 1 : 0;
          const int tok = row - bb * NTOKP;
          const int pos = smp ? (NCACHE + (orow & 31)) : tok;
          float v0[4], v1[4];
#pragma unroll
          for (int j = 0; j < 4; ++j) { v0[j] = acc[ai][bj][m][0][j] * r; v1[j] = acc[ai][bj][m][1][j] * r; }
          if (G < 64 || (G >= 192 && G < 210)) {
            const int q = G < 64 ? (G & 31) : (G < 208 ? G - 192 : G - 208);
            const int g = G < 208 ? (q & 1) : q;
            const int hd = G < 208 ? (q >> 1) : 0;
            const int d0 = 16 * g + o;
            float o0[4], o1[4];
#pragma unroll
            for (int j = 0; j < 4; ++j) {
              const float2 cs = tab[pos * 64 + 2 * (d0 + j)];
              o0[j] = v0[j] * cs.x - v1[j] * cs.y; o1[j] = v1[j] * cs.x + v0[j] * cs.y;
            }
            if (G < 32) {
              u16* d = AQ + (size_t)row * 1024 + hd * 64 + d0;
              *(uint2*)d = make_uint2(pack2(o0[0] * QA_SCALE, o0[1] * QA_SCALE), pack2(o0[2] * QA_SCALE, o0[3] * QA_SCALE));
              *(uint2*)(d + 32) = make_uint2(pack2(o1[0] * QA_SCALE, o1[1] * QA_SCALE), pack2(o1[2] * QA_SCALE, o1[3] * QA_SCALE));
            } else if (G < 64) {
              float* d = out + (smp ? O_AKS : O_AKP) + (size_t)orow * 1024 + hd * 64 + d0;
              *(float4*)d = make_float4(o0[0], o0[1], o0[2], o0[3]);
              *(float4*)(d + 32) = make_float4(o1[0], o1[1], o1[2], o1[3]);
              if (!smp) {
                u16* db = (u16*)(p.ws + OFF_AKB) + ((size_t)(bb * 8 + (hd >> 1)) * NTOKP + tok) * 128 + (hd & 1) * 64 + d0;
                *(uint2*)db = make_uint2(pack2(o0[0], o0[1]), pack2(o0[2], o0[3]));
                *(uint2*)(db + 32) = make_uint2(pack2(o1[0], o1[1]), pack2(o1[2], o1[3]));
              }
            } else if (G < 208) {
              u16* d = IQ + (size_t)row * 512 + hd * 64 + d0;
              *(uint2*)d = make_uint2(pack2(o0[0], o0[1]), pack2(o0[2], o0[3]));
              *(uint2*)(d + 32) = make_uint2(pack2(o1[0], o1[1]), pack2(o1[2], o1[3]));
            } else {
              float* d = out + (smp ? O_IKS : O_IKP) + (size_t)orow * 64 + d0;
              *(float4*)d = make_float4(o0[0], o0[1], o0[2], o0[3]);
              *(float4*)(d + 32) = make_float4(o1[0], o1[1], o1[2], o1[3]);
              if (!smp) {
                u16* db = (u16*)(p.ws + OFF_IKB) + (size_t)row * 64 + d0;
                *(uint2*)db = make_uint2(pack2(o0[0], o0[1]), pack2(o0[2], o0[3]));
                *(uint2*)(db + 32) = make_uint2(pack2(o1[0], o1[1]), pack2(o1[2], o1[3]));
              }
            }
          } else if (G >= 96 && G < 160) {
            const int q = (G - 96) & 31; const int hh = q >> 2, g = q & 3;
            const int d0 = 16 * g + o;
            const float4* tp = (const float4*)(tab + pos * 64 + d0);
            const float4 t01 = tp[0], t23 = tp[1];
            float o0[4], o1[4];
            o0[0] = v0[0] * t01.x - v1[0] * t01.y; o1[0] = v1[0] * t01.x + v0[0] * t01.y;
            o0[1] = v0[1] * t01.z - v1[1] * t01.w; o1[1] = v1[1] * t01.z + v0[1] * t01.w;
            o0[2] = v0[2] * t23.x - v1[2] * t23.y; o1[2] = v1[2] * t23.x + v0[2] * t23.y;
            o0[3] = v0[3] * t23.z - v1[3] * t23.w; o1[3] = v1[3] * t23.z + v0[3] * t23.w;
            if (G < 128) {
              u16* d = BQ + (size_t)row * 1024 + hh * 128 + d0;
              *(uint2*)d = make_uint2(pack2(o0[0] * QB_SCALE, o0[1] * QB_SCALE), pack2(o0[2] * QB_SCALE, o0[3] * QB_SCALE));
              *(uint2*)(d + 64) = make_uint2(pack2(o1[0] * QB_SCALE, o1[1] * QB_SCALE), pack2(o1[2] * QB_SCALE, o1[3] * QB_SCALE));
            } else {
              float* d = out + (smp ? O_BKS : O_BKP) + (size_t)orow * 1024 + hh * 128 + d0;
              *(float4*)d = make_float4(o0[0], o0[1], o0[2], o0[3]);
              *(float4*)(d + 64) = make_float4(o1[0], o1[1], o1[2], o1[3]);
              if (!smp) {
                u16* db = (u16*)(p.ws + OFF_BKB) + ((size_t)(bb * 8 + hh) * NTOKP + tok) * 128 + d0;
                *(uint2*)db = make_uint2(pack2(o0[0], o0[1]), pack2(o0[2], o0[3]));
                *(uint2*)(db + 64) = make_uint2(pack2(o1[0], o1[1]), pack2(o1[2], o1[3]));
              }
            }
          } else if (G < 192) {
            const bool isa = G < 96;
            const int c = (isa ? (G - 64) : (G - 160)) * 32 + o;
            float* d = out + (isa ? (smp ? O_AVS : O_AVP) : (smp ? O_BVS : O_BVP)) + (size_t)orow * 1024 + c;
            *(float4*)d = make_float4(v0[0], v0[1], v0[2], v0[3]);
            *(float4*)(d + 16) = make_float4(v1[0], v1[1], v1[2], v1[3]);
            if (!smp) {
              u16* vt = (u16*)(p.ws + (isa ? OFF_AVT : OFF_BVT)) + ((size_t)(bb * 8 + (c >> 7)) * 128 + (c & 127)) * VTPAD + tok;
#pragma unroll
              for (int j = 0; j < 4; ++j) { vt[(size_t)j * VTPAD] = f2bf(v0[j]); vt[(size_t)(16 + j) * VTPAD] = f2bf(v1[j]); }
            }
          } else if (G == 210) {
            if (fq < 2) *(float4*)(IW + (size_t)row * 8 + o) = make_float4(v0[0] * IW_SCALE, v0[1] * IW_SCALE, v0[2] * IW_SCALE, v0[3] * IW_SCALE);
          } else {
            u16* d = Gt + (size_t)row * 2048 + (G - 211) * 32 + o;
            float s0[4], s1[4];
#pragma unroll
            for (int j = 0; j < 4; ++j) { s0[j] = 1.0f / (1.0f + __expf(-v0[j])); s1[j] = 1.0f / (1.0f + __expf(-v1[j])); }
            *(uint2*)d = make_uint2(pack2(s0[0], s0[1]), pack2(s0[2], s0[3]));
            *(uint2*)(d + 16) = make_uint2(pack2(s1[0], s1[1]), pack2(s1[2], s1[3]));
          }
        }
    }
  }
}

DI void phase_merge(const Params& p, char* smem, int vbid) {
  const u16* OA = (const u16*)(p.ws + OFF_OA); const u16* OB = (const u16*)(p.ws + OFF_OB);
  const u16* WA = (const u16*)(p.ws + OFF_WA); const u16* WB = (const u16*)(p.ws + OFF_WB);
  const u16* G = (const u16*)(p.ws + OFF_G);
  u16* MB = (u16*)(p.ws + OFF_MB);
  G_DECL
  const int nr = gemm_rounds(8);
  int it = 0, m0n = 0, n0n = 0;
  while (it < nr && !gemm_tile(vbid, it, 8, m0n, n0n)) ++it;
  if (it < nr) G_ISSUE(OA, 1024, WA, 1024, m0n, n0n, (const float*)nullptr)
  while (it < nr) {
    const int m0 = m0n, n0 = n0n;
    f32x16 acc[2][2], acc2[2][2]; zero_acc(acc); zero_acc(acc2);
    G_RUN(OA, 1024, WA, 1024, 1024, m0, n0, (u16*)smem, acc, true)
    G_ISSUE(OB, 1024, WB, 1024, m0, n0, (const float*)nullptr)
    G_RUN(OB, 1024, WB, 1024, 1024, m0, n0, (u16*)smem, acc2, true)
    ++it;
    while (it < nr && !gemm_tile(vbid, it, 8, m0n, n0n)) ++it;
    if (it < nr) G_ISSUE(OA, 1024, WA, 1024, m0n, n0n, (const float*)nullptr)
    const int t = tid_opaque(), lane = t & 63, w = t >> 6, wm = w >> 1, wn = w & 1, lr = lane & 31, lh = lane >> 5;
#pragma unroll
    for (int mi = 0; mi < 2; ++mi) {
      const int row = m0 + wm * 64 + mi * 32 + lr;
      if (row >= T) continue;
#pragma unroll
      for (int ni = 0; ni < 2; ++ni)
#pragma unroll
        for (int g = 0; g < 4; ++g) {
          const int col = n0 + wn * 64 + ni * 32 + 8 * g + 4 * lh;
          const uint2 ga = *(const uint2*)(G + (size_t)row * 2048 + col);
          const uint2 gb = *(const uint2*)(G + (size_t)row * 2048 + 1024 + col);
          const float m0v = __uint_as_float(ga.x << 16) * acc[mi][ni][4 * g] + __uint_as_float(gb.x << 16) * acc2[mi][ni][4 * g];
          const float m1v = __uint_as_float(ga.x & 0xffff0000u) * acc[mi][ni][4 * g + 1] + __uint_as_float(gb.x & 0xffff0000u) * acc2[mi][ni][4 * g + 1];
          const float m2v = __uint_as_float(ga.y << 16) * acc[mi][ni][4 * g + 2] + __uint_as_float(gb.y << 16) * acc2[mi][ni][4 * g + 2];
          const float m3v = __uint_as_float(ga.y & 0xffff0000u) * acc[mi][ni][4 * g + 3] + __uint_as_float(gb.y & 0xffff0000u) * acc2[mi][ni][4 * g + 3];
          *(uint2*)(MB + (size_t)row * 1024 + col) = make_uint2(pack2(m0v, m1v), pack2(m2v, m3v));
        }
    }
  }
}

template <int MODE>
DI void attn_item(const Params& p, char* smem, int grp, int b, int h, int q0, int nqv, float lam) {
  int t_ = threadIdx.x;
  asm volatile("" : "+v"(t_));
  const int t = t_, lane = t & 63, w = __builtin_amdgcn_readfirstlane(t >> 6), lr = lane & 31, lh = lane >> 5;
  u16* Ks = (u16*)smem;
  u16* Vt = Ks + 64 * 136;
  u16* Qs = Vt + 128 * 72;
  constexpr int NQB = MODE == 0 ? 128 : 256;
  constexpr int KS = MODE == 0 ? 4 : 8;
  const int NK = grp ? NKS : NTOKP;
  const int qsub = MODE == 0 ? (w >> 1) : w;
  const int map = MODE == 0 ? (w & 1) : 0;
  const int qw0 = q0 + qsub * 32;
  const bool wact = (qsub * 32) < nqv;
  int Lw = 0;
  if (wact) Lw = grp ? NKS : (qw0 < 16 ? 16 : 16 + 64 * (((qw0 - 16) >> 6) + 1));
  const int tql = q0 + nqv - 1;
  const int Lblk = grp ? NKS : (tql < 16 ? 16 : 16 + 64 * (((tql - 16) >> 6) + 1));
  const int nkt = (Lblk + 63) >> 6;
  const int ql = qsub * 32 + lr;
  const int tq = q0 + (ql < nqv ? ql : nqv - 1);
  const size_t gr = grp ? (size_t)TP + b * 32 + tq : (size_t)b * NTOKP + tq;
  __syncthreads();
  bf16x8 qf[KS];
  {
    const u16* Qg = (const u16*)(p.ws + (MODE == 0 ? OFF_AQ : OFF_BQ)) + gr * 1024 + h * 128 + map * 64 + lh * 8;
#pragma unroll
    for (int ks = 0; ks < KS; ++ks) qf[ks] = *(const bf16x8*)(Qg + ks * 16);
  }
  const u64* mrow = nullptr;
  if (MODE == 1) mrow = grp ? (const u64*)(p.ws + OFF_MASKS) + ((size_t)b * 32 + tq) * NWS : (const u64*)(p.ws + OFF_MASKP) + gr * NWP;
  f32x16 O[4];
  float mrun = -1e30f, lrun = 0.f;
#pragma unroll
  for (int db = 0; db < 4; ++db)
#pragma unroll
    for (int i = 0; i < 16; ++i) O[db][i] = 0.f;
  const int kwhich = MODE == 0 ? 0 : 2;
  const u16* Kg = (const u16*)(p.ws + (MODE == 0 ? OFF_AKB : OFF_BKB)) + (size_t)(b * 8 + h) * NTOKP * 128 + (t & 15) * 8;
  const u16* Vg = (const u16*)(p.ws + (MODE == 0 ? OFF_AVT : OFF_BVT)) + ((size_t)(b * 8 + h) * 128 + (t >> 3)) * VTPAD + (t & 7) * 8;
  const int kkey = t >> 4;
  uint4 sa0, sa1, sa2, sa3, sb0, sb1, sb2, sb3, sc0, sc1, sc2, sc3;
  u64 ma = 0, mb = 0, mc = 0;
  sa0 = sa1 = sa2 = sa3 = sb0 = sb1 = sb2 = sb3 = sc0 = sc1 = sc2 = sc3 = make_uint4(0, 0, 0, 0);
  auto issue = [&](int kt, uint4& r0, uint4& r1, uint4& r2, uint4& r3, u64& mwr) {
    if (!grp && kt < nkt) {
      int k0 = kt * 64 + kkey, k1 = k0 + 32;
      k0 = k0 < NTOKP ? k0 : NTOKP - 1; k1 = k1 < NTOKP ? k1 : NTOKP - 1;
      r0 = *(const uint4*)(Kg + (size_t)k0 * 128); r1 = *(const uint4*)(Kg + (size_t)k1 * 128);
      const u16* vp = Vg + kt * 64;
      r2 = *(const uint4*)(vp); r3 = *(const uint4*)(vp + (size_t)64 * VTPAD);
    }
    if (MODE == 1 && kt < nkt) mwr = mrow[kt];
  };
  constexpr int ATT_BUF = 64 * 136 + 128 * 72;
  auto fill = [&](int kt, uint4& r0, uint4& r1, uint4& r2, uint4& r3) {
    u16* Ks = (u16*)smem + (kt & 1) * ATT_BUF; u16* Vt = Ks + 64 * 136;
    if (!grp) {
      *(uint4*)(Ks + kkey * 136 + (t & 15) * 8) = r0; *(uint4*)(Ks + (kkey + 32) * 136 + (t & 15) * 8) = r1;
      *(uint4*)(Vt + (t >> 3) * 72 + (t & 7) * 8) = r2; *(uint4*)(Vt + ((t >> 3) + 64) * 72 + (t & 7) * 8) = r3;
    } else {
#pragma unroll
      for (int i = 0; i < 4; ++i) {
        const int c = t + NTHR * i; const int key = c >> 5, d4 = c & 31;
        int tk = kt * 64 + key; tk = tk < NK ? tk : NK - 1;
        const float4 v = *(const float4*)(kv_row(p, grp, b, tk, kwhich) + h * 128 + d4 * 4);
        *(uint2*)(Ks + key * 136 + d4 * 4) = make_uint2(pack2(v.x, v.y), pack2(v.z, v.w));
      }
      {
        const int kq = t >> 5, d4 = t & 31;
        float4 x[4];
#pragma unroll
        for (int j = 0; j < 4; ++j) {
          int tk = kt * 64 + kq * 4 + j; tk = tk < NK ? tk : NK - 1;
          x[j] = *(const float4*)(kv_row(p, grp, b, tk, kwhich + 1) + h * 128 + d4 * 4);
        }
        u16* vd = Vt + (d4 * 4) * 72 + kq * 4;
        *(uint2*)(vd) = make_uint2(pack2(x[0].x, x[1].x), pack2(x[2].x, x[3].x));
        *(uint2*)(vd + 72) = make_uint2(pack2(x[0].y, x[1].y), pack2(x[2].y, x[3].y));
        *(uint2*)(vd + 144) = make_uint2(pack2(x[0].z, x[1].z), pack2(x[2].z, x[3].z));
        *(uint2*)(vd + 216) = make_uint2(pack2(x[0].w, x[1].w), pack2(x[2].w, x[3].w));
      }
    }
  };
  auto step = [&](int kt, uint4& r0, uint4& r1, uint4& r2, uint4& r3, u64& mwr, uint4& n0, uint4& n1, uint4& n2, uint4& n3) {
    const u64 mw = mwr;
    u16* Ks = (u16*)smem + (kt & 1) * ATT_BUF; u16* Vt = Ks + 64 * 136;
    if (kt + 1 < nkt) fill(kt + 1, n0, n1, n2, n3);
    issue(kt + 3, r0, r1, r2, r3, mwr);
    if (wact && kt * 64 < Lw) {
      f32x16 st0, st1;
#pragma unroll
      for (int i = 0; i < 16; ++i) { st0[i] = 0.f; st1[i] = 0.f; }
#pragma unroll
      for (int ks = 0; ks < KS; ++ks) {
        const bf16x8 k0 = *(const bf16x8*)(Ks + lr * 136 + map * 64 + ks * 16 + lh * 8);
        const bf16x8 k1 = *(const bf16x8*)(Ks + (32 + lr) * 136 + map * 64 + ks * 16 + lh * 8);
        st0 = MFMA(k0, qf[ks], st0);
        st1 = MFMA(k1, qf[ks], st1);
      }
      if (MODE == 0) {
        if (kt * 64 + 64 > Lw) {
#pragma unroll
          for (int i = 0; i < 16; ++i) {
            const int key = kt * 64 + crow(i, lh);
            if (key >= Lw) st0[i] = -INFINITY;
            if (key + 32 >= Lw) st1[i] = -INFINITY;
          }
        }
      } else {
        const unsigned lo = (unsigned)mw >> (4 * lh), hi = (unsigned)(mw >> 32) >> (4 * lh);
#pragma unroll
        for (int i = 0; i < 16; ++i) {
          const int bit = (i & 3) + 8 * (i >> 2);
          if (!((lo >> bit) & 1u)) st0[i] = -INFINITY;
          if (!((hi >> bit) & 1u)) st1[i] = -INFINITY;
        }
      }
      float tm0 = __builtin_fmaxf(__builtin_fmaxf(st0[0], st0[1]), st0[2]), tm1 = __builtin_fmaxf(__builtin_fmaxf(st0[8], st0[9]), st0[10]);
      float tm2 = __builtin_fmaxf(__builtin_fmaxf(st1[0], st1[1]), st1[2]), tm3 = __builtin_fmaxf(__builtin_fmaxf(st1[8], st1[9]), st1[10]);
      tm0 = __builtin_fmaxf(__builtin_fmaxf(tm0, st0[3]), st0[4]); tm1 = __builtin_fmaxf(__builtin_fmaxf(tm1, st0[11]), st0[12]);
      tm2 = __builtin_fmaxf(__builtin_fmaxf(tm2, st1[3]), st1[4]); tm3 = __builtin_fmaxf(__builtin_fmaxf(tm3, st1[11]), st1[12]);
      tm0 = __builtin_fmaxf(__builtin_fmaxf(tm0, st0[5]), st0[6]); tm1 = __builtin_fmaxf(__builtin_fmaxf(tm1, st0[13]), st0[14]);
      tm2 = __builtin_fmaxf(__builtin_fmaxf(tm2, st1[5]), st1[6]); tm3 = __builtin_fmaxf(__builtin_fmaxf(tm3, st1[13]), st1[14]);
      tm0 = __builtin_fmaxf(__builtin_fmaxf(tm0, st0[7]), st0[15]); tm2 = __builtin_fmaxf(__builtin_fmaxf(tm2, st1[7]), st1[15]);
      float tmax = __builtin_fmaxf(__builtin_fmaxf(tm0, tm1), __builtin_fmaxf(tm2, tm3));
      tmax = fmaxf(tmax, shx(tmax, 32));
      const float mnew = fmaxf(mrun, tmax);
      const float alpha = fexp2(mrun - mnew);
      mrun = mnew;
      typedef float f32x2p __attribute__((ext_vector_type(2)));
      const f32x2p mneg = {-mnew, -mnew};
      f32x2p psv = {0.f, 0.f};
#pragma unroll
      for (int i = 0; i < 16; i += 2) {
        f32x2p a = {st0[i], st0[i + 1]}, b = {st1[i], st1[i + 1]};
        a += mneg; b += mneg;
        a.x = fexp2(a.x); a.y = fexp2(a.y); b.x = fexp2(b.x); b.y = fexp2(b.y);
        st0[i] = a.x; st0[i + 1] = a.y; st1[i] = b.x; st1[i + 1] = b.y;
        psv += a; psv += b;
      }
      const float ps = psv.x + psv.y;
      lrun = lrun * alpha + ps;
      if (__any(alpha != 1.0f)) {
#pragma unroll
        for (int db = 0; db < 4; ++db)
#pragma unroll
          for (int i = 0; i < 16; ++i) O[db][i] *= alpha;
      }
      bf16x8 pf[4];
#pragma unroll
      for (int c = 0; c < 4; ++c) {
        const unsigned u0 = (c < 2) ? pack2(st0[(c & 1) * 8 + 0], st0[(c & 1) * 8 + 1]) : pack2(st1[(c & 1) * 8 + 0], st1[(c & 1) * 8 + 1]);
        const unsigned u1 = (c < 2) ? pack2(st0[(c & 1) * 8 + 2], st0[(c & 1) * 8 + 3]) : pack2(st1[(c & 1) * 8 + 2], st1[(c & 1) * 8 + 3]);
        const unsigned u2 = (c < 2) ? pack2(st0[(c & 1) * 8 + 4], st0[(c & 1) * 8 + 5]) : pack2(st1[(c & 1) * 8 + 4], st1[(c & 1) * 8 + 5]);
        const unsigned u3 = (c < 2) ? pack2(st0[(c & 1) * 8 + 6], st0[(c & 1) * 8 + 7]) : pack2(st1[(c & 1) * 8 + 6], st1[(c & 1) * 8 + 7]);
        pf[c] = __builtin_bit_cast(bf16x8, make_uint4(u0, u1, u2, u3));
      }
#pragma unroll
      for (int db = 0; db < 4; ++db)
#pragma unroll
        for (int c = 0; c < 4; ++c) {
          const int kk = (c >> 1) * 32 + (c & 1) * 16 + 4 * lh;
          const bf16x4 v0 = *(const bf16x4*)(Vt + (db * 32 + lr) * 72 + kk);
          const bf16x4 v1 = *(const bf16x4*)(Vt + (db * 32 + lr) * 72 + kk + 8);
          const bf16x8 vf = __builtin_shufflevector(v0, v1, 0, 1, 2, 3, 4, 5, 6, 7);
          O[db] = MFMA(vf, pf[c], O[db]);
        }
    }
    __syncthreads();
  };
  issue(0, sa0, sa1, sa2, sa3, ma);
  issue(1, sb0, sb1, sb2, sb3, mb);
  issue(2, sc0, sc1, sc2, sc3, mc);
  fill(0, sa0, sa1, sa2, sa3);
  __syncthreads();
  for (int kt = 0; kt < nkt; kt += 3) {
    step(kt, sa0, sa1, sa2, sa3, ma, sb0, sb1, sb2, sb3);
    if (kt + 1 < nkt) step(kt + 1, sb0, sb1, sb2, sb3, mb, sc0, sc1, sc2, sc3);
    if (kt + 2 < nkt) step(kt + 2, sc0, sc1, sc2, sc3, mc, sa0, sa1, sa2, sa3);
  }
  const float ltot = lrun + shx(lrun, 32);
  const float inv = 1.0f / ltot;
  const bool qok = ql < nqv;
  if (MODE == 0) {
    float* Ex = (float*)smem;
    __syncthreads();
    if (map == 1) {
      const float sc = inv * lam;
#pragma unroll
      for (int db = 0; db < 4; ++db)
#pragma unroll
        for (int i = 0; i < 16; ++i) Ex[(qsub * 128 + db * 32 + crow(i, lh)) * 33 + lr] = O[db][i] * sc;
    }
    __syncthreads();
    if (map == 0) {
      float ss = 0.f;
#pragma unroll
      for (int db = 0; db < 4; ++db)
#pragma unroll
        for (int i = 0; i < 16; ++i) {
          const float v = O[db][i] * inv - Ex[(qsub * 128 + db * 32 + crow(i, lh)) * 33 + lr];
          O[db][i] = v; ss += v * v;
        }
      ss += shx(ss, 32);
      const float rn = rsqrtf(ss * (1.0f / 128.0f) + EPS) * 0.8f;
      const float* sub = p.in[18];
      u16* dst = (u16*)(p.ws + OFF_OA) + gr * 1024 + h * 128;
      if (wact && qok) {
#pragma unroll
        for (int db = 0; db < 4; ++db)
#pragma unroll
          for (int g = 0; g < 4; ++g) {
            const int d = db * 32 + 8 * g + 4 * lh;
            const float4 sg = *(const float4*)(sub + d);
            *(uint2*)(dst + d) = make_uint2(pack2(O[db][4 * g] * rn * sg.x, O[db][4 * g + 1] * rn * sg.y),
                                            pack2(O[db][4 * g + 2] * rn * sg.z, O[db][4 * g + 3] * rn * sg.w));
          }
      }
    }
  } else {
    u16* dst = (u16*)(p.ws + OFF_OB) + gr * 1024 + h * 128;
    if (wact && qok) {
#pragma unroll
      for (int db = 0; db < 4; ++db)
#pragma unroll
        for (int g = 0; g < 4; ++g) {
          const int d = db * 32 + 8 * g + 4 * lh;
          *(uint2*)(dst + d) = make_uint2(pack2(O[db][4 * g] * inv, O[db][4 * g + 1] * inv),
                                          pack2(O[db][4 * g + 2] * inv, O[db][4 * g + 3] * inv));
        }
    }
  }
}

DI unsigned ford(float f) { unsigned u = __float_as_uint(f); return u ^ ((u >> 31) ? 0xFFFFFFFFu : 0x80000000u); }

DI void idx_item(const Params& p, char* smem, int grp, int b, int pidx) {
  int t_ = threadIdx.x;
  asm volatile("" : "+v"(t_));
  const int t = t_, lane = t & 63, w = __builtin_amdgcn_readfirstlane(t >> 6), lr = lane & 31, lh = lane >> 5;
  u16* IQs = (u16*)smem;
  u16* IKs = IQs + 128 * 520;
  float* IWs = (float*)(smem + 133120 + 9216);
  float* SCb = (float*)(p.ws + OFF_SC);
  const int half = w >> 2;
  int q0h[2], nqh[2], Lh[2];
  if (!grp) {
    if (pidx == 0) { q0h[0] = 0; nqh[0] = 16; Lh[0] = 16; q0h[1] = 0; nqh[1] = 0; Lh[1] = 0; }
    else {
      const int c0 = 2 * (pidx - 1);
      q0h[0] = 16 + 64 * c0; nqh[0] = 64; Lh[0] = 80 + 64 * c0;
      q0h[1] = 80 + 64 * c0; nqh[1] = 64; Lh[1] = 144 + 64 * c0;
    }
  } else { q0h[0] = 0; nqh[0] = 32; Lh[0] = NKS; q0h[1] = 0; nqh[1] = 0; Lh[1] = 0; }
  const int NK = grp ? NKS : NTOKP;
  const int q0 = half ? q0h[1] : q0h[0], nqv = half ? nqh[1] : nqh[0], L = half ? Lh[1] : Lh[0];
  int Lpad; float* SC;
  if (!grp) {
    if (pidx == 0) { Lpad = 64; SC = SCb + SC_META + (size_t)b * 4096; }
    else { const int c = 2 * (pidx - 1) + half; Lpad = 64 * (c + 2); SC = SCb + (size_t)b * SC_BSTRIDE + 4096ull * (size_t)(c * (c + 3) / 2); }
  } else { Lpad = 2112; SC = SCb + SC_SAMP + (size_t)b * 64 * 2112; }
  const int nkt = (L + 63) >> 6;
  const int Lmax = Lh[1] > Lh[0] ? Lh[1] : Lh[0];
  const int nkt_blk = (Lmax + 63) >> 6;
  const u16* IQg = (const u16*)(p.ws + OFF_IQ);
  const float* IWg = (const float*)(p.ws + OFF_IW);
  __syncthreads();
#pragma unroll 4
  for (int i = 0; i < 16; ++i) {
    const int c = t + NTHR * i; const int q = c >> 6, ch = c & 63;
    const int hh = q >> 6, qq = q & 63;
    const int hq0 = hh ? q0h[1] : q0h[0], hn = hh ? nqh[1] : nqh[0];
    const int tq = hn > 0 ? hq0 + (qq < hn ? qq : hn - 1) : q0h[0];
    const size_t gr = grp ? (size_t)TP + b * 32 + tq : (size_t)b * NTOKP + tq;
    *(uint4*)(IQs + q * 520 + ch * 8) = *(const uint4*)(IQg + gr * 512 + ch * 8);
  }
#pragma unroll
  for (int i = 0; i < 2; ++i) {
    const int e = t + NTHR * i; const int q = e >> 3, hd = e & 7;
    const int hh = q >> 6, qq = q & 63;
    const int hq0 = hh ? q0h[1] : q0h[0], hn = hh ? nqh[1] : nqh[0];
    const int tq = hn > 0 ? hq0 + (qq < hn ? qq : hn - 1) : q0h[0];
    const size_t gr = grp ? (size_t)TP + b * 32 + tq : (size_t)b * NTOKP + tq;
    IWs[e] = IWg[gr * 8 + hd];
  }
  const int wq = w >> 1, wk = w & 1;
  const u16* IKg = (const u16*)(p.ws + OFF_IKB) + (size_t)b * NTOKP * 64 + (t & 7) * 8;
  const int ikey = t >> 3;
  uint4 ri0 = make_uint4(0, 0, 0, 0);
  if (!grp) {
    int k0 = ikey; k0 = k0 < NTOKP ? k0 : NTOKP - 1;
    ri0 = *(const uint4*)(IKg + (size_t)k0 * 64);
  }
  for (int kt = 0; kt < nkt_blk; ++kt) {
    __syncthreads();
    if (!grp) {
      *(uint4*)(IKs + ikey * 72 + (t & 7) * 8) = ri0;
    } else {
#pragma unroll
      for (int i = 0; i < 2; ++i) {
        const int c = t + NTHR * i; const int key = c >> 4, d4 = c & 15;
        int tk = kt * 64 + key; tk = tk < NK ? tk : NK - 1;
        const float4 v = *(const float4*)(ik_row(p, grp, b, tk) + d4 * 4);
        *(uint2*)(IKs + key * 72 + d4 * 4) = make_uint2(pack2(v.x, v.y), pack2(v.z, v.w));
      }
    }
    __syncthreads();
    if (!grp && kt + 1 < nkt_blk) {
      int k0 = (kt + 1) * 64 + ikey; k0 = k0 < NTOKP ? k0 : NTOKP - 1;
      ri0 = *(const uint4*)(IKg + (size_t)k0 * 64);
    }
    if (kt < nkt) {
      bf16x8 kf[4];
#pragma unroll
      for (int ks = 0; ks < 4; ++ks) kf[ks] = *(const bf16x8*)(IKs + (wk * 32 + lr) * 72 + ks * 16 + lh * 8);
      float sc[16];
#pragma unroll
      for (int i = 0; i < 16; ++i) sc[i] = 0.f;
#pragma unroll
      for (int hd = 0; hd < 8; ++hd) {
        f32x16 st;
#pragma unroll
        for (int i = 0; i < 16; ++i) st[i] = 0.f;
#pragma unroll
        for (int ks = 0; ks < 4; ++ks) {
          const bf16x8 qfr = *(const bf16x8*)(IQs + (wq * 32 + lr) * 520 + hd * 64 + ks * 16 + lh * 8);
          st = MFMA(kf[ks], qfr, st);
        }
        const float wv = IWs[(wq * 32 + lr) * 8 + hd];
#pragma unroll
        for (int i = 0; i < 16; ++i) sc[i] += wv * fmaxf(st[i], 0.f);
      }
      float* srow = SC + (size_t)((wq & 1) * 32 + lr) * Lpad + kt * 64 + wk * 32 + 4 * lh;
#pragma unroll
      for (int g = 0; g < 4; ++g) *(float4*)(srow + 8 * g) = make_float4(sc[4 * g], sc[4 * g + 1], sc[4 * g + 2], sc[4 * g + 3]);
    }
  }
  __threadfence();
  __syncthreads();
  for (int j = 0; j < 16; ++j) {
    const int q = (w & 3) * 16 + j;
    if (q >= nqv) break;
    const int tq = q0 + q;
    u64* mrow = grp ? (u64*)(p.ws + OFF_MASKS) + ((size_t)b * 32 + tq) * NWS : (u64*)(p.ws + OFF_MASKP) + ((size_t)b * NTOKP + tq) * NWP;
    if (L <= 256) {
      for (int i = 0; i < nkt; ++i) {
        const u64 wd = __ballot(i * 64 + lane < L);
        if (lane == 0) mrow[i] = wd;
      }
      continue;
    }
    const unsigned* srow = (const unsigned*)(SC + (size_t)q * Lpad);
    int Lr = L;
    asm volatile("" : "+v"(Lr));
    int nkr = __builtin_amdgcn_readfirstlane(nkt);
    asm volatile("" : "+s"(nkr));
    int lanev = lane;
    asm volatile("" : "+v"(lanev));
    unsigned v[129];
#pragma unroll
    for (int g = 0; g < 17; ++g) {
      if (g * 8 < nkt) {
#pragma unroll
        for (int jj = 0; jj < 8; ++jj) {
          const int i = g * 8 + jj; if (i >= 129) continue;
          v[i] = __hip_atomic_load(srow + i * 64 + lanev, __ATOMIC_RELAXED, __HIP_MEMORY_SCOPE_AGENT);
        }
      } else {
#pragma unroll
        for (int jj = 0; jj < 8; ++jj) if (g * 8 + jj < 129) v[g * 8 + jj] = 0u;
      }
    }
#pragma unroll
    for (int g = 0; g < 17; ++g) {
      if (g * 8 < nkt) {
#pragma unroll
        for (int jj = 0; jj < 8; ++jj) {
          const int i = g * 8 + jj; if (i >= 129) continue; const int key = i * 64 + lanev;
          const unsigned u = ford(__uint_as_float(v[i]));
          v[i] = key < Lr ? u : 0u;
        }
        __builtin_amdgcn_sched_barrier(0);
      }
    }
    unsigned Tt = 0u;
    for (int bit = 31; bit >= 0; --bit) {
      const unsigned cand = Tt | (1u << bit);
      int cnt = 0;
#pragma unroll
      for (int g = 0; g < 17; ++g) {
        if (g * 8 < nkt) {
#pragma unroll
          for (int jj = 0; jj < 8; ++jj) if (g * 8 + jj < 129) cnt += (v[g * 8 + jj] >= cand) ? 1 : 0;
          __builtin_amdgcn_sched_barrier(0);
        }
      }
#pragma unroll
      for (int m = 32; m >= 1; m >>= 1) cnt += __shfl_xor(cnt, m, 64);
      if (cnt >= 256) Tt = cand;
    }
    int cgt = 0;
#pragma unroll
    for (int g = 0; g < 17; ++g) {
      if (g * 8 < nkt) {
#pragma unroll
        for (int jj = 0; jj < 8; ++jj) if (g * 8 + jj < 129) cgt += (v[g * 8 + jj] > Tt) ? 1 : 0;
        __builtin_amdgcn_sched_barrier(0);
      }
    }
#pragma unroll
    for (int m = 32; m >= 1; m >>= 1) cgt += __shfl_xor(cgt, m, 64);
    const int need = 256 - cgt;
    int run = 0;
    const u64 lmask = (1ull << lane) - 1ull;
#pragma unroll
    for (int g = 0; g < 17; ++g) {
      if (g * 8 < nkt) {
#pragma unroll
        for (int jj = 0; jj < 8; ++jj) {
          const int i = g * 8 + jj; if (i >= 129) continue;
          const bool eq = v[i] == Tt;
          const u64 em = __ballot(eq);
          const int pre = run + __popcll(em & lmask);
          const bool sel = (v[i] > Tt) || (eq && pre < need);
          run += __popcll(em);
          const u64 wd = __ballot(sel);
          if (i < nkr) { if (lane == 0) mrow[i] = wd; }
          __builtin_amdgcn_sched_barrier(0);
        }
      }
    }
  }
}

DI unsigned xcc_id() { return (unsigned)__builtin_amdgcn_s_getreg((3 << 11) | 20) & 7u; }

DI int next_item(unsigned* cnt, int* s_item, int qlen, int& q, int& tries) {
  __syncthreads();
  if (threadIdx.x == 0) {
    int r = -1;
    while (tries < 8) {
      const int j = (int)atomicAdd(cnt + q, 1u);
      if (j < qlen) { r = (q << 16) | j; break; }
      q = (q + 1) & 7; ++tries;
    }
    s_item[0] = r; s_item[1] = q; s_item[2] = tries;
  }
  __syncthreads();
  q = __builtin_amdgcn_readfirstlane(s_item[1]);
  tries = __builtin_amdgcn_readfirstlane(s_item[2]);
  return __builtin_amdgcn_readfirstlane(s_item[0]);
}

DI void phase_attn_a(const Params& p, char* smem, int cbase = 0) {
  unsigned* cnt = (unsigned*)(p.ws + OFF_CNT) + cbase;
  int* s_item = (int*)(smem + SMEM_ITEM);
  float lam;
  {
    const int lane = threadIdx.x & 63;
    float a = p.in[14][lane] * p.in[15][lane], c = p.in[16][lane] * p.in[17][lane];
#pragma unroll
    for (int m = 32; m >= 1; m >>= 1) { a += shx(a, m); c += shx(c, m); }
    lam = expf(a) - expf(c) + 0.2f;
  }
  int q = (int)xcc_id(), tries = 0;
  while (true) {
    const int it = next_item(cnt, s_item, 165, q, tries);
    if (it < 0) break;
    const int x = it >> 16, j = it & 0xffff;
#ifndef NO_IDX
    if (j < 17) {
      const int k = j * 8 + x;
      if (k < 130) idx_item(p, smem, 0, k & 1, 64 - (k >> 1));
    } else if (j < 19) {
      idx_item(p, smem, 1, 2 * x + (j - 17), 0);
    } else
#else
    if (j < 19) {} else
#endif
    if (j < 35) {
      const int jj = j - 19;
      attn_item<0>(p, smem, 1, 2 * x + (jj >> 3), jj & 7, 0, 32, lam);
    } else {
      const int jj = j - 35; const int bh = 2 * x + jj / 65, qt = 64 - jj % 65;
      attn_item<0>(p, smem, 0, bh >> 3, bh & 7, qt == 0 ? 0 : 16 + (qt - 1) * 128, qt == 0 ? 16 : 128, lam);
    }
  }
}

DI void phase_attn_b(const Params& p, char* smem, int cbase = 8) {
  unsigned* cnt = (unsigned*)(p.ws + OFF_CNT) + cbase;
  int* s_item = (int*)(smem + SMEM_ITEM);
  int q = (int)xcc_id(), tries = 0;
  while (true) {
    const int it = next_item(cnt, s_item, 82, q, tries);
    if (it < 0) break;
    const int x = it >> 16, j = it & 0xffff;
    if (j < 16) {
      attn_item<1>(p, smem, 1, 2 * x + (j >> 3), j & 7, 0, 32, 0.f);
    } else {
      const int jj = j - 16; const int bh = 2 * x + jj / 33, qt = 32 - jj % 33;
      attn_item<1>(p, smem, 0, bh >> 3, bh & 7, qt == 0 ? 0 : 16 + (qt - 1) * 256, qt == 0 ? 16 : 256, 0.f);
    }
  }
}

DI void phase_final(const Params& p) {
  const int t = tid_opaque(), lane = t & 63;
  const int wv = blockIdx.x * 8 + (t >> 6), nw = gridDim.x * 8;
  const float* xf = (const float*)(p.ws + OFF_XF);
  const float* ssp = (const float*)(p.ws + OFF_SSP3);
  const float4* gf = (const float4*)p.in[26];
  for (int row = wv; row < T; row += nw) {
    float* dst;
    if (row < TP) {
      const int b = row >= NTOKP ? 1 : 0; const int tok = row - b * NTOKP;
      if (tok < 16) continue;
      dst = p.out + O_YP + ((size_t)b * 8192 + (tok - 16)) * 1024;
    } else dst = p.out + O_YS + (size_t)(row - TP) * 1024;
    float s = 0.f;
#pragma unroll
    for (int i = 0; i < 16; ++i) s += ssp[(size_t)row * 16 + i];
    const float r = rsqrtf(s * (1.0f / 1024.0f) + EPS);
#pragma unroll
    for (int i = 0; i < 4; ++i) {
      const float4 v = ((const float4*)(xf + (size_t)row * 1024))[lane + 64 * i];
      const float4 g = gf[lane + 64 * i];
      ((float4*)dst)[lane + 64 * i] = make_float4(v.x * r * g.x, v.y * r * g.y, v.z * r * g.z, v.w * r * g.w);
    }
  }
}

#ifndef PHM
#define PHM 0x7ff
#endif
#define PHON(n) ((PHM >> n) & 1)
__global__ void __launch_bounds__(512, 2) mega(Params p) {
  extern __shared__ __attribute__((aligned(16))) char smem[];
  cg::grid_group grid = cg::this_grid();
  volatile LAS unsigned* xst = (volatile LAS unsigned*)(smem + SMEM_ITEM + 48);
  if (threadIdx.x == 0) { xst[0] = 0u; xst[1] = 0u; }
  __syncthreads();
  (void)xcd_barrier_post((unsigned*)(p.ws + OFF_XBAR), xst);
  int* sv = (int*)(smem + SMEM_ITEM) + 8;
  if (threadIdx.x == 0) {
    const unsigned x = xcc_id();
    sv[0] = (int)x;
    sv[1] = (int)atomicAdd((unsigned*)(p.ws + OFF_CNT) + 48 + x, 1u);
  }
  if (PHON(0)) phase_prep(p, smem);
  grid.sync();
  int vbid;
  {
    if (threadIdx.x == 0) {
      const int x = sv[0], r = sv[1];
      int v = -1;
      if (gridDim.x == 256) {
        unsigned cntx[8];
#pragma unroll
        for (int i = 0; i < 8; ++i) cntx[i] = __hip_atomic_load((unsigned*)(p.ws + OFF_CNT) + 48 + i, __ATOMIC_RELAXED, __HIP_MEMORY_SCOPE_AGENT);
        if (r < 32) v = r * 8 + x;
        else {
          int k = r - 32;
#pragma unroll
          for (int i = 0; i < 8; ++i) if (i < x && cntx[i] > 32u) k += (int)cntx[i] - 32;
#pragma unroll
          for (int i = 0; i < 8; ++i) {
            const int freei = cntx[i] < 32u ? 32 - (int)cntx[i] : 0;
            if (v < 0) { if (k < freei) v = ((int)cntx[i] + k) * 8 + i; else k -= freei; }
          }
        }
      }
      sv[2] = v;
    }
    __syncthreads();
    vbid = __builtin_amdgcn_readfirstlane(sv[2]);
    if (vbid < 0) vbid = blockIdx.x;
  }
  if (PHON(1)) phase_gateup(p, smem, OFF_SSP0, OFF_WGU1, vbid);
  gbar(p, smem);
#ifdef DUP_GEMM
  phase_gateup(p, smem, OFF_SSP0, OFF_WGU1, vbid);
  gbar(p, smem);
#endif
  if (PHON(2)) phase_resid8<1>(p, smem, (const u16*)(p.ws + OFF_HID), 2816, OFF_WD1, 0.5f, OFF_SSP1, vbid);
  gbar(p, smem);
#ifdef DUP_G2
  phase_resid<1>(p, smem, (const u16*)(p.ws + OFF_HID), 2816, 2816, OFF_WD1, 0.5f, OFF_SSP1, vbid);
  gbar(p, smem);
#endif
  if (PHON(3)) phase_win8(p, smem, vbid);
  gbar(p, smem);
#ifdef DUP_GEMM
  phase_win8(p, smem, vbid);
  gbar(p, smem);
#endif
  if (PHON(4)) phase_attn_a(p, smem);
  gbar(p, smem);
#ifdef DUP_P4
  phase_attn_a(p, smem, 16);
  gbar(p, smem);
#endif
  if (PHON(5)) phase_attn_b(p, smem);
  gbar(p, smem);
#ifdef DUP_P5
  phase_attn_b(p, smem, 24);
  gbar(p, smem);
#endif
  if (PHON(6)) phase_merge8(p, smem, vbid);
  gbar(p, smem);
#ifdef DUP_G2
  phase_merge(p, smem, vbid);
  gbar(p, smem);
#endif
  if (PHON(7)) phase_resid8<0>(p, smem, (const u16*)(p.ws + OFF_MB), 1024, OFF_WO, 1.0f, OFF_SSP2, vbid);
  gbar(p, smem);
  if (PHON(8)) phase_gateup(p, smem, OFF_SSP2, OFF_WGU2, vbid);
  gbar(p, smem);
  if (PHON(9)) phase_resid8<0>(p, smem, (const u16*)(p.ws + OFF_HID), 2816, OFF_WD2, 0.5f, OFF_SSP3, vbid);
  gbar(p, smem);
  if (PHON(10)) phase_final(p);
}

extern "C" void kernel_launch(void* const* d_in, const int* in_sizes, int n_in, void* d_out, int out_size, void* d_ws,
                              size_t ws_size, hipStream_t stream) {
  Params p{};
  for (int i = 0; i < 27; ++i) p.in[i] = (const float*)d_in[i];
  p.out = (float*)d_out;
  p.ws = (char*)d_ws;
  static int grid_blocks = 0;
  if (!grid_blocks) {
    hipFuncSetAttribute((const void*)mega, hipFuncAttributeMaxDynamicSharedMemorySize, SMEM_BYTES);
    int dev = 0, cus = 0, per_cu = 0;
    hipGetDevice(&dev);
    hipDeviceGetAttribute(&cus, hipDeviceAttributeMultiprocessorCount, dev);
    hipOccupancyMaxActiveBlocksPerMultiprocessor(&per_cu, mega, NTHR, SMEM_BYTES);
    if (per_cu > 1) per_cu = 1;
    if (per_cu < 1) per_cu = 1;
    grid_blocks = cus * per_cu;
  }
  if (ws_size < WS_END) fprintf(stderr, "workspace too small: %zu < %zu\n", ws_size, (size_t)WS_END);
  (void)hipMemsetAsync((char*)d_ws + OFF_CNT, 0, 256 + SZ_XBAR, stream);
  void* args[] = {&p};
  hipError_t e = hipLaunchCooperativeKernel((void*)mega, dim3(grid_blocks), dim3(NTHR), args, SMEM_BYTES, stream);
  if (e != hipSuccess) fprintf(stderr, "cooperative launch failed: %s (grid %d)\n", hipGetErrorString(e), grid_blocks);
}
```

```cpp
#include <hip/hip_runtime.h>
#include <hip/hip_cooperative_groups.h>
#include <stdint.h>
#include <cstdio>
namespace cg = cooperative_groups;

typedef __attribute__((ext_vector_type(8))) short bf16x8;
typedef __attribute__((ext_vector_type(4))) short bf16x4;
typedef __attribute__((ext_vector_type(16))) float f32x16;
typedef unsigned short u16;
typedef unsigned long long u64;
#define MFMA(a, b, c) __builtin_amdgcn_mfma_f32_32x32x16_bf16((a), (b), (c), 0, 0, 0)
#define DI __device__ __forceinline__

constexpr int NTOKP = 8208;
constexpr int TP = 2 * NTOKP;
constexpr int TS = 512;
constexpr int T = TP + TS;
constexpr int TPAD = 17152;
constexpr int NT_M = 67;
constexpr int NTHR = 512;
constexpr int NCACHE = 2064;
constexpr int NKS = 2096;
constexpr int NWP = 129;
constexpr int NWS = 33;
constexpr float EPS = 1e-6f;
constexpr float LOG2E = 1.4426950408889634f;
constexpr float QA_SCALE = 0.125f * LOG2E;
constexpr float QB_SCALE = 0.08838834764831845f * LOG2E;
constexpr float IW_SCALE = 0.125f * 0.35355339059327373f;

constexpr size_t O_YP = 0;
constexpr size_t O_YS = O_YP + 2ull * 8192 * 1024;
constexpr size_t O_AKP = O_YS + 512ull * 1024;
constexpr size_t SZ_NEWP = (size_t)TP * 1024;
constexpr size_t O_AVP = O_AKP + SZ_NEWP;
constexpr size_t O_BKP = O_AVP + SZ_NEWP;
constexpr size_t O_BVP = O_BKP + SZ_NEWP;
constexpr size_t O_IKP = O_BVP + SZ_NEWP;
constexpr size_t O_AKS = O_IKP + (size_t)TP * 64;
constexpr size_t SZ_NEWS = (size_t)TS * 1024;
constexpr size_t O_AVS = O_AKS + SZ_NEWS;
constexpr size_t O_BKS = O_AVS + SZ_NEWS;
constexpr size_t O_BVS = O_BKS + SZ_NEWS;
constexpr size_t O_IKS = O_BVS + SZ_NEWS;

constexpr size_t al256(size_t x) { return (x + 255) & ~size_t(255); }
constexpr size_t SZ_WGU = 5632ull * 1024 * 2, SZ_WD = 1024ull * 2816 * 2, SZ_WIN = 8960ull * 1024 * 2, SZ_WSQ = 1024ull * 1024 * 2;
constexpr int VTPAD = 8256;
constexpr size_t OFF_WA = 0;
constexpr size_t OFF_WB = OFF_WA + SZ_WSQ;
constexpr size_t OFF_WO = OFF_WB + SZ_WSQ;
constexpr size_t OFF_WGU2 = OFF_WO + SZ_WSQ;
constexpr size_t OFF_WD2 = OFF_WGU2 + SZ_WGU;
constexpr size_t OFF_XF = OFF_WD2 + SZ_WD;
constexpr size_t SZ_SSP = (size_t)TPAD * 16 * 4;
constexpr size_t OFF_SSP0 = OFF_XF + (size_t)TPAD * 1024 * 4;
constexpr size_t OFF_SSP1 = OFF_SSP0 + SZ_SSP;
constexpr size_t OFF_SSP2 = OFF_SSP1 + SZ_SSP;
constexpr size_t OFF_SSP3 = OFF_SSP2 + SZ_SSP;
constexpr size_t OFF_TAB = OFF_SSP3 + SZ_SSP;
constexpr size_t OFF_AQ = OFF_TAB + (size_t)NTOKP * 64 * 8;
constexpr size_t OFF_MB = OFF_AQ;
constexpr size_t OFF_BQ = OFF_AQ + (size_t)TPAD * 1024 * 2;
constexpr size_t OFF_IQ = OFF_BQ + (size_t)TPAD * 1024 * 2;
constexpr size_t OFF_IW = OFF_IQ + (size_t)TPAD * 512 * 2;
constexpr size_t OFF_G = OFF_IW + (size_t)TPAD * 8 * 4;
constexpr size_t OFF_OA = OFF_G + (size_t)TPAD * 2048 * 2;
constexpr size_t OFF_MASKP = OFF_OA + (size_t)TPAD * 1024 * 2;
constexpr size_t OFF_MASKS = OFF_MASKP + al256((size_t)TP * NWP * 8);
constexpr size_t OFF_CNT = OFF_MASKS + al256((size_t)TS * NWS * 8);
constexpr size_t OFF_XBAR = OFF_CNT + 256;
constexpr size_t SZ_XBAR = 3456 * 4 + 256;
constexpr size_t OFF_AKB = OFF_XBAR + ((SZ_XBAR + 255) & ~size_t(255));
constexpr size_t OFF_BKB = OFF_AKB + (size_t)TP * 1024 * 2;
constexpr size_t SZ_VT = 2ull * 8 * 128 * VTPAD * 2;
constexpr size_t OFF_AVT = OFF_BKB + (size_t)TP * 1024 * 2;
constexpr size_t OFF_BVT = OFF_AVT + SZ_VT;
constexpr size_t OFF_IKB = OFF_BVT + SZ_VT;
constexpr size_t OFF_DEAD = OFF_IKB + al256((size_t)TP * 64 * 2);
constexpr size_t OFF_WGU1 = OFF_DEAD;
constexpr size_t OFF_WD1 = OFF_WGU1 + SZ_WGU;
constexpr size_t OFF_WIN = OFF_WD1 + SZ_WD;
constexpr size_t OFF_XB = OFF_WIN + SZ_WIN;
constexpr size_t OFF_HID = OFF_XB + (size_t)TPAD * 1024 * 2;
constexpr size_t OFF_OB = OFF_HID + (size_t)TPAD * 2816 * 2;
constexpr size_t OFF_SC = OFF_DEAD;
constexpr size_t SC_BSTRIDE = 4096ull * (128 * 131 / 2);
constexpr size_t SC_META = 2 * SC_BSTRIDE;
constexpr size_t SC_SAMP = SC_META + 2 * 4096;
constexpr size_t SC_FLOATS = SC_SAMP + 16ull * 64 * 2112;
constexpr size_t WS_END = OFF_SC + SC_FLOATS * 4 + 4096;
static_assert(WS_END <= 736544256ull, "workspace budget");
static_assert(OFF_OB + (size_t)TPAD * 1024 * 2 <= WS_END, "dead region fits");

constexpr int SMEM_ITEM = 149504;
constexpr int SMEM_BYTES = SMEM_ITEM + 64;

struct Params {
  const float* in[27];
  float* out;
  char* ws;
};

typedef __attribute__((ext_vector_type(2))) float f32x2_t;
typedef __attribute__((ext_vector_type(2))) __bf16 bf16x2_t;
DI unsigned pack2(float a, float b) {
  f32x2_t v = {a, b};
  return __builtin_bit_cast(unsigned, __builtin_convertvector(v, bf16x2_t));
}
DI u16 f2bf(float x) { return (u16)(pack2(x, x) & 0xffffu); }
DI int tid_opaque() { int t = threadIdx.x; asm volatile("" : "+v"(t)); return t; }
DI int crow(int i, int h) { return (i & 3) + 8 * (i >> 2) + 4 * h; }
DI float fexp2(float x) { return __builtin_amdgcn_exp2f(x); }
DI float shx(float v, int m) { return __shfl_xor(v, m, 64); }

DI const float* xrow_ptr(const Params& p, int row) {
  if (row < TP) {
    int b = row >= NTOKP ? 1 : 0;
    int tok = row - b * NTOKP;
    if (tok < 16) return p.in[7] + (size_t)tok * 1024;
    return p.in[0] + ((size_t)b * 8192 + (tok - 16)) * 1024;
  }
  return p.in[1] + (size_t)(row - TP) * 1024;
}

DI const float* kv_row(const Params& p, int grp, int b, int tk, int which) {
  if (!grp) return p.out + O_AKP + (size_t)which * SZ_NEWP + ((size_t)b * NTOKP + tk) * 1024;
  if (tk < NCACHE) return (which == 0 ? p.in[2] : which == 1 ? p.in[3] : which == 2 ? p.in[4] : p.in[5]) + ((size_t)b * NCACHE + tk) * 1024;
  return p.out + O_AKS + (size_t)which * SZ_NEWS + ((size_t)b * 32 + (tk - NCACHE)) * 1024;
}
DI const float* ik_row(const Params& p, int grp, int b, int tk) {
  if (!grp) return p.out + O_IKP + ((size_t)b * NTOKP + tk) * 64;
  if (tk < NCACHE) return p.in[6] + ((size_t)b * NCACHE + tk) * 64;
  return p.out + O_IKS + ((size_t)b * 32 + (tk - NCACHE)) * 64;
}

#define XB_TMO      128
#define XB_XCNT(j)  (256  + 64 * (j))
#define XB_XSUB(j)  (1280 + 64 * (j))
#define XB_XGEN(j)  (2304 + 64 * (j))
#define XB_TOP      3328
#define XB_TOPGEN   3392
#define XCD_BAR_WORDS 3456
#define XB_SPIN_CAP (1u << 18)
#define LAS __attribute__((address_space(3)))

__device__ __forceinline__ unsigned xb_ld(unsigned* p)              { return __hip_atomic_load(p, __ATOMIC_RELAXED, __HIP_MEMORY_SCOPE_AGENT); }
__device__ __forceinline__ unsigned xb_add(unsigned* p, unsigned v) { return __hip_atomic_fetch_add(p, v, __ATOMIC_RELAXED, __HIP_MEMORY_SCOPE_AGENT); }
__device__ __forceinline__ unsigned xb_xcc_id() { return (unsigned)__builtin_amdgcn_s_getreg((3 << 11) | 20) & 0xFu; }
#define XB_SPIN(cond, bar) do { unsigned _sp = 0; while (cond) { __builtin_amdgcn_s_sleep(1); \
    if ((++_sp & 255u) == 0u) { if (xb_ld(&(bar)[XB_TMO])) break; if (_sp > XB_SPIN_CAP) { atomicAdd(&(bar)[XB_TMO], 1u); break; } } } } while (0)

struct XcdBarrier {
    unsigned* bar; unsigned x;
    volatile LAS unsigned* st;
};

__device__ __forceinline__ XcdBarrier xcd_barrier_post(unsigned* bar, volatile LAS unsigned* st) {
    XcdBarrier b; b.bar = bar; b.x = xb_xcc_id(); b.st = st;
    if (threadIdx.x == 0) (void)xb_add(&bar[XB_XCNT(b.x)], 1u);
    return b;
}
__device__ __forceinline__ void xcd_barrier_complete(unsigned* bar, unsigned x, unsigned& nloc, unsigned& nx) {
    const unsigned G = gridDim.x * gridDim.y * gridDim.z;
    unsigned sum, cnt, mine, sp = 0u;
    for (;;) {
        sum = 0u; cnt = 0u; mine = 0u;
#pragma unroll
        for (unsigned j = 0; j < 16; ++j) { const unsigned c = xb_ld(&bar[XB_XCNT(j)]); sum += c; cnt += (c > 0u) ? 1u : 0u; mine = (j == x) ? c : mine; }
        if (sum == G) break;
        __builtin_amdgcn_s_sleep(1);
        if ((++sp & 255u) == 0u) { if (xb_ld(&bar[XB_TMO])) break; if (sp > XB_SPIN_CAP) { atomicAdd(&bar[XB_TMO], 1u); break; } }
    }
    nloc = mine > 0u ? mine : 1u; nx = cnt > 0u ? cnt : 1u;
}

__device__ __forceinline__ void xcd_barrier(const XcdBarrier& b) {
    asm volatile("s_waitcnt vmcnt(0)" ::: "memory");
    __syncthreads();
    if (threadIdx.x == 0) {
        unsigned* bar = b.bar;
        __builtin_amdgcn_s_waitcnt(0);
        unsigned nloc = b.st[0], nx = b.st[1];
        if (nloc == 0u) { xcd_barrier_complete(bar, b.x, nloc, nx); b.st[0] = nloc; b.st[1] = nx; }
        const unsigned old = xb_add(&bar[XB_XSUB(b.x)], 1u);
        const unsigned gen = old / nloc;
        if (old + 1u == (gen + 1u) * nloc) {
            __builtin_amdgcn_fence(__ATOMIC_RELEASE, "agent");
            asm volatile("s_waitcnt vmcnt(0)" ::: "memory");
            const unsigned og = xb_add(&bar[XB_TOP], 1u);
            const unsigned tg = og / nx;
            if (og + 1u == (tg + 1u) * nx) xb_add(&bar[XB_TOPGEN], 1u);
            else XB_SPIN(xb_ld(&bar[XB_TOPGEN]) == tg, bar);
            __builtin_amdgcn_fence(__ATOMIC_ACQUIRE, "agent");
            xb_add(&bar[XB_XGEN(b.x)], 1u);
            asm volatile("s_waitcnt vmcnt(0)" ::: "memory");
        } else {
            XB_SPIN(xb_ld(&bar[XB_XGEN(b.x)]) == gen, bar);
            __builtin_amdgcn_fence(__ATOMIC_ACQUIRE, "agent");
            asm volatile("s_waitcnt vmcnt(0)" ::: "memory");
        }
    }
    __syncthreads();
}


DI void gbar(const Params& p, char* smem) {
  XcdBarrier b; b.bar = (unsigned*)(p.ws + OFF_XBAR); b.x = xb_xcc_id(); b.st = (volatile LAS unsigned*)(smem + SMEM_ITEM + 48);
  xcd_barrier(b);
}
template <int job>
DI void wt_tile(const Params& p, int seg, int kt, float* ts) {
  const int t = threadIdx.x & 255;
  ts += (threadIdx.x >> 8) * (128 * 33);
  const float* src = nullptr; int ld = 0; const float* gs = nullptr; u16* dst = nullptr; int K = 1024; int nvalid4 = 8;
  switch (job) {
    case 0: case 6: {
      const float* wg = job == 0 ? p.in[9] : p.in[23]; const float* wu = job == 0 ? p.in[10] : p.in[24];
      const int c4g = threadIdx.x & 7;
      src = (c4g < 4 ? wg : wu) + 16 * seg - (c4g < 4 ? 0 : 16); ld = 2816; gs = job == 0 ? p.in[8] : p.in[22];
      dst = (u16*)(p.ws + (job == 0 ? OFF_WGU1 : OFF_WGU2)) + (size_t)seg * 32 * 1024; K = 1024;
    } break;
    case 1: case 7: {
      src = (job == 1 ? p.in[11] : p.in[25]) + 32 * seg; ld = 1024; K = 2816;
      dst = (u16*)(p.ws + (job == 1 ? OFF_WD1 : OFF_WD2)) + (size_t)seg * 32 * 2816;
    } break;
    case 2: {
      const int G = seg; const int c4g = threadIdx.x & 7; const int hf = c4g >> 2;
      int a0 = 0; bool valid = true;
      if (G < 64) { const int base = G < 32 ? 0 : 1024; const int q = G & 31; a0 = base + (q >> 1) * 64 + (q & 1) * 16 + hf * 32; }
      else if (G < 96) a0 = 2048 + (G - 64) * 32 + hf * 16;
      else if (G < 160) { const int base = G < 128 ? 3072 : 4096; const int q = (G - 96) & 31; a0 = base + (q >> 2) * 128 + (q & 3) * 16 + hf * 64; }
      else if (G < 192) a0 = 5120 + (G - 160) * 32 + hf * 16;
      else if (G < 208) { const int q = G - 192; a0 = 6144 + (q >> 1) * 64 + (q & 1) * 16 + hf * 32; }
      else if (G < 210) { a0 = 6656 + (G - 208) * 16 + hf * 32; }
      else if (G == 210) { a0 = 6720; valid = c4g < 2; }
      else if (G < 275) a0 = 6728 + (G - 211) * 32 + hf * 16;
      else valid = false;
      if (!valid) a0 = 0;
      src = p.in[13] + a0 - (valid ? hf * 16 : c4g * 4); ld = 8776; gs = p.in[12]; K = 1024;
      nvalid4 = valid ? 8 : 0;
      dst = (u16*)(p.ws + OFF_WIN) + (size_t)G * 32 * 1024;
    } break;
    default: {
      src = (job == 3 ? p.in[19] : (job == 4 ? p.in[20] : p.in[21])) + 32 * seg; ld = 1024; K = 1024;
      dst = (u16*)(p.ws + (job == 3 ? OFF_WA : (job == 4 ? OFF_WB : OFF_WO))) + (size_t)seg * 32 * 1024;
    } break;
  }
  const int c4 = t & 7, kr = t >> 3;
  {
#pragma unroll
  for (int ps = 0; ps < 4; ++ps) {
    const int kl = ps * 32 + kr; const int k = kt * 128 + kl;
    float4 v = make_float4(0.f, 0.f, 0.f, 0.f);
    if (c4 < nvalid4) v = *(const float4*)(src + (size_t)k * ld + c4 * 4);
    const float s = gs ? gs[k] : 1.0f;
    float* d = ts + kl * 33 + c4 * 4;
    d[0] = v.x * s; d[1] = v.y * s; d[2] = v.z * s; d[3] = v.w * s;
  }
  }
  __syncthreads();
  {
    const int r = t >> 3, kc = t & 7;
    unsigned o[8];
#pragma unroll
    for (int j = 0; j < 8; ++j) o[j] = pack2(ts[(kc * 16 + 2 * j) * 33 + r], ts[(kc * 16 + 2 * j + 1) * 33 + r]);
    uint4* dp = (uint4*)(dst + (size_t)r * K + kt * 128 + kc * 16);
    dp[0] = make_uint4(o[0], o[1], o[2], o[3]);
    dp[1] = make_uint4(o[4], o[5], o[6], o[7]);
  }
  __syncthreads();
}

DI void phase_prep(const Params& p, char* smem) {
  const int t = tid_opaque(), lane = t & 63;
  for (int e = blockIdx.x * NTHR + t; e < NTOKP * 64; e += gridDim.x * NTHR) {
    const int pos = e >> 6, i = e & 63;
    double inv = 1.0;
    for (int j = 0; j < i; ++j) inv *= 0.8659643233600653;
    const float invf = (float)inv;
    const float ang = (float)pos * invf;
    const double a = (double)ang;
    const double qd = rint(a * 0.6366197723675814);
    const double r = (a - qd * 1.5707963267948966) - qd * 6.123233995736766e-17;
    const double r2 = r * r;
    double sn = r2 * (1.0 / 6227020800.0) - 1.0 / 39916800.0;
    sn = sn * r2 + 1.0 / 362880.0; sn = sn * r2 - 1.0 / 5040.0; sn = sn * r2 + 1.0 / 120.0; sn = sn * r2 - 1.0 / 6.0; sn = sn * r2 * r + r;
    double cn = -r2 * (1.0 / 87178291200.0) + 1.0 / 479001600.0;
    cn = cn * r2 - 1.0 / 3628800.0; cn = cn * r2 + 1.0 / 40320.0; cn = cn * r2 - 1.0 / 720.0; cn = cn * r2 + 1.0 / 24.0; cn = cn * r2 - 0.5; cn = cn * r2 + 1.0;
    const int q = ((int)qd) & 3;
    double c, s;
    if (q == 0) { c = cn; s = sn; } else if (q == 1) { c = -sn; s = cn; } else if (q == 2) { c = -cn; s = -sn; } else { c = sn; s = -cn; }
    ((float2*)(p.ws + OFF_TAB))[e] = make_float2((float)c, (float)s);
  }
  for (int e = blockIdx.x * NTHR + t; e < 2 * 2048 * 6; e += gridDim.x * NTHR) {
    const int which = e / (2048 * 6), r = e % (2048 * 6);
    const int row = r / 6, ch = r % 6;
    u16* vt = (u16*)(p.ws + (which ? OFF_BVT : OFF_AVT)) + (size_t)row * VTPAD + NTOKP + ch * 8;
    *(uint4*)vt = make_uint4(0, 0, 0, 0);
  }
  {
    const int wv = blockIdx.x * 8 + (t >> 6), nw = gridDim.x * 8;
    for (int row = wv; row < TPAD; row += nw) {
      u16* xb = (u16*)(p.ws + OFF_XB) + (size_t)row * 1024;
      float* ssp = (float*)(p.ws + OFF_SSP0) + (size_t)row * 16;
      if (row >= T) {
        uint4 z = make_uint4(0, 0, 0, 0);
        ((uint4*)xb)[lane * 2] = z; ((uint4*)xb)[lane * 2 + 1] = z;
        if (lane < 16) ssp[lane] = lane == 0 ? 1024.f : 0.f;
        continue;
      }
      const float4* src = (const float4*)xrow_ptr(p, row);
      float ss = 0.f;
#pragma unroll
      for (int i = 0; i < 4; ++i) {
        const float4 v = src[lane + 64 * i];
        ss += v.x * v.x + v.y * v.y + v.z * v.z + v.w * v.w;
        ((uint2*)xb)[lane + 64 * i] = make_uint2(pack2(v.x, v.y), pack2(v.z, v.w));
      }
#pragma unroll
      for (int m = 32; m >= 1; m >>= 1) ss += shx(ss, m);
      if (lane < 16) ssp[lane] = lane == 0 ? ss : 0.f;
    }
  }
  {
    float* ts = (float*)smem;
    for (int tb = blockIdx.x * 2; tb < 7232; tb += gridDim.x * 2) {
      const int tile = __builtin_amdgcn_readfirstlane(tb + (int)(threadIdx.x >> 8));
      if (tile >= 7232) { __syncthreads(); __syncthreads(); continue; }
      int job, r = tile;
      if (r < 1408) job = 0;
      else if ((r -= 1408) < 704) job = 1;
      else if ((r -= 704) < 2240) job = 2;
      else if ((r -= 2240) < 256) job = 3;
      else if ((r -= 256) < 256) job = 4;
      else if ((r -= 256) < 256) job = 5;
      else if ((r -= 256) < 1408) job = 6;
      else { r -= 1408; job = 7; }
      const int nkt = (job == 1 || job == 7) ? 22 : 8;
      const int sg = r / nkt, kk = r % nkt;
      switch (job) {
        case 0: wt_tile<0>(p, sg, kk, ts); break;
        case 1: wt_tile<1>(p, sg, kk, ts); break;
        case 2: wt_tile<2>(p, sg, kk, ts); break;
        case 3: wt_tile<3>(p, sg, kk, ts); break;
        case 4: wt_tile<4>(p, sg, kk, ts); break;
        case 5: wt_tile<5>(p, sg, kk, ts); break;
        case 6: wt_tile<6>(p, sg, kk, ts); break;
        default: wt_tile<7>(p, sg, kk, ts); break;
      }
    }
  }
}

constexpr int GSTAGE = (256 + 128) * 72;
constexpr int RS_OFF = 2 * GSTAGE * 2;
#define G_DECL uint4 gs0, gs1, gs2, gs3, gs4, gs5, gs6, gs7, gs8, gs9, gs10, gs11, gs12, gs13, gs14, gs15, gs16, gs17; float4 gq0, gq1, gq2, gq3;
#define G_LOAD(S0, S1, S2, S3, S4, S5, kn) { \
    S0 = *(const uint4*)(Ap + (kn)); S1 = *(const uint4*)(Ap + (size_t)64 * lda_ + (kn)); \
    S2 = *(const uint4*)(Ap + (size_t)128 * lda_ + (kn)); S3 = *(const uint4*)(Ap + (size_t)192 * lda_ + (kn)); \
    S4 = *(const uint4*)(Bp + (kn)); S5 = *(const uint4*)(Bp + (size_t)64 * ldb_ + (kn)); }
#define G_STORE(S0, S1, S2, S3, S4, S5, st) { \
    u16* An_ = smem_ + (st) * GSTAGE; u16* Bn_ = An_ + 256 * 72; \
    *(uint4*)(An_ + (lrow) * 72 + lkc * 8) = S0; *(uint4*)(An_ + (lrow + 64) * 72 + lkc * 8) = S1; \
    *(uint4*)(An_ + (lrow + 128) * 72 + lkc * 8) = S2; *(uint4*)(An_ + (lrow + 192) * 72 + lkc * 8) = S3; \
    *(uint4*)(Bn_ + (lrow) * 72 + lkc * 8) = S4; *(uint4*)(Bn_ + (lrow + 64) * 72 + lkc * 8) = S5; }
#define G_LOAD_A(kn) G_LOAD(gs0, gs1, gs2, gs3, gs4, gs5, kn)
#define G_LOAD_B(kn) G_LOAD(gs6, gs7, gs8, gs9, gs10, gs11, kn)
#define G_LOAD_C(kn) G_LOAD(gs12, gs13, gs14, gs15, gs16, gs17, kn)
#define G_STORE_A(st) G_STORE(gs0, gs1, gs2, gs3, gs4, gs5, st)
#define G_STORE_B(st) G_STORE(gs6, gs7, gs8, gs9, gs10, gs11, st)
#define G_STORE_C(st) G_STORE(gs12, gs13, gs14, gs15, gs16, gs17, st)
#define G_COMPUTE(st, SWAPC, ACC) { \
    const u16* As_ = smem_ + (st) * GSTAGE; const u16* Bs_ = As_ + 256 * 72; \
    _Pragma("unroll") for (int kk = 0; kk < 4; ++kk) { \
      bf16x8 a0 = *(const bf16x8*)(As_ + (gwm * 64 + glr) * 72 + kk * 16 + glh * 8); \
      bf16x8 a1 = *(const bf16x8*)(As_ + (gwm * 64 + 32 + glr) * 72 + kk * 16 + glh * 8); \
      bf16x8 b0 = *(const bf16x8*)(Bs_ + (gwn * 64 + glr) * 72 + kk * 16 + glh * 8); \
      bf16x8 b1 = *(const bf16x8*)(Bs_ + (gwn * 64 + 32 + glr) * 72 + kk * 16 + glh * 8); \
      if (SWAPC) { \
        ACC[0][0] = MFMA(b0, a0, ACC[0][0]); ACC[0][1] = MFMA(b1, a0, ACC[0][1]); \
        ACC[1][0] = MFMA(b0, a1, ACC[1][0]); ACC[1][1] = MFMA(b1, a1, ACC[1][1]); \
      } else { \
        ACC[0][0] = MFMA(a0, b0, ACC[0][0]); ACC[0][1] = MFMA(a0, b1, ACC[0][1]); \
        ACC[1][0] = MFMA(a1, b0, ACC[1][0]); ACC[1][1] = MFMA(a1, b1, ACC[1][1]); } } }
#define G_STEP(k, SL, SS, SWAPC, ACC) if ((k) < nk_) { \
    if ((k) + 3 < nk_) G_LOAD_##SL(((k) + 3) << 6) \
    G_COMPUTE((k) & 1, SWAPC, ACC) \
    if ((k) + 1 < nk_) G_STORE_##SS(((k) + 1) & 1) \
    __syncthreads(); }
#define G_ISSUE(A_, LDA, B_, LDB, M0, N0, SSP) { \
    const int t_ = tid_opaque(); const int lrow = t_ >> 3, lkc = t_ & 7; const int lda_ = (LDA), ldb_ = (LDB); \
    const u16* Ap = (A_) + (size_t)((M0) + lrow) * lda_ + lkc * 8; \
    const u16* Bp = (B_) + (size_t)((N0) + lrow) * ldb_ + lkc * 8; \
    G_LOAD_A(0) G_LOAD_B(64) G_LOAD_C(128) \
    const float* ssp_ = (SSP); \
    if (ssp_ && t_ < 256) { const float4* q_ = (const float4*)(ssp_ + (size_t)((M0) + t_) * 16); gq0 = q_[0]; gq1 = q_[1]; gq2 = q_[2]; gq3 = q_[3]; } }
#define G_RSFIN(RS) { const int t_ = tid_opaque(); if (t_ < 256) { \
    const float s_ = ((gq0.x + gq0.y) + (gq0.z + gq0.w)) + ((gq1.x + gq1.y) + (gq1.z + gq1.w)) + ((gq2.x + gq2.y) + (gq2.z + gq2.w)) + ((gq3.x + gq3.y) + (gq3.z + gq3.w)); \
    (RS)[t_] = rsqrtf(s_ * (1.0f / 1024.0f) + EPS); } }
#define G_RUN(A_, LDA, B_, LDB, K_, M0, N0, SMEM, ACC, SWAPC) { \
    const int t_ = tid_opaque(), glane = t_ & 63, gw = t_ >> 6, gwm = gw >> 1, gwn = gw & 1; \
    const int glr = glane & 31, glh = glane >> 5; const int lrow = t_ >> 3, lkc = t_ & 7; const int lda_ = (LDA), ldb_ = (LDB); \
    u16* smem_ = (SMEM); \
    const u16* Ap = (A_) + (size_t)((M0) + lrow) * lda_ + lkc * 8; \
    const u16* Bp = (B_) + (size_t)((N0) + lrow) * ldb_ + lkc * 8; \
    const int nk_ = (K_) >> 6; \
    G_STORE_A(0) \
    __syncthreads(); \
    for (int ks = 0; ks < nk_; ks += 3) { \
      G_STEP(ks, A, B, SWAPC, ACC) \
      G_STEP(ks + 1, B, C, SWAPC, ACC) \
      G_STEP(ks + 2, C, A, SWAPC, ACC) } }

DI bool gemm_tile(int vbid, int it, int nt_n, int& m0, int& n0) {
  if (gridDim.x == 256) {
    const int x = vbid & 7, r = vbid >> 3;
    const int L = (it * 8 + x) * 32 + r;
    if (L >= NT_M * nt_n) return false;
    const int full = (NT_M / 4) * 4 * nt_n;
    int m, n;
    if (L < full) { const int band = L / (4 * nt_n), idx = L - band * 4 * nt_n; n = idx >> 2; m = band * 4 + (idx & 3); }
    else { const int idx = L - full; constexpr int rem = NT_M % 4; n = idx / rem; m = (NT_M / 4) * 4 + idx % rem; }
    m0 = m * 256; n0 = n * 128;
    return true;
  }
  const int tile = blockIdx.x + it * gridDim.x;
  m0 = (tile / nt_n) * 256; n0 = (tile % nt_n) * 128;
  return tile < NT_M * nt_n;
}
DI int gemm_rounds(int nt_n) {
  return (NT_M * nt_n + gridDim.x - 1) / gridDim.x;
}

DI void zero_acc(f32x16 (&acc)[2][2]) {
#pragma unroll
  for (int a = 0; a < 2; ++a)
#pragma unroll
    for (int b = 0; b < 2; ++b)
#pragma unroll
      for (int i = 0; i < 16; ++i) acc[a][b][i] = 0.f;
}

DI void load_rs(const float* ssp, int m0, float* rs_s) {
  __syncthreads();
  const int t = threadIdx.x;
  if (t < 256) {
    const float4* q = (const float4*)(ssp + (size_t)(m0 + t) * 16);
    const float4 a = q[0], b = q[1], c = q[2], d = q[3];
    const float s = ((a.x + a.y) + (a.z + a.w)) + ((b.x + b.y) + (b.z + b.w)) + ((c.x + c.y) + (c.z + c.w)) + ((d.x + d.y) + (d.z + d.w));
    rs_s[t] = rsqrtf(s * (1.0f / 1024.0f) + EPS);
  }
}

typedef __attribute__((ext_vector_type(4))) float f32x4;
constexpr int P8_HT = 128 * 64;
constexpr int RS8_OFF = 8 * P8_HT * 2;
DI int p8_lds_byte(int r, int c) {
  const int st = (r >> 4) * 2 + (c >> 5), rr = r & 15, cc = c & 31, ob = rr * 64 + cc * 2;
  return st * 1024 + (ob ^ (((ob >> 9) & 1) << 5));
}
DI void p8_stage_rc(int b, int& R, int& C) {
  const int st = b / 1024, sb = b % 1024, swz = sb ^ (((sb >> 9) & 1) << 5);
  R = (st >> 1) * 16 + swz / 64; C = (st & 1) * 32 + (swz % 64) / 2;
}
typedef __attribute__((address_space(3))) unsigned lds_u32;
typedef __attribute__((address_space(3))) unsigned char lds_u8;
typedef __attribute__((address_space(3))) bf16x8 lds_bf16x8;
DI void gemm8_tile(const u16* __restrict__ A, const u16* __restrict__ Bt, const int K, const int brow, const int bcol,
                   u16* shm, f32x4 (&acc)[2][2][4][2], const int klen = 0) {
#define P8_SA(b, h) (((b) * 2 + (h)) * 16384)
#define P8_SB(b, h) ((4 + (b) * 2 + (h)) * 16384)
#define P8_STAGE(P, BASE, br, kt) do { const char* _gb = (const char*)(BASE) + ((long)(br) * K + (long)(kt) * 64) * 2; \
    __builtin_amdgcn_global_load_lds((const unsigned*)(_gb + so0), (lds_u32*)(lds + (P) + lo0), 16, 0, 0); \
    __builtin_amdgcn_global_load_lds((const unsigned*)(_gb + (long)K * 128 + so0), (lds_u32*)(lds + (P) + lo0 + 8192), 16, 0, 0); } while (0)
#define P8_LDA(dst, b, h) _Pragma("unroll") for (int m = 0; m < 4; ++m) _Pragma("unroll") for (int k = 0; k < 2; ++k) \
    dst[m][k] = *(const lds_bf16x8*)(lds + P8_SA(b, h) + aoff + m * 2048 + k * 1024)
#define P8_LDB(dst, b, h) _Pragma("unroll") for (int n = 0; n < 2; ++n) _Pragma("unroll") for (int k = 0; k < 2; ++k) \
    dst[n][k] = *(const lds_bf16x8*)(lds + P8_SB(b, h) + boff + n * 2048 + k * 1024)
#define P8_MMA(ai, bj, At_, Bt_) do { __builtin_amdgcn_s_setprio(1); \
    _Pragma("unroll") for (int m = 0; m < 4; ++m) _Pragma("unroll") for (int n = 0; n < 2; ++n) _Pragma("unroll") for (int k = 0; k < 2; ++k) \
      acc[ai][bj][m][n] = __builtin_amdgcn_mfma_f32_16x16x32_bf16(Bt_[n][k], At_[m][k], acc[ai][bj][m][n], 0, 0, 0); \
    __builtin_amdgcn_s_setprio(0); } while (0)
#define P8_WAIT_V(n) asm volatile("s_waitcnt vmcnt(" #n ")" ::: "memory")
#define P8_WAIT_L(n) asm volatile("s_waitcnt lgkmcnt(" #n ")" ::: "memory")
#define P8_BAR __builtin_amdgcn_s_barrier()
#define P8_SCHED __builtin_amdgcn_sched_barrier(0)
  const int HALF = 128;
  const int tid8 = tid_opaque();
  const int wid = __builtin_amdgcn_readfirstlane(tid8 >> 6), lane = tid8 & 63, wr = wid >> 2, wc = wid & 3, fr = lane & 15, fq = lane >> 4;
  lds_u8* lds = (lds_u8*)shm;
  const int lo0 = tid8 * 16;
  const int aoff = p8_lds_byte(wr * 64 + fr, fq * 8), boff = p8_lds_byte(wc * 32 + fr, fq * 8);
  unsigned so0;
  { int r_, c_; p8_stage_rc(lo0, r_, c_); so0 = (unsigned)(r_ * K + c_) * 2u; }
  bf16x8 At[4][2], B0[2][2], B1[2][2];
  const int nt = (klen ? klen : K) / 64;
  P8_STAGE(P8_SB(0, 0), Bt, bcol, 0); P8_STAGE(P8_SA(0, 0), A, brow, 0);
  P8_STAGE(P8_SB(0, 1), Bt, bcol + HALF, 0); P8_STAGE(P8_SA(0, 1), A, brow + HALF, 0);
  if (wr == 1) P8_BAR;
  P8_WAIT_V(4); P8_BAR;
  P8_STAGE(P8_SB(1, 0), Bt, bcol, 1); P8_STAGE(P8_SA(1, 0), A, brow, 1); P8_STAGE(P8_SB(1, 1), Bt, bcol + HALF, 1);
  P8_WAIT_V(6); P8_BAR;
  for (int t = 0; t < nt - 2; t += 2) {
    P8_LDB(B0, 0, 0); P8_SCHED; P8_LDA(At, 0, 0); P8_STAGE(P8_SA(1, 1), A, brow + HALF, t + 1);
    P8_WAIT_L(8); P8_BAR; P8_WAIT_L(0); P8_MMA(0, 0, At, B0); P8_BAR; P8_SCHED;
    P8_LDB(B1, 0, 1); P8_STAGE(P8_SB(0, 0), Bt, bcol, t + 2);
    P8_BAR; P8_WAIT_L(0); P8_MMA(0, 1, At, B1); P8_BAR;
    P8_LDA(At, 0, 1); P8_STAGE(P8_SA(0, 0), A, brow, t + 2);
    P8_BAR; P8_WAIT_L(0); P8_MMA(1, 0, At, B0); P8_BAR; P8_SCHED;
    P8_STAGE(P8_SB(0, 1), Bt, bcol + HALF, t + 2);
    P8_WAIT_V(6); P8_BAR; P8_MMA(1, 1, At, B1); P8_BAR;
    P8_LDB(B0, 1, 0); P8_SCHED; P8_LDA(At, 1, 0); P8_STAGE(P8_SA(0, 1), A, brow + HALF, t + 2);
    P8_WAIT_L(8); P8_BAR; P8_WAIT_L(0); P8_MMA(0, 0, At, B0); P8_BAR; P8_SCHED;
    P8_LDB(B1, 1, 1); P8_STAGE(P8_SB(1, 0), Bt, bcol, t + 3);
    P8_BAR; P8_WAIT_L(0); P8_MMA(0, 1, At, B1); P8_BAR;
    P8_LDA(At, 1, 1); P8_STAGE(P8_SA(1, 0), A, brow, t + 3);
    P8_BAR; P8_WAIT_L(0); P8_MMA(1, 0, At, B0); P8_BAR; P8_SCHED;
    P8_STAGE(P8_SB(1, 1), Bt, bcol + HALF, t + 3);
    P8_WAIT_V(6); P8_BAR; P8_MMA(1, 1, At, B1); P8_BAR;
  }
  { P8_LDB(B0, 0, 0); P8_LDA(At, 0, 0); P8_STAGE(P8_SA(1, 1), A, brow + HALF, nt - 1);
    P8_BAR; P8_WAIT_L(0); P8_MMA(0, 0, At, B0); P8_BAR;
    P8_LDB(B1, 0, 1); P8_BAR; P8_WAIT_L(0); P8_MMA(0, 1, At, B1); P8_BAR;
    P8_LDA(At, 0, 1); P8_WAIT_V(4); P8_BAR; P8_WAIT_L(0); P8_MMA(1, 0, At, B0); P8_MMA(1, 1, At, B1); P8_BAR; }
  { P8_LDB(B0, 1, 0); P8_LDA(At, 1, 0); P8_WAIT_V(2); P8_BAR; P8_WAIT_L(0); P8_MMA(0, 0, At, B0); P8_BAR;
    P8_LDB(B1, 1, 1); P8_WAIT_V(0); P8_BAR; P8_WAIT_L(0); P8_MMA(0, 1, At, B1); P8_BAR;
    P8_LDA(At, 1, 1); P8_BAR; P8_WAIT_L(0); P8_MMA(1, 0, At, B0); P8_MMA(1, 1, At, B1); P8_BAR; }
  if (wr == 0) P8_BAR;
}

DI void phase_gateup(const Params& p, char* smem, size_t off_ssp, size_t off_w, int vbid) {
  const u16* A = (const u16*)(p.ws + OFF_XB);
  const u16* B = (const u16*)(p.ws + off_w);
  const float* ssp = (const float*)(p.ws + off_ssp);
  u16* hid = (u16*)(p.ws + OFF_HID);
  float* rs_s = (float*)(smem + RS8_OFF);
  const int nr = gemm_rounds(22);
  for (int it = 0; it < nr; ++it) {
    int m0, n0;
    if (!gemm_tile(vbid, it, 22, m0, n0)) continue;
    n0 *= 2;
    load_rs(ssp, m0, rs_s);
    __syncthreads();
    f32x4 acc[2][2][4][2];
#pragma unroll
    for (int a_ = 0; a_ < 2; ++a_)
#pragma unroll
      for (int b_ = 0; b_ < 2; ++b_)
#pragma unroll
        for (int m_ = 0; m_ < 4; ++m_)
#pragma unroll
          for (int n_ = 0; n_ < 2; ++n_) acc[a_][b_][m_][n_] = (f32x4){0.f, 0.f, 0.f, 0.f};
    gemm8_tile(A, B, 1024, m0, n0, (u16*)smem, acc);
    const int t = tid_opaque(), lane = t & 63, wid = t >> 6, wr = wid >> 2, wc = wid & 3, fr = lane & 15, fq = lane >> 4;
#pragma unroll
    for (int ai = 0; ai < 2; ++ai)
#pragma unroll
      for (int m = 0; m < 4; ++m) {
        const int rl = ai * 128 + wr * 64 + m * 16 + fr; const int row = m0 + rl;
        if (row < T) {
          const float r = rs_s[rl];
#pragma unroll
          for (int bj = 0; bj < 2; ++bj) {
            float hv[4];
#pragma unroll
            for (int j = 0; j < 4; ++j) {
              const float gg = acc[ai][bj][m][0][j] * r, uu = acc[ai][bj][m][1][j] * r;
              hv[j] = gg / (1.0f + __expf(-gg)) * uu;
            }
            const int hc = ((n0 + bj * 128 + wc * 32) >> 1) + fq * 4;
            *(uint2*)(hid + (size_t)row * 2816 + hc) = make_uint2(pack2(hv[0], hv[1]), pack2(hv[2], hv[3]));
          }
        }
      }
  }
}

DI void phase_merge8(const Params& p, char* smem, int vbid) {
  const u16* OA = (const u16*)(p.ws + OFF_OA); const u16* OB = (const u16*)(p.ws + OFF_OB);
  const u16* WA = (const u16*)(p.ws + OFF_WA); const u16* WB = (const u16*)(p.ws + OFF_WB);
  const u16* G = (const u16*)(p.ws + OFF_G);
  u16* MB = (u16*)(p.ws + OFF_MB);
  float* tmp = (float*)(p.ws + OFF_HID);
  float* part_buf = (float*)(p.ws + OFF_BQ);
  const bool splitmode = gridDim.x == 256;
  const int nr = splitmode ? 1 : gemm_rounds(4);
  const int nitem = splitmode ? 12 * 8 : 0;
  for (int itx = 0; itx < nr + (nitem ? 1 : 0); ++itx) {
    int m0, n0, slice = -1, spass = 0;
    if (itx < nr) {
      if (!gemm_tile(vbid, itx, 4, m0, n0)) continue;
      n0 *= 2;
    } else {
      if (vbid >= nitem) continue;
      const int tl = vbid >> 3; spass = (vbid >> 2) & 1; slice = vbid & 3;
      m0 = (64 + (tl >> 2)) * 256; n0 = (tl & 3) * 256;
    }
#pragma unroll 1
    for (int pass = (slice < 0 ? 0 : spass); pass < (slice < 0 ? 2 : spass + 1); ++pass) {
      __syncthreads();
      f32x4 acc[2][2][4][2];
#pragma unroll
      for (int a_ = 0; a_ < 2; ++a_)
#pragma unroll
        for (int b_ = 0; b_ < 2; ++b_)
#pragma unroll
          for (int m_ = 0; m_ < 4; ++m_)
#pragma unroll
            for (int n_ = 0; n_ < 2; ++n_) acc[a_][b_][m_][n_] = (f32x4){0.f, 0.f, 0.f, 0.f};
      {
        const int koff = slice < 0 ? 0 : slice * 256;
        gemm8_tile((pass ? OB : OA) + koff, (pass ? WB : WA) + koff, 1024, m0, n0, (u16*)smem, acc, slice < 0 ? 1024 : 256);
      }
      const int t = tid_opaque(), lane = t & 63, wid = t >> 6, wr = wid >> 2, wc = wid & 3, fr = lane & 15, fq = lane >> 4;
      float* pb = part_buf + (size_t)(pass * 4 + (slice < 0 ? 0 : slice)) * 768 * 1024;
#pragma unroll
      for (int ai = 0; ai < 2; ++ai)
#pragma unroll
        for (int m = 0; m < 4; ++m) {
          const int row = m0 + ai * 128 + wr * 64 + m * 16 + fr;
          if (row >= T) continue;
#pragma unroll
          for (int bj = 0; bj < 2; ++bj)
#pragma unroll
            for (int n = 0; n < 2; ++n) {
              const int col = n0 + bj * 128 + wc * 32 + n * 16 + fq * 4;
              if (slice >= 0) {
                *(float4*)(pb + (size_t)(row - 16384) * 1024 + col) = make_float4(acc[ai][bj][m][n][0], acc[ai][bj][m][n][1], acc[ai][bj][m][n][2], acc[ai][bj][m][n][3]);
                continue;
              }
              const uint2 gg = *(const uint2*)(G + (size_t)row * 2048 + pass * 1024 + col);
              const float g0 = __uint_as_float(gg.x << 16), g1 = __uint_as_float(gg.x & 0xffff0000u);
              const float g2 = __uint_as_float(gg.y << 16), g3 = __uint_as_float(gg.y & 0xffff0000u);
              float4 v = make_float4(g0 * acc[ai][bj][m][n][0], g1 * acc[ai][bj][m][n][1], g2 * acc[ai][bj][m][n][2], g3 * acc[ai][bj][m][n][3]);
              float* tp = tmp + (size_t)row * 1024 + col;
              if (pass == 0) *(float4*)tp = v;
              else {
                const float4 u = *(const float4*)tp;
                *(uint2*)(MB + (size_t)row * 1024 + col) = make_uint2(pack2(u.x + v.x, u.y + v.y), pack2(u.z + v.z, u.w + v.w));
              }
            }
        }
    }
  }
  if (splitmode) {
    gbar(p, smem);
    const int t = tid_opaque(), lane = t & 63;
    const int wv = vbid * 8 + (t >> 6);
    for (int rr = wv; rr < T - 16384; rr += 256 * 8) {
      const int row = 16384 + rr;
#pragma unroll
      for (int i = 0; i < 4; ++i) {
        const int col = (lane + 64 * i) * 4;
        float4 sa = make_float4(0.f, 0.f, 0.f, 0.f), sb = sa;
        for (int sl = 0; sl < 4; ++sl) {
          const float4 qa = *(const float4*)(part_buf + ((size_t)sl * 768 + rr) * 1024 + col);
          const float4 qb = *(const float4*)(part_buf + ((size_t)(4 + sl) * 768 + rr) * 1024 + col);
          sa.x += qa.x; sa.y += qa.y; sa.z += qa.z; sa.w += qa.w;
          sb.x += qb.x; sb.y += qb.y; sb.z += qb.z; sb.w += qb.w;
        }
        const uint2 ga = *(const uint2*)(G + (size_t)row * 2048 + col);
        const uint2 gb = *(const uint2*)(G + (size_t)row * 2048 + 1024 + col);
        const float m0v = __uint_as_float(ga.x << 16) * sa.x + __uint_as_float(gb.x << 16) * sb.x;
        const float m1v = __uint_as_float(ga.x & 0xffff0000u) * sa.y + __uint_as_float(gb.x & 0xffff0000u) * sb.y;
        const float m2v = __uint_as_float(ga.y << 16) * sa.z + __uint_as_float(gb.y << 16) * sb.z;
        const float m3v = __uint_as_float(ga.y & 0xffff0000u) * sa.w + __uint_as_float(gb.y & 0xffff0000u) * sb.w;
        *(uint2*)(MB + (size_t)row * 1024 + col) = make_uint2(pack2(m0v, m1v), pack2(m2v, m3v));
      }
    }
  }
}

template <int RESID_ORIG>
DI void phase_resid8(const Params& p, char* smem, const u16* A, int K, size_t off_w, float factor, size_t off_ssp_out, int vbid) {
  const u16* B = (const u16*)(p.ws + off_w);
  float* xf = (float*)(p.ws + OFF_XF);
  u16* xb = (u16*)(p.ws + OFF_XB);
  float* sspo = (float*)(p.ws + off_ssp_out);
  float* part_buf = (float*)(p.ws + OFF_G);
  const bool splitmode = gridDim.x == 256;
  const int nslice = K >> 8;
  const int nr = splitmode ? 1 : gemm_rounds(4);
  const int nitem = splitmode ? 12 * nslice : 0;
  for (int itx = 0; itx < nr + (nitem + 255) / 256; ++itx) {
    int m0, n0, slice = -1;
    if (itx < nr) {
      if (!gemm_tile(vbid, itx, 4, m0, n0)) continue;
      n0 *= 2;
    } else {
      const int id = (itx - nr) * 256 + vbid;
      if (id >= nitem) continue;
      const int tl = id / nslice; slice = id - tl * nslice;
      m0 = (64 + (tl >> 2)) * 256; n0 = (tl & 3) * 256;
    }
    __syncthreads();
    f32x4 acc[2][2][4][2];
#pragma unroll
    for (int a_ = 0; a_ < 2; ++a_)
#pragma unroll
      for (int b_ = 0; b_ < 2; ++b_)
#pragma unroll
        for (int m_ = 0; m_ < 4; ++m_)
#pragma unroll
          for (int n_ = 0; n_ < 2; ++n_) acc[a_][b_][m_][n_] = (f32x4){0.f, 0.f, 0.f, 0.f};
    {
      const int koff = slice < 0 ? 0 : slice * 256;
      gemm8_tile(A + koff, B + koff, K, m0, n0, (u16*)smem, acc, slice < 0 ? K : 256);
    }
    const int t = tid_opaque(), lane = t & 63, wid = t >> 6, wr = wid >> 2, wc = wid & 3, fr = lane & 15, fq = lane >> 4;
    const int pn = n0 >> 8;
    if (slice >= 0) {
      float* pb = part_buf + (size_t)slice * 768 * 1024;
#pragma unroll
      for (int ai = 0; ai < 2; ++ai)
#pragma unroll
        for (int m = 0; m < 4; ++m) {
          const int row = m0 + ai * 128 + wr * 64 + m * 16 + fr;
          if (row >= T) continue;
#pragma unroll
          for (int bj = 0; bj < 2; ++bj)
#pragma unroll
            for (int n = 0; n < 2; ++n) {
              const int col = n0 + bj * 128 + wc * 32 + n * 16 + fq * 4;
              *(float4*)(pb + (size_t)(row - 16384) * 1024 + col) = make_float4(acc[ai][bj][m][n][0], acc[ai][bj][m][n][1], acc[ai][bj][m][n][2], acc[ai][bj][m][n][3]);
            }
        }
      continue;
    }
#pragma unroll
    for (int ai = 0; ai < 2; ++ai)
#pragma unroll
      for (int m = 0; m < 4; ++m) {
        const int row = m0 + ai * 128 + wr * 64 + m * 16 + fr;
        const bool ok = row < T;
        float part = 0.f;
        if (ok) {
          const float* rsrc = RESID_ORIG ? xrow_ptr(p, row) : (xf + (size_t)row * 1024);
#pragma unroll
          for (int bj = 0; bj < 2; ++bj)
#pragma unroll
            for (int n = 0; n < 2; ++n) {
              const int col = n0 + bj * 128 + wc * 32 + n * 16 + fq * 4;
              const float4 xr = *(const float4*)(rsrc + col);
              float4 v;
              v.x = xr.x + factor * acc[ai][bj][m][n][0]; v.y = xr.y + factor * acc[ai][bj][m][n][1];
              v.z = xr.z + factor * acc[ai][bj][m][n][2]; v.w = xr.w + factor * acc[ai][bj][m][n][3];
              *(float4*)(xf + (size_t)row * 1024 + col) = v;
              *(uint2*)(xb + (size_t)row * 1024 + col) = make_uint2(pack2(v.x, v.y), pack2(v.z, v.w));
              part += v.x * v.x + v.y * v.y + v.z * v.z + v.w * v.w;
            }
        }
        part += shx(part, 16); part += shx(part, 32);
        if (ok && fq == 0) sspo[(size_t)row * 16 + pn * 4 + wc] = part;
      }
  }
  if (splitmode) {
    gbar(p, smem);
    const int t = tid_opaque(), lane = t & 63;
    const int wv = vbid * 8 + (t >> 6);
    const float* px_ = p.in[0]; const float* ps_ = p.in[1];
    for (int rr = wv; rr < T - 16384; rr += 256 * 8) {
      const int row = 16384 + rr;
      const float* rsrc = RESID_ORIG ? (row < TP ? px_ + (size_t)(8192 + row - NTOKP - 16) * 1024 : ps_ + (size_t)(row - TP) * 1024) : (xf + (size_t)row * 1024);
      float ss = 0.f;
#pragma unroll
      for (int i = 0; i < 4; ++i) {
        const int col = (lane + 64 * i) * 4;
        float4 sum = make_float4(0.f, 0.f, 0.f, 0.f);
        for (int sl = 0; sl < nslice; ++sl) {
          const float4 q = *(const float4*)(part_buf + ((size_t)sl * 768 + rr) * 1024 + col);
          sum.x += q.x; sum.y += q.y; sum.z += q.z; sum.w += q.w;
        }
        const float4 xr = *(const float4*)(rsrc + col);
        float4 v;
        v.x = xr.x + factor * sum.x; v.y = xr.y + factor * sum.y; v.z = xr.z + factor * sum.z; v.w = xr.w + factor * sum.w;
        *(float4*)(xf + (size_t)row * 1024 + col) = v;
        *(uint2*)(xb + (size_t)row * 1024 + col) = make_uint2(pack2(v.x, v.y), pack2(v.z, v.w));
        ss += v.x * v.x + v.y * v.y + v.z * v.z + v.w * v.w;
      }
#pragma unroll
      for (int mm = 32; mm >= 1; mm >>= 1) ss += shx(ss, mm);
      if (lane < 16) sspo[(size_t)row * 16 + lane] = lane == 0 ? ss : 0.f;
    }
  }
}

template <int RESID_ORIG>
DI void phase_resid(const Params& p, char* smem, const u16* A, int lda, int K, size_t off_w, float factor, size_t off_ssp_out, int vbid) {
  const u16* B = (const u16*)(p.ws + off_w);
  float* xf = (float*)(p.ws + OFF_XF);
  u16* xb = (u16*)(p.ws + OFF_XB);
  float* sspo = (float*)(p.ws + off_ssp_out);
  G_DECL
  const int nr = gemm_rounds(8);
  int it = 0, m0 = 0, n0 = 0;
  while (it < nr && !gemm_tile(vbid, it, 8, m0, n0)) ++it;
  if (it < nr) G_ISSUE(A, lda, B, K, m0, n0, (const float*)nullptr)
  while (it < nr) {
    f32x16 acc[2][2]; zero_acc(acc);
    G_RUN(A, lda, B, K, K, m0, n0, (u16*)smem, acc, true)
    const int cm0 = m0, cn0 = n0; const int nt = cn0 >> 7;
    ++it;
    while (it < nr && !gemm_tile(vbid, it, 8, m0, n0)) ++it;
    if (it < nr) G_ISSUE(A, lda, B, K, m0, n0, (const float*)nullptr)
    const int t = tid_opaque(), lane = t & 63, w = t >> 6, wm = w >> 1, wn = w & 1, lr = lane & 31, lh = lane >> 5;
#pragma unroll
    for (int mi = 0; mi < 2; ++mi) {
      const int row = cm0 + wm * 64 + mi * 32 + lr;
      const bool ok = row < T;
      float part = 0.f;
      if (ok) {
        const float* rsrc = RESID_ORIG ? xrow_ptr(p, row) : (xf + (size_t)row * 1024);
#pragma unroll
        for (int ni = 0; ni < 2; ++ni)
#pragma unroll
          for (int g = 0; g < 4; ++g) {
            const int col = cn0 + wn * 64 + ni * 32 + 8 * g + 4 * lh;
            const float4 xr = *(const float4*)(rsrc + col);
            float4 v;
            v.x = xr.x + factor * acc[mi][ni][4 * g]; v.y = xr.y + factor * acc[mi][ni][4 * g + 1];
            v.z = xr.z + factor * acc[mi][ni][4 * g + 2]; v.w = xr.w + factor * acc[mi][ni][4 * g + 3];
            *(float4*)(xf + (size_t)row * 1024 + col) = v;
            *(uint2*)(xb + (size_t)row * 1024 + col) = make_uint2(pack2(v.x, v.y), pack2(v.z, v.w));
            part += v.x * v.x + v.y * v.y + v.z * v.z + v.w * v.w;
          }
      }
      part += shx(part, 32);
      if (ok && lh == 0) sspo[(size_t)row * 16 + nt * 2 + wn] = part;
    }
  }
}

DI void phase_win(const Params& p, char* smem, int vbid) {
  const u16* A = (const u16*)(p.ws + OFF_XB);
  const u16* B = (const u16*)(p.ws + OFF_WIN);
  const float* ssp = (const float*)(p.ws + OFF_SSP1);
  const float2* tab = (const float2*)(p.ws + OFF_TAB);
  u16* AQ = (u16*)(p.ws + OFF_AQ); u16* BQ = (u16*)(p.ws + OFF_BQ); u16* IQ = (u16*)(p.ws + OFF_IQ);
  float* IW = (float*)(p.ws + OFF_IW); u16* G = (u16*)(p.ws + OFF_G);
  float* out = p.out;
  float* rs_all = (float*)(smem + RS_OFF);
  G_DECL
  const int nr = gemm_rounds(69);
  int it = 0, m0n = 0, n0n = 0, par = 0;
  while (it < nr && !gemm_tile(vbid, it, 69, m0n, n0n)) ++it;
  while (it < nr) {
    float* rs_s = rs_all + par * 256; par ^= 1;
    load_rs(ssp, m0n, rs_s);
    G_ISSUE(A, 1024, B, 1024, m0n, n0n, (const float*)nullptr)
    f32x16 acc[2][2]; zero_acc(acc);
    const int vgw = __builtin_amdgcn_readfirstlane((n0n >> 6) + ((tid_opaque() >> 6) & 1));
    const bool swapw = !((vgw >= 32 && vgw < 48) || (vgw >= 80 && vgw < 96));
    if (swapw) G_RUN(A, 1024, B, 1024, 1024, m0n, n0n, (u16*)smem, acc, true)
    else G_RUN(A, 1024, B, 1024, 1024, m0n, n0n, (u16*)smem, acc, false)
    const int m0 = m0n, n0 = n0n;
    const int t = tid_opaque(), lane = t & 63, w = t >> 6, wm = w >> 1, wn = w & 1, lr = lane & 31, lh = lane >> 5;
    const int vg = vgw;
    if (!swapw) {
      const int q = vg < 48 ? vg - 32 : vg - 80;
      u16* vtb = (u16*)(p.ws + (vg < 48 ? OFF_AVT : OFF_BVT));
#pragma unroll
      for (int mi = 0; mi < 2; ++mi)
#pragma unroll
        for (int g = 0; g < 4; ++g) {
          const int rl = wm * 64 + mi * 32 + 8 * g + 4 * lh; const int row = m0 + rl;
          if (row < TP) {
            const int bb = row >= NTOKP ? 1 : 0; const int tok = row - bb * NTOKP;
            const float r0 = rs_s[rl], r1 = rs_s[rl + 1], r2 = rs_s[rl + 2], r3 = rs_s[rl + 3];
#pragma unroll
            for (int ni = 0; ni < 2; ++ni) {
              const int d = (q & 1) * 64 + ni * 32 + lr;
              u16* dst = vtb + ((size_t)(bb * 8 + (q >> 1)) * 128 + d) * VTPAD + tok;
              *(uint2*)dst = make_uint2(pack2(acc[mi][ni][4 * g] * r0, acc[mi][ni][4 * g + 1] * r1),
                                        pack2(acc[mi][ni][4 * g + 2] * r2, acc[mi][ni][4 * g + 3] * r3));
            }
          }
        }
#pragma unroll
      for (int mi = 0; mi < 2; ++mi)
#pragma unroll
        for (int i = 0; i < 16; ++i) {
          const int rl = wm * 64 + mi * 32 + crow(i, lh); const int row = m0 + rl;
          if (row >= T) continue;
          const float r = rs_s[rl];
          const float v0 = acc[mi][0][i] * r, v1 = acc[mi][1][i] * r;
          const bool smp = row >= TP;
          const int orow = smp ? row - TP : row;
          float* d = out + (vg < 48 ? (smp ? O_AVS : O_AVP) : (smp ? O_BVS : O_BVP)) + (size_t)orow * 1024 + q * 64 + lr;
          d[0] = v0; d[32] = v1;
        }
    } else {
#pragma unroll
      for (int mi = 0; mi < 2; ++mi) {
        int rl = wm * 64 + mi * 32 + lr;
        asm volatile("" : "+v"(rl));
        const int row = m0 + rl;
        if (row >= T) continue;
        const float r = rs_s[rl];
        const bool smp = row >= TP;
        const int orow = smp ? row - TP : row;
        const int bb = (!smp && row >= NTOKP) ? 1 : 0;
        const int tok = row - bb * NTOKP;
        const int pos = smp ? (NCACHE + (orow & 31)) : tok;
#pragma unroll
        for (int g = 0; g < 4; ++g) {
          const int c0 = 8 * g + 4 * lh;
          float v0[4], v1[4];
#pragma unroll
          for (int j = 0; j < 4; ++j) { v0[j] = acc[mi][0][4 * g + j] * r; v1[j] = acc[mi][1][4 * g + j] * r; }
          if (vg < 32 || (vg >= 96 && vg < 105)) {
            float o0[4], o1[4];
#pragma unroll
            for (int j = 0; j < 4; ++j) {
              const float2 cs = tab[pos * 64 + 2 * (c0 + j)];
              o0[j] = v0[j] * cs.x - v1[j] * cs.y; o1[j] = v1[j] * cs.x + v0[j] * cs.y;
            }
            if (vg < 16) {
              u16* d = AQ + (size_t)row * 1024 + vg * 64 + c0;
              *(uint2*)d = make_uint2(pack2(o0[0] * QA_SCALE, o0[1] * QA_SCALE), pack2(o0[2] * QA_SCALE, o0[3] * QA_SCALE));
              *(uint2*)(d + 32) = make_uint2(pack2(o1[0] * QA_SCALE, o1[1] * QA_SCALE), pack2(o1[2] * QA_SCALE, o1[3] * QA_SCALE));
            } else if (vg < 32) {
              float* d = out + (smp ? O_AKS : O_AKP) + (size_t)orow * 1024 + (vg - 16) * 64 + c0;
              *(float4*)d = make_float4(o0[0], o0[1], o0[2], o0[3]);
              *(float4*)(d + 32) = make_float4(o1[0], o1[1], o1[2], o1[3]);
              if (!smp) {
                const int q = vg - 16;
                u16* db = (u16*)(p.ws + OFF_AKB) + ((size_t)(bb * 8 + (q >> 1)) * NTOKP + tok) * 128 + (q & 1) * 64 + c0;
                *(uint2*)db = make_uint2(pack2(o0[0], o0[1]), pack2(o0[2], o0[3]));
                *(uint2*)(db + 32) = make_uint2(pack2(o1[0], o1[1]), pack2(o1[2], o1[3]));
              }
            } else if (vg < 104) {
              u16* d = IQ + (size_t)row * 512 + (vg - 96) * 64 + c0;
              *(uint2*)d = make_uint2(pack2(o0[0], o0[1]), pack2(o0[2], o0[3]));
              *(uint2*)(d + 32) = make_uint2(pack2(o1[0], o1[1]), pack2(o1[2], o1[3]));
            } else {
              float* d = out + (smp ? O_IKS : O_IKP) + (size_t)orow * 64 + c0;
              *(float4*)d = make_float4(o0[0], o0[1], o0[2], o0[3]);
              *(float4*)(d + 32) = make_float4(o1[0], o1[1], o1[2], o1[3]);
              if (!smp) {
                u16* db = (u16*)(p.ws + OFF_IKB) + (size_t)row * 64 + c0;
                *(uint2*)db = make_uint2(pack2(o0[0], o0[1]), pack2(o0[2], o0[3]));
                *(uint2*)(db + 32) = make_uint2(pack2(o1[0], o1[1]), pack2(o1[2], o1[3]));
              }
            }
          } else if (vg < 80) {
            const int q = vg < 64 ? vg - 48 : vg - 64; const int hh = q >> 1, gi = q & 1;
            float o0[4], o1[4];
            const float4* tp = (const float4*)(tab + pos * 64 + gi * 32 + c0);
            const float4 t01 = tp[0], t23 = tp[1];
            o0[0] = v0[0] * t01.x - v1[0] * t01.y; o1[0] = v1[0] * t01.x + v0[0] * t01.y;
            o0[1] = v0[1] * t01.z - v1[1] * t01.w; o1[1] = v1[1] * t01.z + v0[1] * t01.w;
            o0[2] = v0[2] * t23.x - v1[2] * t23.y; o1[2] = v1[2] * t23.x + v0[2] * t23.y;
            o0[3] = v0[3] * t23.z - v1[3] * t23.w; o1[3] = v1[3] * t23.z + v0[3] * t23.w;
            if (vg < 64) {
              u16* d = BQ + (size_t)row * 1024 + hh * 128 + gi * 32 + c0;
              *(uint2*)d = make_uint2(pack2(o0[0] * QB_SCALE, o0[1] * QB_SCALE), pack2(o0[2] * QB_SCALE, o0[3] * QB_SCALE));
              *(uint2*)(d + 64) = make_uint2(pack2(o1[0] * QB_SCALE, o1[1] * QB_SCALE), pack2(o1[2] * QB_SCALE, o1[3] * QB_SCALE));
            } else {
              float* d = out + (smp ? O_BKS : O_BKP) + (size_t)orow * 1024 + hh * 128 + gi * 32 + c0;
              *(float4*)d = make_float4(o0[0], o0[1], o0[2], o0[3]);
              *(float4*)(d + 64) = make_float4(o1[0], o1[1], o1[2], o1[3]);
              if (!smp) {
                u16* db = (u16*)(p.ws + OFF_BKB) + ((size_t)(bb * 8 + hh) * NTOKP + tok) * 128 + gi * 32 + c0;
                *(uint2*)db = make_uint2(pack2(o0[0], o0[1]), pack2(o0[2], o0[3]));
                *(uint2*)(db + 64) = make_uint2(pack2(o1[0], o1[1]), pack2(o1[2], o1[3]));
              }
            }
          } else if (vg == 105) {
            if (g == 0) *(float4*)(IW + (size_t)row * 8 + c0) = make_float4(v0[0] * IW_SCALE, v0[1] * IW_SCALE, v0[2] * IW_SCALE, v0[3] * IW_SCALE);
          } else {
            u16* d = G + (size_t)row * 2048 + (vg - 106) * 64 + c0;
            float s0[4], s1[4];
#pragma unroll
            for (int j = 0; j < 4; ++j) { s0[j] = 1.0f / (1.0f + __expf(-v0[j])); s1[j] = 1.0f / (1.0f + __expf(-v1[j])); }
            *(uint2*)d = make_uint2(pack2(s0[0], s0[1]), pack2(s0[2], s0[3]));
            *(uint2*)(d + 32) = make_uint2(pack2(s1[0], s1[1]), pack2(s1[2], s1[3]));
          }
          __builtin_amdgcn_sched_barrier(0);
        }
      }
    }
    ++it;
    while (it < nr && !gemm_tile(vbid, it, 69, m0n, n0n)) ++it;
  }
}

DI void phase_win8(const Params& p, char* smem, int vbid) {
  const u16* A = (const u16*)(p.ws + OFF_XB);
  const u16* B = (const u16*)(p.ws + OFF_WIN);
  const float* ssp = (const float*)(p.ws + OFF_SSP1);
  const float2* tab = (const float2*)(p.ws + OFF_TAB);
  u16* AQ = (u16*)(p.ws + OFF_AQ); u16* BQ = (u16*)(p.ws + OFF_BQ); u16* IQ = (u16*)(p.ws + OFF_IQ);
  float* IW = (float*)(p.ws + OFF_IW); u16* Gt = (u16*)(p.ws + OFF_G);
  float* out = p.out;
  float* rs_s = (float*)(smem + RS8_OFF);
  const int nr = gemm_rounds(35);
  for (int it = 0; it < nr; ++it) {
    int m0, n0;
    if (!gemm_tile(vbid, it, 35, m0, n0)) continue;
    n0 *= 2;
    load_rs(ssp, m0, rs_s);
    __syncthreads();
    f32x4 acc[2][2][4][2];
#pragma unroll
    for (int a_ = 0; a_ < 2; ++a_)
#pragma unroll
      for (int b_ = 0; b_ < 2; ++b_)
#pragma unroll
        for (int m_ = 0; m_ < 4; ++m_)
#pragma unroll
          for (int n_ = 0; n_ < 2; ++n_) acc[a_][b_][m_][n_] = (f32x4){0.f, 0.f, 0.f, 0.f};
    gemm8_tile(A, B, 1024, m0, n0, (u16*)smem, acc);
    const int t = tid_opaque(), lane = t & 63, wid = __builtin_amdgcn_readfirstlane(t >> 6), wr = wid >> 2, wc = wid & 3, fr = lane & 15, fq = lane >> 4;
    const int o = fq * 4;
#pragma unroll
    for (int bj = 0; bj < 2; ++bj) {
      const int G = (n0 >> 5) + bj * 4 + wc;
      if (G >= 275) continue;
#pragma unroll
      for (int ai = 0; ai < 2; ++ai)
#pragma unroll
        for (int m = 0; m < 4; ++m) {
          int rl = ai * 128 + wr * 64 + m * 16 + fr;
          asm volatile("" : "+v"(rl));
          const int row = m0 + rl;
          if (row >= T) continue;
          const float r = rs_s[rl];
          const bool smp = row >= TP;
          const int orow = smp ? row - TP : row;
          const int bb = (!smp && row >= NTOKP) ? 1 : 0;
          const int tok = row - bb * NTOKP;
          const int pos = smp ? (NCACHE + (orow & 31)) : tok;
          float v0[4], v1[4];
#pragma unroll
          for (int j = 0; j < 4; ++j) { v0[j] = acc[ai][bj][m][0][j] * r; v1[j] = acc[ai][bj][m][1][j] * r; }
          if (G < 64 || (G >= 192 && G < 210)) {
            const int q = G < 64 ? (G & 31) : (G < 208 ? G - 192 : G - 208);
            const int g = G < 208 ? (q & 1) : q;
            const int hd = G < 208 ? (q >> 1) : 0;
            const int d0 = 16 * g + o;
            float o0[4], o1[4];
#pragma unroll
            for (int j = 0; j < 4; ++j) {
              const float2 cs = tab[pos * 64 + 2 * (d0 + j)];
              o0[j] = v0[j] * cs.x - v1[j] * cs.y; o1[j] = v1[j] * cs.x + v0[j] * cs.y;
            }
            if (G < 32) {
              u16* d = AQ + (size_t)row * 1024 + hd * 64 + d0;
              *(uint2*)d = make_uint2(pack2(o0[0] * QA_SCALE, o0[1] * QA_SCALE), pack2(o0[2] * QA_SCALE, o0[3] * QA_SCALE));
              *(uint2*)(d + 32) = make_uint2(pack2(o1[0] * QA_SCALE, o1[1] * QA_SCALE), pack2(o1[2] * QA_SCALE, o1[3] * QA_SCALE));
            } else if (G < 64) {
              float* d = out + (smp ? O_AKS : O_AKP) + (size_t)orow * 1024 + hd * 64 + d0;
              *(float4*)d = make_float4(o0[0], o0[1], o0[2], o0[3]);
              *(float4*)(d + 32) = make_float4(o1[0], o1[1], o1[2], o1[3]);
              if (!smp) {
                u16* db = (u16*)(p.ws + OFF_AKB) + ((size_t)(bb * 8 + (hd >> 1)) * NTOKP + tok) * 128 + (hd & 1) * 64 + d0;
                *(uint2*)db = make_uint2(pack2(o0[0], o0[1]), pack2(o0[2], o0[3]));
                *(uint2*)(db + 32) = make_uint2(pack2(o1[0], o1[1]), pack2(o1[2], o1[3]));
              }
            } else if (G < 208) {
              u16* d = IQ + (size_t)row * 512 + hd * 64 + d0;
              *(uint2*)d = make_uint2(pack2(o0[0], o0[1]), pack2(o0[2], o0[3]));
              *(uint2*)(d + 32) = make_uint2(pack2(o1[0], o1[1]), pack2(o1[2], o1[3]));
            } else {
              float* d = out + (smp ? O_IKS : O_IKP) + (size_t)orow * 64 + d0;
              *(float4*)d = make_float4(o0[0], o0[1], o0[2], o0[3]);
              *(float4*)(d + 32) = make_float4(o1[0], o1[1], o1[2], o1[3]);
              if (!smp) {
                u16* db = (u16*)(p.ws + OFF_IKB) + (size_t)row * 64 + d0;
                *(uint2*)db = make_uint2(pack2(o0[0], o0[1]), pack2(o0[2], o0[3]));
                *(uint2*)(db + 32) = make_uint2(pack2(o1[0], o1[1]), pack2(o1[2], o1[3]));
              }
            }
          } else if (G >= 96 && G < 160) {
            const int q = (G - 96) & 31; const int hh = q >> 2, g = q & 3;
            const int d0 = 16 * g + o;
            const float4* tp = (const float4*)(tab + pos * 64 + d0);
            const float4 t01 = tp[0], t23 = tp[1];
            float o0[4], o1[4];
            o0[0] = v0[0] * t01.x - v1[0] * t01.y; o1[0] = v1[0] * t01.x + v0[0] * t01.y;
            o0[1] = v0[1] * t01.z - v1[1] * t01.w; o1[1] = v1[1] * t01.z + v0[1] * t01.w;
            o0[2] = v0[2] * t23.x - v1[2] * t23.y; o1[2] = v1[2] * t23.x + v0[2] * t23.y;
            o0[3] = v0[3] * t23.z - v1[3] * t23.w; o1[3] = v1[3] * t23.z + v0[3] * t23.w;
            if (G < 128) {
              u16* d = BQ + (size_t)row * 1024 + hh * 128 + d0;
              *(uint2*)d = make_uint2(pack2(o0[0] * QB_SCALE, o0[1] * QB_SCALE), pack2(o0[2] * QB_SCALE, o0[3] * QB_SCALE));
              *(uint2*)(d + 64) = make_uint2(pack2(o1[0] * QB_SCALE, o1[1] * QB_SCALE), pack2(o1[2] * QB_SCALE, o1[3] * QB_SCALE));
            } else {
              float* d = out + (smp ? O_BKS : O_BKP) + (size_t)orow * 1024 + hh * 128 + d0;
              *(float4*)d = make_float4(o0[0], o0[1], o0[2], o0[3]);
              *(float4*)(d + 64) = make_float4(o1[0], o1[1], o1[2], o1[3]);
              if (!smp) {
                u16* db = (u16*)(p.ws + OFF_BKB) + ((size_t)(bb * 8 + hh) * NTOKP + tok) * 128 + d0;
                *(uint2*)db = make_uint2(pack2(o0[0], o0[1]), pack2(o0[2], o0[3]));
                *(uint2*)(db + 64) = make_uint2(pack2(o1[0], o1[1]), pack2(o1[2], o1[3]));
              }
            }
          } else if (G < 192) {
            const bool isa = G < 96;
            const int c = (isa ? (G - 64) : (G - 160)) * 32 + o;
            float* d = out + (isa ? (smp ? O_AVS : O_AVP) : (smp ? O_BVS : O_BVP)) + (size_t)orow * 1024 + c;
            *(float4*)d = make_float4(v0[0], v0[1], v0[2], v0[3]);
            *(float4*)(d + 16) = make_float4(v1[0], v1[1], v1[2], v1[3]);
            if (!smp) {
              u16* vt = (u16*)(p.ws + (isa ? OFF_AVT : OFF_BVT)) + ((size_t)(bb * 8 + (c >> 7)) * 128 + (c & 127)) * VTPAD + tok;
#pragma unroll
              for (int j = 0; j < 4; ++j) { vt[(size_t)j * VTPAD] = f2bf(v0[j]); vt[(size_t)(16 + j) * VTPAD] = f2bf(v1[j]); }
            }
          } else if (G == 210) {
            if (fq < 2) *(float4*)(IW + (size_t)row * 8 + o) = make_float4(v0[0] * IW_SCALE, v0[1] * IW_SCALE, v0[2] * IW_SCALE, v0[3] * IW_SCALE);
          } else {
            u16* d = Gt + (size_t)row * 2048 + (G - 211) * 32 + o;
            float s0[4], s1[4];
#pragma unroll
            for (int j = 0; j < 4; ++j) { s0[j] = 1.0f / (1.0f + __expf(-v0[j])); s1[j] = 1.0f / (1.0f + __expf(-v1[j])); }
            *(uint2*)d = make_uint2(pack2(s0[0], s0[1]), pack2(s0[2], s0[3]));
            *(uint2*)(d + 16) = make_uint2(pack2(s1[0], s1[1]), pack2(s1[2], s1[3]));
          }
        }
    }
  }
}

DI void phase_merge(const Params& p, char* smem, int vbid) {
  const u16* OA = (const u16*)(p.ws + OFF_OA); const u16* OB = (const u16*)(p.ws + OFF_OB);
  const u16* WA = (const u16*)(p.ws + OFF_WA); const u16* WB = (const u16*)(p.ws + OFF_WB);
  const u16* G = (const u16*)(p.ws + OFF_G);
  u16* MB = (u16*)(p.ws + OFF_MB);
  G_DECL
  const int nr = gemm_rounds(8);
  int it = 0, m0n = 0, n0n = 0;
  while (it < nr && !gemm_tile(vbid, it, 8, m0n, n0n)) ++it;
  if (it < nr) G_ISSUE(OA, 1024, WA, 1024, m0n, n0n, (const float*)nullptr)
  while (it < nr) {
    const int m0 = m0n, n0 = n0n;
    f32x16 acc[2][2], acc2[2][2]; zero_acc(acc); zero_acc(acc2);
    G_RUN(OA, 1024, WA, 1024, 1024, m0, n0, (u16*)smem, acc, true)
    G_ISSUE(OB, 1024, WB, 1024, m0, n0, (const float*)nullptr)
    G_RUN(OB, 1024, WB, 1024, 1024, m0, n0, (u16*)smem, acc2, true)
    ++it;
    while (it < nr && !gemm_tile(vbid, it, 8, m0n, n0n)) ++it;
    if (it < nr) G_ISSUE(OA, 1024, WA, 1024, m0n, n0n, (const float*)nullptr)
    const int t = tid_opaque(), lane = t & 63, w = t >> 6, wm = w >> 1, wn = w & 1, lr = lane & 31, lh = lane >> 5;
#pragma unroll
    for (int mi = 0; mi < 2; ++mi) {
      const int row = m0 + wm * 64 + mi * 32 + lr;
      if (row >= T) continue;
#pragma unroll
      for (int ni = 0; ni < 2; ++ni)
#pragma unroll
        for (int g = 0; g < 4; ++g) {
          const int col = n0 + wn * 64 + ni * 32 + 8 * g + 4 * lh;
          const uint2 ga = *(const uint2*)(G + (size_t)row * 2048 + col);
          const uint2 gb = *(const uint2*)(G + (size_t)row * 2048 + 1024 + col);
          const float m0v = __uint_as_float(ga.x << 16) * acc[mi][ni][4 * g] + __uint_as_float(gb.x << 16) * acc2[mi][ni][4 * g];
          const float m1v = __uint_as_float(ga.x & 0xffff0000u) * acc[mi][ni][4 * g + 1] + __uint_as_float(gb.x & 0xffff0000u) * acc2[mi][ni][4 * g + 1];
          const float m2v = __uint_as_float(ga.y << 16) * acc[mi][ni][4 * g + 2] + __uint_as_float(gb.y << 16) * acc2[mi][ni][4 * g + 2];
          const float m3v = __uint_as_float(ga.y & 0xffff0000u) * acc[mi][ni][4 * g + 3] + __uint_as_float(gb.y & 0xffff0000u) * acc2[mi][ni][4 * g + 3];
          *(uint2*)(MB + (size_t)row * 1024 + col) = make_uint2(pack2(m0v, m1v), pack2(m2v, m3v));
        }
    }
  }
}

template <int MODE>
DI void attn_item(const Params& p, char* smem, int grp, int b, int h, int q0, int nqv, float lam) {
  int t_ = threadIdx.x;
  asm volatile("" : "+v"(t_));
  const int t = t_, lane = t & 63, w = __builtin_amdgcn_readfirstlane(t >> 6), lr = lane & 31, lh = lane >> 5;
  u16* Ks = (u16*)smem;
  u16* Vt = Ks + 64 * 136;
  u16* Qs = Vt + 128 * 72;
  constexpr int NQB = MODE == 0 ? 128 : 256;
  constexpr int KS = MODE == 0 ? 4 : 8;
  const int NK = grp ? NKS : NTOKP;
  const int qsub = MODE == 0 ? (w >> 1) : w;
  const int map = MODE == 0 ? (w & 1) : 0;
  const int qw0 = q0 + qsub * 32;
  const bool wact = (qsub * 32) < nqv;
  int Lw = 0;
  if (wact) Lw = grp ? NKS : (qw0 < 16 ? 16 : 16 + 64 * (((qw0 - 16) >> 6) + 1));
  const int tql = q0 + nqv - 1;
  const int Lblk = grp ? NKS : (tql < 16 ? 16 : 16 + 64 * (((tql - 16) >> 6) + 1));
  const int nkt = (Lblk + 63) >> 6;
  const int ql = qsub * 32 + lr;
  const int tq = q0 + (ql < nqv ? ql : nqv - 1);
  const size_t gr = grp ? (size_t)TP + b * 32 + tq : (size_t)b * NTOKP + tq;
  __syncthreads();
  bf16x8 qf[KS];
  {
    const u16* Qg = (const u16*)(p.ws + (MODE == 0 ? OFF_AQ : OFF_BQ)) + gr * 1024 + h * 128 + map * 64 + lh * 8;
#pragma unroll
    for (int ks = 0; ks < KS; ++ks) qf[ks] = *(const bf16x8*)(Qg + ks * 16);
  }
  const u64* mrow = nullptr;
  if (MODE == 1) mrow = grp ? (const u64*)(p.ws + OFF_MASKS) + ((size_t)b * 32 + tq) * NWS : (const u64*)(p.ws + OFF_MASKP) + gr * NWP;
  f32x16 O[4];
  float mrun = -1e30f, lrun = 0.f;
#pragma unroll
  for (int db = 0; db < 4; ++db)
#pragma unroll
    for (int i = 0; i < 16; ++i) O[db][i] = 0.f;
  const int kwhich = MODE == 0 ? 0 : 2;
  const u16* Kg = (const u16*)(p.ws + (MODE == 0 ? OFF_AKB : OFF_BKB)) + (size_t)(b * 8 + h) * NTOKP * 128 + (t & 15) * 8;
  const u16* Vg = (const u16*)(p.ws + (MODE == 0 ? OFF_AVT : OFF_BVT)) + ((size_t)(b * 8 + h) * 128 + (t >> 3)) * VTPAD + (t & 7) * 8;
  const int kkey = t >> 4;
  uint4 sa0, sa1, sa2, sa3, sb0, sb1, sb2, sb3, sc0, sc1, sc2, sc3;
  u64 ma = 0, mb = 0, mc = 0;
  sa0 = sa1 = sa2 = sa3 = sb0 = sb1 = sb2 = sb3 = sc0 = sc1 = sc2 = sc3 = make_uint4(0, 0, 0, 0);
  auto issue = [&](int kt, uint4& r0, uint4& r1, uint4& r2, uint4& r3, u64& mwr) {
    if (!grp && kt < nkt) {
      int k0 = kt * 64 + kkey, k1 = k0 + 32;
      k0 = k0 < NTOKP ? k0 : NTOKP - 1; k1 = k1 < NTOKP ? k1 : NTOKP - 1;
      r0 = *(const uint4*)(Kg + (size_t)k0 * 128); r1 = *(const uint4*)(Kg + (size_t)k1 * 128);
      const u16* vp = Vg + kt * 64;
      r2 = *(const uint4*)(vp); r3 = *(const uint4*)(vp + (size_t)64 * VTPAD);
    }
    if (MODE == 1 && kt < nkt) mwr = mrow[kt];
  };
  constexpr int ATT_BUF = 64 * 136 + 128 * 72;
  auto fill = [&](int kt, uint4& r0, uint4& r1, uint4& r2, uint4& r3) {
    u16* Ks = (u16*)smem + (kt & 1) * ATT_BUF; u16* Vt = Ks + 64 * 136;
    if (!grp) {
      *(uint4*)(Ks + kkey * 136 + (t & 15) * 8) = r0; *(uint4*)(Ks + (kkey + 32) * 136 + (t & 15) * 8) = r1;
      *(uint4*)(Vt + (t >> 3) * 72 + (t & 7) * 8) = r2; *(uint4*)(Vt + ((t >> 3) + 64) * 72 + (t & 7) * 8) = r3;
    } else {
#pragma unroll
      for (int i = 0; i < 4; ++i) {
        const int c = t + NTHR * i; const int key = c >> 5, d4 = c & 31;
        int tk = kt * 64 + key; tk = tk < NK ? tk : NK - 1;
        const float4 v = *(const float4*)(kv_row(p, grp, b, tk, kwhich) + h * 128 + d4 * 4);
        *(uint2*)(Ks + key * 136 + d4 * 4) = make_uint2(pack2(v.x, v.y), pack2(v.z, v.w));
      }
      {
        const int kq = t >> 5, d4 = t & 31;
        float4 x[4];
#pragma unroll
        for (int j = 0; j < 4; ++j) {
          int tk = kt * 64 + kq * 4 + j; tk = tk < NK ? tk : NK - 1;
          x[j] = *(const float4*)(kv_row(p, grp, b, tk, kwhich + 1) + h * 128 + d4 * 4);
        }
        u16* vd = Vt + (d4 * 4) * 72 + kq * 4;
        *(uint2*)(vd) = make_uint2(pack2(x[0].x, x[1].x), pack2(x[2].x, x[3].x));
        *(uint2*)(vd + 72) = make_uint2(pack2(x[0].y, x[1].y), pack2(x[2].y, x[3].y));
        *(uint2*)(vd + 144) = make_uint2(pack2(x[0].z, x[1].z), pack2(x[2].z, x[3].z));
        *(uint2*)(vd + 216) = make_uint2(pack2(x[0].w, x[1].w), pack2(x[2].w, x[3].w));
      }
    }
  };
  auto step = [&](int kt, uint4& r0, uint4& r1, uint4& r2, uint4& r3, u64& mwr, uint4& n0, uint4& n1, uint4& n2, uint4& n3) {
    const u64 mw = mwr;
    u16* Ks = (u16*)smem + (kt & 1) * ATT_BUF; u16* Vt = Ks + 64 * 136;
    if (kt + 1 < nkt) fill(kt + 1, n0, n1, n2, n3);
    issue(kt + 3, r0, r1, r2, r3, mwr);
    if (wact && kt * 64 < Lw) {
      f32x16 st0, st1;
#pragma unroll
      for (int i = 0; i < 16; ++i) { st0[i] = 0.f; st1[i] = 0.f; }
#pragma unroll
      for (int ks = 0; ks < KS; ++ks) {
        const bf16x8 k0 = *(const bf16x8*)(Ks + lr * 136 + map * 64 + ks * 16 + lh * 8);
        const bf16x8 k1 = *(const bf16x8*)(Ks + (32 + lr) * 136 + map * 64 + ks * 16 + lh * 8);
        st0 = MFMA(k0, qf[ks], st0);
        st1 = MFMA(k1, qf[ks], st1);
      }
      if (MODE == 0) {
        if (kt * 64 + 64 > Lw) {
#pragma unroll
          for (int i = 0; i < 16; ++i) {
            const int key = kt * 64 + crow(i, lh);
            if (key >= Lw) st0[i] = -INFINITY;
            if (key + 32 >= Lw) st1[i] = -INFINITY;
          }
        }
      } else {
        const unsigned lo = (unsigned)mw >> (4 * lh), hi = (unsigned)(mw >> 32) >> (4 * lh);
#pragma unroll
        for (int i = 0; i < 16; ++i) {
          const int bit = (i & 3) + 8 * (i >> 2);
          if (!((lo >> bit) & 1u)) st0[i] = -INFINITY;
          if (!((hi >> bit) & 1u)) st1[i] = -INFINITY;
        }
      }
      float tm0 = __builtin_fmaxf(__builtin_fmaxf(st0[0], st0[1]), st0[2]), tm1 = __builtin_fmaxf(__builtin_fmaxf(st0[8], st0[9]), st0[10]);
      float tm2 = __builtin_fmaxf(__builtin_fmaxf(st1[0], st1[1]), st1[2]), tm3 = __builtin_fmaxf(__builtin_fmaxf(st1[8], st1[9]), st1[10]);
      tm0 = __builtin_fmaxf(__builtin_fmaxf(tm0, st0[3]), st0[4]); tm1 = __builtin_fmaxf(__builtin_fmaxf(tm1, st0[11]), st0[12]);
      tm2 = __builtin_fmaxf(__builtin_fmaxf(tm2, st1[3]), st1[4]); tm3 = __builtin_fmaxf(__builtin_fmaxf(tm3, st1[11]), st1[12]);
      tm0 = __builtin_fmaxf(__builtin_fmaxf(tm0, st0[5]), st0[6]); tm1 = __builtin_fmaxf(__builtin_fmaxf(tm1, st0[13]), st0[14]);
      tm2 = __builtin_fmaxf(__builtin_fmaxf(tm2, st1[5]), st1[6]); tm3 = __builtin_fmaxf(__builtin_fmaxf(tm3, st1[13]), st1[14]);
      tm0 = __builtin_fmaxf(__builtin_fmaxf(tm0, st0[7]), st0[15]); tm2 = __builtin_fmaxf(__builtin_fmaxf(tm2, st1[7]), st1[15]);
      float tmax = __builtin_fmaxf(__builtin_fmaxf(tm0, tm1), __builtin_fmaxf(tm2, tm3));
      tmax = fmaxf(tmax, shx(tmax, 32));
      const bool need = __any(tmax - mrun > 8.0f);
      const float mnew = need ? fmaxf(mrun, tmax) : mrun;
      const float alpha = need ? fexp2(mrun - mnew) : 1.0f;
      mrun = mnew;
      typedef float f32x2p __attribute__((ext_vector_type(2)));
      const f32x2p mneg = {-mnew, -mnew};
      f32x2p psv = {0.f, 0.f};
#pragma unroll
      for (int i = 0; i < 16; i += 2) {
        f32x2p a = {st0[i], st0[i + 1]}, b = {st1[i], st1[i + 1]};
        a += mneg; b += mneg;
        a.x = fexp2(a.x); a.y = fexp2(a.y); b.x = fexp2(b.x); b.y = fexp2(b.y);
        st0[i] = a.x; st0[i + 1] = a.y; st1[i] = b.x; st1[i + 1] = b.y;
        psv += a; psv += b;
      }
      const float ps = psv.x + psv.y;
      lrun = lrun * alpha + ps;
      if (need) {
#pragma unroll
        for (int db = 0; db < 4; ++db)
#pragma unroll
          for (int i = 0; i < 16; ++i) O[db][i] *= alpha;
      }
      bf16x8 pf[4];
#pragma unroll
      for (int c = 0; c < 4; ++c) {
        const unsigned u0 = (c < 2) ? pack2(st0[(c & 1) * 8 + 0], st0[(c & 1) * 8 + 1]) : pack2(st1[(c & 1) * 8 + 0], st1[(c & 1) * 8 + 1]);
        const unsigned u1 = (c < 2) ? pack2(st0[(c & 1) * 8 + 2], st0[(c & 1) * 8 + 3]) : pack2(st1[(c & 1) * 8 + 2], st1[(c & 1) * 8 + 3]);
        const unsigned u2 = (c < 2) ? pack2(st0[(c & 1) * 8 + 4], st0[(c & 1) * 8 + 5]) : pack2(st1[(c & 1) * 8 + 4], st1[(c & 1) * 8 + 5]);
        const unsigned u3 = (c < 2) ? pack2(st0[(c & 1) * 8 + 6], st0[(c & 1) * 8 + 7]) : pack2(st1[(c & 1) * 8 + 6], st1[(c & 1) * 8 + 7]);
        pf[c] = __builtin_bit_cast(bf16x8, make_uint4(u0, u1, u2, u3));
      }
#pragma unroll
      for (int db = 0; db < 4; ++db)
#pragma unroll
        for (int c = 0; c < 4; ++c) {
          const int kk = (c >> 1) * 32 + (c & 1) * 16 + 4 * lh;
          const bf16x4 v0 = *(const bf16x4*)(Vt + (db * 32 + lr) * 72 + kk);
          const bf16x4 v1 = *(const bf16x4*)(Vt + (db * 32 + lr) * 72 + kk + 8);
          const bf16x8 vf = __builtin_shufflevector(v0, v1, 0, 1, 2, 3, 4, 5, 6, 7);
          O[db] = MFMA(vf, pf[c], O[db]);
        }
    }
    __syncthreads();
  };
  issue(0, sa0, sa1, sa2, sa3, ma);
  issue(1, sb0, sb1, sb2, sb3, mb);
  issue(2, sc0, sc1, sc2, sc3, mc);
  fill(0, sa0, sa1, sa2, sa3);
  __syncthreads();
  for (int kt = 0; kt < nkt; kt += 3) {
    step(kt, sa0, sa1, sa2, sa3, ma, sb0, sb1, sb2, sb3);
    if (kt + 1 < nkt) step(kt + 1, sb0, sb1, sb2, sb3, mb, sc0, sc1, sc2, sc3);
    if (kt + 2 < nkt) step(kt + 2, sc0, sc1, sc2, sc3, mc, sa0, sa1, sa2, sa3);
  }
  const float ltot = lrun + shx(lrun, 32);
  const float inv = 1.0f / ltot;
  const bool qok = ql < nqv;
  if (MODE == 0) {
    float* Ex = (float*)smem;
    __syncthreads();
    if (map == 1) {
      const float sc = inv * lam;
#pragma unroll
      for (int db = 0; db < 4; ++db)
#pragma unroll
        for (int i = 0; i < 16; ++i) Ex[(qsub * 128 + db * 32 + crow(i, lh)) * 33 + lr] = O[db][i] * sc;
    }
    __syncthreads();
    if (map == 0) {
      float ss = 0.f;
#pragma unroll
      for (int db = 0; db < 4; ++db)
#pragma unroll
        for (int i = 0; i < 16; ++i) {
          const float v = O[db][i] * inv - Ex[(qsub * 128 + db * 32 + crow(i, lh)) * 33 + lr];
          O[db][i] = v; ss += v * v;
        }
      ss += shx(ss, 32);
      const float rn = rsqrtf(ss * (1.0f / 128.0f) + EPS) * 0.8f;
      const float* sub = p.in[18];
      u16* dst = (u16*)(p.ws + OFF_OA) + gr * 1024 + h * 128;
      if (wact && qok) {
#pragma unroll
        for (int db = 0; db < 4; ++db)
#pragma unroll
          for (int g = 0; g < 4; ++g) {
            const int d = db * 32 + 8 * g + 4 * lh;
            const float4 sg = *(const float4*)(sub + d);
            *(uint2*)(dst + d) = make_uint2(pack2(O[db][4 * g] * rn * sg.x, O[db][4 * g + 1] * rn * sg.y),
                                            pack2(O[db][4 * g + 2] * rn * sg.z, O[db][4 * g + 3] * rn * sg.w));
          }
      }
    }
  } else {
    u16* dst = (u16*)(p.ws + OFF_OB) + gr * 1024 + h * 128;
    if (wact && qok) {
#pragma unroll
      for (int db = 0; db < 4; ++db)
#pragma unroll
        for (int g = 0; g < 4; ++g) {
          const int d = db * 32 + 8 * g + 4 * lh;
          *(uint2*)(dst + d) = make_uint2(pack2(O[db][4 * g] * inv, O[db][4 * g + 1] * inv),
                                          pack2(O[db][4 * g + 2] * inv, O[db][4 * g + 3] * inv));
        }
    }
  }
}

DI unsigned ford(float f) { unsigned u = __float_as_uint(f); return u ^ ((u >> 31) ? 0xFFFFFFFFu : 0x80000000u); }

DI void idx_item(const Params& p, char* smem, int grp, int b, int pidx) {
  int t_ = threadIdx.x;
  asm volatile("" : "+v"(t_));
  const int t = t_, lane = t & 63, w = __builtin_amdgcn_readfirstlane(t >> 6), lr = lane & 31, lh = lane >> 5;
  u16* IQs = (u16*)smem;
  u16* IKs = IQs + 128 * 520;
  float* IWs = (float*)(smem + 133120 + 9216);
  float* SCb = (float*)(p.ws + OFF_SC);
  const int half = w >> 2;
  int q0h[2], nqh[2], Lh[2];
  if (!grp) {
    if (pidx == 0) { q0h[0] = 0; nqh[0] = 16; Lh[0] = 16; q0h[1] = 0; nqh[1] = 0; Lh[1] = 0; }
    else {
      const int c0 = 2 * (pidx - 1);
      q0h[0] = 16 + 64 * c0; nqh[0] = 64; Lh[0] = 80 + 64 * c0;
      q0h[1] = 80 + 64 * c0; nqh[1] = 64; Lh[1] = 144 + 64 * c0;
    }
  } else { q0h[0] = 0; nqh[0] = 32; Lh[0] = NKS; q0h[1] = 0; nqh[1] = 0; Lh[1] = 0; }
  const int NK = grp ? NKS : NTOKP;
  const int q0 = half ? q0h[1] : q0h[0], nqv = half ? nqh[1] : nqh[0], L = half ? Lh[1] : Lh[0];
  int Lpad; float* SC;
  if (!grp) {
    if (pidx == 0) { Lpad = 64; SC = SCb + SC_META + (size_t)b * 4096; }
    else { const int c = 2 * (pidx - 1) + half; Lpad = 64 * (c + 2); SC = SCb + (size_t)b * SC_BSTRIDE + 4096ull * (size_t)(c * (c + 3) / 2); }
  } else { Lpad = 2112; SC = SCb + SC_SAMP + (size_t)b * 64 * 2112; }
  const int nkt = (L + 63) >> 6;
  const int Lmax = Lh[1] > Lh[0] ? Lh[1] : Lh[0];
  const int nkt_blk = (Lmax + 63) >> 6;
  const u16* IQg = (const u16*)(p.ws + OFF_IQ);
  const float* IWg = (const float*)(p.ws + OFF_IW);
  __syncthreads();
#pragma unroll 4
  for (int i = 0; i < 16; ++i) {
    const int c = t + NTHR * i; const int q = c >> 6, ch = c & 63;
    const int hh = q >> 6, qq = q & 63;
    const int hq0 = hh ? q0h[1] : q0h[0], hn = hh ? nqh[1] : nqh[0];
    const int tq = hn > 0 ? hq0 + (qq < hn ? qq : hn - 1) : q0h[0];
    const size_t gr = grp ? (size_t)TP + b * 32 + tq : (size_t)b * NTOKP + tq;
    *(uint4*)(IQs + q * 520 + ch * 8) = *(const uint4*)(IQg + gr * 512 + ch * 8);
  }
#pragma unroll
  for (int i = 0; i < 2; ++i) {
    const int e = t + NTHR * i; const int q = e >> 3, hd = e & 7;
    const int hh = q >> 6, qq = q & 63;
    const int hq0 = hh ? q0h[1] : q0h[0], hn = hh ? nqh[1] : nqh[0];
    const int tq = hn > 0 ? hq0 + (qq < hn ? qq : hn - 1) : q0h[0];
    const size_t gr = grp ? (size_t)TP + b * 32 + tq : (size_t)b * NTOKP + tq;
    IWs[e] = IWg[gr * 8 + hd];
  }
  const int wq = w >> 1, wk = w & 1;
  const u16* IKg = (const u16*)(p.ws + OFF_IKB) + (size_t)b * NTOKP * 64 + (t & 7) * 8;
  const int ikey = t >> 3;
  uint4 ri0 = make_uint4(0, 0, 0, 0);
  if (!grp) {
    int k0 = ikey; k0 = k0 < NTOKP ? k0 : NTOKP - 1;
    ri0 = *(const uint4*)(IKg + (size_t)k0 * 64);
  }
  for (int kt = 0; kt < nkt_blk; ++kt) {
    __syncthreads();
    if (!grp) {
      *(uint4*)(IKs + ikey * 72 + (t & 7) * 8) = ri0;
    } else {
#pragma unroll
      for (int i = 0; i < 2; ++i) {
        const int c = t + NTHR * i; const int key = c >> 4, d4 = c & 15;
        int tk = kt * 64 + key; tk = tk < NK ? tk : NK - 1;
        const float4 v = *(const float4*)(ik_row(p, grp, b, tk) + d4 * 4);
        *(uint2*)(IKs + key * 72 + d4 * 4) = make_uint2(pack2(v.x, v.y), pack2(v.z, v.w));
      }
    }
    __syncthreads();
    if (!grp && kt + 1 < nkt_blk) {
      int k0 = (kt + 1) * 64 + ikey; k0 = k0 < NTOKP ? k0 : NTOKP - 1;
      ri0 = *(const uint4*)(IKg + (size_t)k0 * 64);
    }
    if (kt < nkt) {
      bf16x8 kf[4];
#pragma unroll
      for (int ks = 0; ks < 4; ++ks) kf[ks] = *(const bf16x8*)(IKs + (wk * 32 + lr) * 72 + ks * 16 + lh * 8);
      float sc[16];
#pragma unroll
      for (int i = 0; i < 16; ++i) sc[i] = 0.f;
#pragma unroll
      for (int hd = 0; hd < 8; ++hd) {
        f32x16 st;
#pragma unroll
        for (int i = 0; i < 16; ++i) st[i] = 0.f;
#pragma unroll
        for (int ks = 0; ks < 4; ++ks) {
          const bf16x8 qfr = *(const bf16x8*)(IQs + (wq * 32 + lr) * 520 + hd * 64 + ks * 16 + lh * 8);
          st = MFMA(kf[ks], qfr, st);
        }
        const float wv = IWs[(wq * 32 + lr) * 8 + hd];
#pragma unroll
        for (int i = 0; i < 16; ++i) sc[i] += wv * fmaxf(st[i], 0.f);
      }
      float* srow = SC + (size_t)((wq & 1) * 32 + lr) * Lpad + kt * 64 + wk * 32 + 4 * lh;
#pragma unroll
      for (int g = 0; g < 4; ++g) *(float4*)(srow + 8 * g) = make_float4(sc[4 * g], sc[4 * g + 1], sc[4 * g + 2], sc[4 * g + 3]);
    }
  }
  __threadfence();
  __syncthreads();
  for (int j = 0; j < 16; ++j) {
    const int q = (w & 3) * 16 + j;
    if (q >= nqv) break;
    const int tq = q0 + q;
    u64* mrow = grp ? (u64*)(p.ws + OFF_MASKS) + ((size_t)b * 32 + tq) * NWS : (u64*)(p.ws + OFF_MASKP) + ((size_t)b * NTOKP + tq) * NWP;
    if (L <= 256) {
      for (int i = 0; i < nkt; ++i) {
        const u64 wd = __ballot(i * 64 + lane < L);
        if (lane == 0) mrow[i] = wd;
      }
      continue;
    }
    const unsigned* srow = (const unsigned*)(SC + (size_t)q * Lpad);
    int Lr = L;
    asm volatile("" : "+v"(Lr));
    int nkr = __builtin_amdgcn_readfirstlane(nkt);
    asm volatile("" : "+s"(nkr));
    int lanev = lane;
    asm volatile("" : "+v"(lanev));
    unsigned v[129];
#pragma unroll
    for (int g = 0; g < 17; ++g) {
      if (g * 8 < nkt) {
#pragma unroll
        for (int jj = 0; jj < 8; ++jj) {
          const int i = g * 8 + jj; if (i >= 129) continue;
          v[i] = __hip_atomic_load(srow + i * 64 + lanev, __ATOMIC_RELAXED, __HIP_MEMORY_SCOPE_AGENT);
        }
      } else {
#pragma unroll
        for (int jj = 0; jj < 8; ++jj) if (g * 8 + jj < 129) v[g * 8 + jj] = 0u;
      }
    }
#pragma unroll
    for (int g = 0; g < 17; ++g) {
      if (g * 8 < nkt) {
#pragma unroll
        for (int jj = 0; jj < 8; ++jj) {
          const int i = g * 8 + jj; if (i >= 129) continue; const int key = i * 64 + lanev;
          const unsigned u = ford(__uint_as_float(v[i]));
          v[i] = key < Lr ? u : 0u;
        }
        __builtin_amdgcn_sched_barrier(0);
      }
    }
    unsigned Tt = 0u;
    for (int bit = 31; bit >= 0; --bit) {
      const unsigned cand = Tt | (1u << bit);
      int cnt = 0;
#pragma unroll
      for (int g = 0; g < 17; ++g) {
        if (g * 8 < nkt) {
#pragma unroll
          for (int jj = 0; jj < 8; ++jj) if (g * 8 + jj < 129) cnt += (v[g * 8 + jj] >= cand) ? 1 : 0;
          __builtin_amdgcn_sched_barrier(0);
        }
      }
#pragma unroll
      for (int m = 32; m >= 1; m >>= 1) cnt += __shfl_xor(cnt, m, 64);
      if (cnt >= 256) Tt = cand;
    }
    int cgt = 0;
#pragma unroll
    for (int g = 0; g < 17; ++g) {
      if (g * 8 < nkt) {
#pragma unroll
        for (int jj = 0; jj < 8; ++jj) if (g * 8 + jj < 129) cgt += (v[g * 8 + jj] > Tt) ? 1 : 0;
        __builtin_amdgcn_sched_barrier(0);
      }
    }
#pragma unroll
    for (int m = 32; m >= 1; m >>= 1) cgt += __shfl_xor(cgt, m, 64);
    const int need = 256 - cgt;
    int run = 0;
    const u64 lmask = (1ull << lane) - 1ull;
#pragma unroll
    for (int g = 0; g < 17; ++g) {
      if (g * 8 < nkt) {
#pragma unroll
        for (int jj = 0; jj < 8; ++jj) {
          const int i = g * 8 + jj; if (i >= 129) continue;
          const bool eq = v[i] == Tt;
          const u64 em = __ballot(eq);
          const int pre = run + __popcll(em & lmask);
          const bool sel = (v[i] > Tt) || (eq && pre < need);
          run += __popcll(em);
          const u64 wd = __ballot(sel);
          if (i < nkr) { if (lane == 0) mrow[i] = wd; }
          __builtin_amdgcn_sched_barrier(0);
        }
      }
    }
  }
}

DI unsigned xcc_id() { return (unsigned)__builtin_amdgcn_s_getreg((3 << 11) | 20) & 7u; }

DI int next_item(unsigned* cnt, int* s_item, int qlen, int& q, int& tries) {
  __syncthreads();
  if (threadIdx.x == 0) {
    int r = -1;
    while (tries < 8) {
      const int j = (int)atomicAdd(cnt + q, 1u);
      if (j < qlen) { r = (q << 16) | j; break; }
      q = (q + 1) & 7; ++tries;
    }
    s_item[0] = r; s_item[1] = q; s_item[2] = tries;
  }
  __syncthreads();
  q = __builtin_amdgcn_readfirstlane(s_item[1]);
  tries = __builtin_amdgcn_readfirstlane(s_item[2]);
  return __builtin_amdgcn_readfirstlane(s_item[0]);
}

DI void phase_attn_a(const Params& p, char* smem, int cbase = 0) {
  unsigned* cnt = (unsigned*)(p.ws + OFF_CNT) + cbase;
  int* s_item = (int*)(smem + SMEM_ITEM);
  float lam;
  {
    const int lane = threadIdx.x & 63;
    float a = p.in[14][lane] * p.in[15][lane], c = p.in[16][lane] * p.in[17][lane];
#pragma unroll
    for (int m = 32; m >= 1; m >>= 1) { a += shx(a, m); c += shx(c, m); }
    lam = expf(a) - expf(c) + 0.2f;
  }
  int q = (int)xcc_id(), tries = 0;
  while (true) {
    const int it = next_item(cnt, s_item, 165, q, tries);
    if (it < 0) break;
    const int x = it >> 16, j = it & 0xffff;
#ifndef NO_IDX
    if (j < 17) {
      const int k = j * 8 + x;
      if (k < 130) idx_item(p, smem, 0, k & 1, 64 - (k >> 1));
    } else if (j < 19) {
      idx_item(p, smem, 1, 2 * x + (j - 17), 0);
    } else
#else
    if (j < 19) {} else
#endif
    if (j < 35) {
      const int jj = j - 19;
      attn_item<0>(p, smem, 1, 2 * x + (jj >> 3), jj & 7, 0, 32, lam);
    } else {
      const int jj = j - 35; const int bh = 2 * x + jj / 65, qt = 64 - jj % 65;
      attn_item<0>(p, smem, 0, bh >> 3, bh & 7, qt == 0 ? 0 : 16 + (qt - 1) * 128, qt == 0 ? 16 : 128, lam);
    }
  }
}

DI void phase_attn_b(const Params& p, char* smem, int cbase = 8) {
  unsigned* cnt = (unsigned*)(p.ws + OFF_CNT) + cbase;
  int* s_item = (int*)(smem + SMEM_ITEM);
  int q = (int)xcc_id(), tries = 0;
  while (true) {
    const int it = next_item(cnt, s_item, 82, q, tries);
    if (it < 0) break;
    const int x = it >> 16, j = it & 0xffff;
    if (j < 16) {
      attn_item<1>(p, smem, 1, 2 * x + (j >> 3), j & 7, 0, 32, 0.f);
    } else {
      const int jj = j - 16; const int bh = 2 * x + jj / 33, qt = 32 - jj % 33;
      attn_item<1>(p, smem, 0, bh >> 3, bh & 7, qt == 0 ? 0 : 16 + (qt - 1) * 256, qt == 0 ? 16 : 256, 0.f);
    }
  }
}

DI void phase_final(const Params& p) {
  const int t = tid_opaque(), lane = t & 63;
  const int wv = blockIdx.x * 8 + (t >> 6), nw = gridDim.x * 8;
  const float* xf = (const float*)(p.ws + OFF_XF);
  const float* ssp = (const float*)(p.ws + OFF_SSP3);
  const float4* gf = (const float4*)p.in[26];
  for (int row = wv; row < T; row += nw) {
    float* dst;
    if (row < TP) {
      const int b = row >= NTOKP ? 1 : 0; const int tok = row - b * NTOKP;
      if (tok < 16) continue;
      dst = p.out + O_YP + ((size_t)b * 8192 + (tok - 16)) * 1024;
    } else dst = p.out + O_YS + (size_t)(row - TP) * 1024;
    float s = 0.f;
#pragma unroll
    for (int i = 0; i < 16; ++i) s += ssp[(size_t)row * 16 + i];
    const float r = rsqrtf(s * (1.0f / 1024.0f) + EPS);
#pragma unroll
    for (int i = 0; i < 4; ++i) {
      const float4 v = ((const float4*)(xf + (size_t)row * 1024))[lane + 64 * i];
      const float4 g = gf[lane + 64 * i];
      ((float4*)dst)[lane + 64 * i] = make_float4(v.x * r * g.x, v.y * r * g.y, v.z * r * g.z, v.w * r * g.w);
    }
  }
}

#ifndef PHM
#define PHM 0x7ff
#endif
#define PHON(n) ((PHM >> n) & 1)
__global__ void __launch_bounds__(512, 2) mega(Params p) {
  extern __shared__ __attribute__((aligned(16))) char smem[];
  cg::grid_group grid = cg::this_grid();
  volatile LAS unsigned* xst = (volatile LAS unsigned*)(smem + SMEM_ITEM + 48);
  if (threadIdx.x == 0) { xst[0] = 0u; xst[1] = 0u; }
  __syncthreads();
  (void)xcd_barrier_post((unsigned*)(p.ws + OFF_XBAR), xst);
  int* sv = (int*)(smem + SMEM_ITEM) + 8;
  if (threadIdx.x == 0) {
    const unsigned x = xcc_id();
    sv[0] = (int)x;
    sv[1] = (int)atomicAdd((unsigned*)(p.ws + OFF_CNT) + 48 + x, 1u);
  }
  if (PHON(0)) phase_prep(p, smem);
  grid.sync();
  int vbid;
  {
    if (threadIdx.x == 0) {
      const int x = sv[0], r = sv[1];
      int v = -1;
      if (gridDim.x == 256) {
        unsigned cntx[8];
#pragma unroll
        for (int i = 0; i < 8; ++i) cntx[i] = __hip_atomic_load((unsigned*)(p.ws + OFF_CNT) + 48 + i, __ATOMIC_RELAXED, __HIP_MEMORY_SCOPE_AGENT);
        if (r < 32) v = r * 8 + x;
        else {
          int k = r - 32;
#pragma unroll
          for (int i = 0; i < 8; ++i) if (i < x && cntx[i] > 32u) k += (int)cntx[i] - 32;
#pragma unroll
          for (int i = 0; i < 8; ++i) {
            const int freei = cntx[i] < 32u ? 32 - (int)cntx[i] : 0;
            if (v < 0) { if (k < freei) v = ((int)cntx[i] + k) * 8 + i; else k -= freei; }
          }
        }
      }
      sv[2] = v;
    }
    __syncthreads();
    vbid = __builtin_amdgcn_readfirstlane(sv[2]);
    if (vbid < 0) vbid = blockIdx.x;
  }
  if (PHON(1)) phase_gateup(p, smem, OFF_SSP0, OFF_WGU1, vbid);
  gbar(p, smem);
#ifdef DUP_GEMM
  phase_gateup(p, smem, OFF_SSP0, OFF_WGU1, vbid);
  gbar(p, smem);
#endif
  if (PHON(2)) phase_resid8<1>(p, smem, (const u16*)(p.ws + OFF_HID), 2816, OFF_WD1, 0.5f, OFF_SSP1, vbid);
  gbar(p, smem);
#ifdef DUP_G2
  phase_resid<1>(p, smem, (const u16*)(p.ws + OFF_HID), 2816, 2816, OFF_WD1, 0.5f, OFF_SSP1, vbid);
  gbar(p, smem);
#endif
  if (PHON(3)) phase_win8(p, smem, vbid);
  gbar(p, smem);
#ifdef DUP_GEMM
  phase_win8(p, smem, vbid);
  gbar(p, smem);
#endif
  if (PHON(4)) phase_attn_a(p, smem);
  gbar(p, smem);
#ifdef DUP_P4
  phase_attn_a(p, smem, 16);
  gbar(p, smem);
#endif
  if (PHON(5)) phase_attn_b(p, smem);
  gbar(p, smem);
#ifdef DUP_P5
  phase_attn_b(p, smem, 24);
  gbar(p, smem);
#endif
  if (PHON(6)) phase_merge8(p, smem, vbid);
  gbar(p, smem);
#ifdef DUP_G2
  phase_merge(p, smem, vbid);
  gbar(p, smem);
#endif
  if (PHON(7)) phase_resid8<0>(p, smem, (const u16*)(p.ws + OFF_MB), 1024, OFF_WO, 1.0f, OFF_SSP2, vbid);
  gbar(p, smem);
  if (PHON(8)) phase_gateup(p, smem, OFF_SSP2, OFF_WGU2, vbid);
  gbar(p, smem);
  if (PHON(9)) phase_resid8<0>(p, smem, (const u16*)(p.ws + OFF_HID), 2816, OFF_WD2, 0.5f, OFF_SSP3, vbid);
  gbar(p, smem);
  if (PHON(10)) phase_final(p);
}

extern "C" void kernel_launch(void* const* d_in, const int* in_sizes, int n_in, void* d_out, int out_size, void* d_ws,
                              size_t ws_size, hipStream_t stream) {
  Params p{};
  for (int i = 0; i < 27; ++i) p.in[i] = (const float*)d_in[i];
  p.out = (float*)d_out;
  p.ws = (char*)d_ws;
  static int grid_blocks = 0;
  if (!grid_blocks) {
    hipFuncSetAttribute((const void*)mega, hipFuncAttributeMaxDynamicSharedMemorySize, SMEM_BYTES);
    int dev = 0, cus = 0, per_cu = 0;
    hipGetDevice(&dev);
    hipDeviceGetAttribute(&cus, hipDeviceAttributeMultiprocessorCount, dev);
    hipOccupancyMaxActiveBlocksPerMultiprocessor(&per_cu, mega, NTHR, SMEM_BYTES);
    if (per_cu > 1) per_cu = 1;
    if (per_cu < 1) per_cu = 1;
    grid_blocks = cus * per_cu;
  }
  if (ws_size < WS_END) fprintf(stderr, "workspace too small: %zu < %zu\n", ws_size, (size_t)WS_END);
  (void)hipMemsetAsync((char*)d_ws + OFF_CNT, 0, 256 + SZ_XBAR, stream);
  void* args[] = {&p};
  hipError_t e = hipLaunchCooperativeKernel((void*)mega, dim3(grid_blocks), dim3(NTHR), args, SMEM_BYTES, stream);
  if (e != hipSuccess) fprintf(stderr, "cooperative launch failed: %s (grid %d)\n", hipGetErrorString(e), grid_blocks);
}
```
